# Optimizing an MI355X kernel written in HIP

```python
import math
import functools
import jax
import jax.numpy as jnp
from jax import lax
import numpy as np

D_MODEL = 1024
BATCH = 16
SEQ = 2048
DEPTH = 2

F32 = jnp.float32
GRID_W = 64
CTX_LEN = 256
N_BRANCH = 4
MIX_W = 512
HEAD_DIM = 64
RMS_EPS = 1e-6

HY_BANDS = 16
HY_EMB = 1 + 2 * HY_BANDS
HY_FFN = 64
HY_DECAY_TARGET = 1e-2
HY_SHORT_PCT = 0.3
HY_LONG_PCT = 1.5

RW_HEADS = MIX_W // HEAD_DIM
RW_DECAY_RANK = 64
RW_A_RANK = 64
RW_G_RANK = 128
RW_DECAY_SCALE = 0.606531
RW_GN_EPS = 64e-5
RW_SPLITS = (MIX_W, MIX_W, MIX_W, RW_DECAY_RANK, RW_DECAY_RANK, RW_A_RANK, RW_A_RANK, RW_G_RANK)
RW_IN = sum(RW_SPLITS)

S5_GROUP = 16
S5_GROUPS = MIX_W // S5_GROUP
S5_STATE = 64
S5_DT_MIN = 1e-3
S5_DT_MAX = 1e-1

GLA_HEADS = 4
GLA_DK = MIX_W // 2
GLA_DV = MIX_W
GLA_HK = GLA_DK // GLA_HEADS
GLA_HV = GLA_DV // GLA_HEADS
GLA_GATE_RANK = 16
GLA_GATE_NORM = 16.0
GLA_CHUNK = 64
GLA_SPLITS = (GLA_DK, GLA_DK, GLA_DV, GLA_DV, GLA_GATE_RANK, GLA_GATE_RANK)
GLA_IN = sum(GLA_SPLITS)

D_FF = 2816
N_EXPERTS = 8
TOP_K = 2
D_FF_EXPERT = 3584
MOE_BLOCK = 128
N_DENSE = (DEPTH + 1) // 2
N_MOE = DEPTH // 2

IN_SPLITS = (3 * MIX_W, RW_IN, MIX_W, GLA_IN, N_BRANCH * D_MODEL)
IN_TOTAL = sum(IN_SPLITS)

kernel_name = 'hybrid_hyena_rwkv7_s5_gla_moe_dit'


def _split(t, sizes):
    return jnp.split(t, np.cumsum(sizes)[:-1].tolist(), axis=-1)


def _rmsnorm(x, g):
    xf = x.astype(F32)
    return xf * lax.rsqrt(jnp.mean(xf * xf, axis=-1, keepdims=True) + RMS_EPS) * g


def _swiglu(h, w1, w3, w2):
    return (jax.nn.silu(h @ w1) * (h @ w3)) @ w2


def _flip(t):
    return jnp.flip(t, axis=1)


def _ident(t):
    return t


def _to_col_major(t):
    b, l, ch = t.shape
    rows = l // GRID_W
    return jnp.swapaxes(t.reshape(b, rows, GRID_W, ch), 1, 2).reshape(b, l, ch)


def _to_raster(t):
    b, l, ch = t.shape
    rows = l // GRID_W
    return jnp.swapaxes(t.reshape(b, GRID_W, rows, ch), 1, 2).reshape(b, l, ch)


def _conv3(u, w):
    up = jnp.pad(u, ((0, 0), (1, 1), (0, 0)))
    return up[:, :-2] * w[0] + up[:, 1:-1] * w[1] + up[:, 2:] * w[2]


def _hyena_filter(L, fw1, fb1, fw2, fb2, fw3, fb3):
    pos = jnp.arange(L, dtype=F32)
    t = pos / max(L - 1, 1)
    freqs = jnp.linspace(1e-4, HY_BANDS - 1, HY_BANDS, dtype=F32)
    ang = (2.0 * math.pi / L) * pos[:, None] * freqs[None, :]
    z = jnp.concatenate([t[:, None], jnp.cos(ang), -jnp.sin(ang)], axis=-1)
    hdn = jnp.sin(z @ fw1 + fb1)
    hdn = jnp.sin(hdn @ fw2 + fb2)
    filt = hdn @ fw3 + fb3
    rates = jnp.abs(jnp.linspace(math.log(HY_DECAY_TARGET) / HY_LONG_PCT,
                                 math.log(HY_DECAY_TARGET) / HY_SHORT_PCT, MIX_W, dtype=F32))
    rates = jnp.concatenate([rates, rates])
    return filt * jnp.exp(-t[:, None] * rates[None, :])


def _bidir_long_conv(u, filt, bias):
    b, L, ch = u.shape
    h_f, h_b = filt[:, :ch], filt[:, ch:]
    k = jnp.concatenate([h_f, jnp.zeros((1, ch), F32), h_b[:0:-1]], axis=0)
    U = jnp.fft.rfft(u, n=2 * L, axis=1)
    K = jnp.fft.rfft(k, n=2 * L, axis=0)
    y = jnp.fft.irfft(U * K[None], n=2 * L, axis=1)[:, :L]
    return y + u * bias


def _hyena_mixer(p, conv_w, conv_b, fw1, fb1, fw2, fb2, fw3, fb3, bias):
    u = _conv3(p.astype(F32), conv_w) + conv_b
    x0, x1, v = _split(u, (MIX_W, MIX_W, MIX_W))
    filt = _hyena_filter(p.shape[1], fw1, fb1, fw2, fb2, fw3, fb3)
    return x0 * _bidir_long_conv(v * x1, filt, bias)


def _centred_shift(p, mu):
    pp = jnp.pad(p, ((0, 0), (1, 1), (0, 0)))
    return p + mu[0] * (pp[:, :-2] - p) + mu[1] * (pp[:, 2:] - p)


def _rwkv7_inputs(p, mu, w0, w_up, a0, a_up, g_up, k_k, k_a):
    b, L, _ = p.shape
    p = _centred_shift(p.astype(F32), mu)
    r, k, v, wd_f, wd_b, ad_f, ad_b, gd = _split(p, RW_SPLITS)
    heads = lambda t: t.reshape(b, L, RW_HEADS, HEAD_DIM)
    g = jax.nn.sigmoid(gd) @ g_up
    kk = heads(k * k_k)
    kk = kk / jnp.maximum(jnp.sqrt(jnp.sum(kk * kk, axis=-1, keepdims=True)), 1e-12)
    dirs = []
    for d, (wd, ad) in enumerate(((wd_f, ad_f), (wd_b, ad_b))):
        logw = -RW_DECAY_SCALE * jax.nn.sigmoid(w0[d] + jnp.tanh(wd) @ w_up[d])
        a = jax.nn.sigmoid(a0[d] + ad @ a_up[d])
        k_d = k * (1.0 + (a - 1.0) * k_a)
        dirs.append((heads(jnp.exp(logw)), heads(k_d), heads(a)))
    return heads(r), heads(v), kk, g, dirs


def _rwkv7_scan(s0, seq, d, reverse):
    r, v, kk, _, dirs = seq
    w, k, a = dirs[d]

    def step(s, inp):
        r_t, w_t, k_t, v_t, kk_t, a_t = inp
        s = (s * w_t[:, :, None, :]
             - jnp.einsum('bhvk,bhk->bhv', s, kk_t)[..., None] * (kk_t * a_t)[:, :, None, :]
             + v_t[..., None] * k_t[:, :, None, :])
        return s, jnp.einsum('bhvk,bhk->bhv', s, r_t)

    xs = tuple(jnp.swapaxes(t, 0, 1) for t in (r, w, k, v, kk, a))
    s_fin, o = lax.scan(step, s0, xs, reverse=reverse)
    return s_fin, jnp.swapaxes(o, 0, 1)


def _rwkv7_readout(o, seq, r_k, ln_g, ln_b):
    r, v, _, g, dirs = seq
    b, L = o.shape[:2]
    mean = jnp.mean(o, axis=-1, keepdims=True)
    var = jnp.mean(jnp.square(o - mean), axis=-1, keepdims=True)
    on = ((o - mean) * lax.rsqrt(var + RW_GN_EPS)).reshape(b, L, MIX_W) * ln_g + ln_b
    bonus = sum(jnp.sum(r * k_d * r_k, axis=-1, keepdims=True) * v for (_, k_d, _) in dirs)
    return (on + bonus.reshape(b, L, MIX_W)) * g


def _rwkv7_mixer(pc, pl, want_ctx, mu, w0, w_up, a0, a_up, g_up, k_k, k_a, r_k, ln_g, ln_b):
    seq_c = _rwkv7_inputs(pc, mu, w0, w_up, a0, a_up, g_up, k_k, k_a)
    seq_l = _rwkv7_inputs(pl, mu, w0, w_up, a0, a_up, g_up, k_k, k_a)
    s0 = jnp.zeros((pl.shape[0], RW_HEADS, HEAD_DIM, HEAD_DIM), F32)
    o_c = 0.0
    o_l = 0.0
    for d in range(2):
        s_c, oc = _rwkv7_scan(s0, seq_c, d, d == 1)
        _, ol = _rwkv7_scan(s_c, seq_l, d, d == 1)
        o_c = o_c + oc
        o_l = o_l + ol
    y_l = _rwkv7_readout(o_l, seq_l, r_k, ln_g, ln_b)
    y_c = _rwkv7_readout(o_c, seq_c, r_k, ln_g, ln_b) if want_ctx else None
    return y_c, y_l


def _s5_discretise(a_re, a_im, log_dt):
    dt = jnp.exp(log_dt)[:, None]
    mag = jnp.exp(a_re * dt)
    ang = a_im * dt
    ab_re, ab_im = mag * jnp.cos(ang), mag * jnp.sin(ang)
    nr, ni = ab_re - 1.0, ab_im
    den = a_re * a_re + a_im * a_im
    return ab_re, ab_im, (nr * a_re + ni * a_im) / den, (ni * a_re - nr * a_im) / den


def _cplx_affine(e1, e2):
    a1r, a1i, b1r, b1i = e1
    a2r, a2i, b2r, b2i = e2
    return (a1r * a2r - a1i * a2i, a1r * a2i + a1i * a2r,
            a2r * b1r - a2i * b1i + b2r, a2r * b1i + a2i * b1r + b2i)


def _s5_scan(ab_re, ab_im, x_re, x_im, h_re, h_im, reverse):
    if reverse:
        x_re, x_im = _flip(x_re), _flip(x_im)
    x_re = x_re.at[:, 0].add(ab_re * h_re - ab_im * h_im)
    x_im = x_im.at[:, 0].add(ab_re * h_im + ab_im * h_re)
    L = x_re.shape[1]
    a_re = jnp.broadcast_to(ab_re, (1, L) + ab_re.shape)
    a_im = jnp.broadcast_to(ab_im, (1, L) + ab_im.shape)
    _, _, s_re, s_im = lax.associative_scan(_cplx_affine, (a_re, a_im, x_re, x_im), axis=1)
    if reverse:
        s_re, s_im = _flip(s_re), _flip(s_im)
    return s_re, s_im


def _s5_readout(s_re, s_im, c_re, c_im):
    return jnp.einsum('gpn,blgn->blgp', c_re, s_re) - jnp.einsum('gpn,blgn->blgp', c_im, s_im)


def _s5_output(y, u, d_skip, glu_w, glu_b):
    y = jax.nn.gelu(y.reshape(u.shape) + d_skip * u)
    return y * jax.nn.sigmoid(y @ glu_w + glu_b)


def _s5_mixer(pc, pl, want_ctx, a_re, a_im, log_dt, b_re, b_im, c_re, c_im, d_skip, glu_w, glu_b):
    def drive(p):
        u = p.astype(F32)
        ug = u.reshape(u.shape[0], u.shape[1], S5_GROUPS, S5_GROUP)
        return u, jnp.einsum('blgp,gnp->blgn', ug, b_re), jnp.einsum('blgp,gnp->blgn', ug, b_im)

    uc, bc_re, bc_im = drive(pc)
    ul, bl_re, bl_im = drive(pl)
    zero = jnp.zeros((ul.shape[0], S5_GROUPS, S5_STATE), F32)
    y_c = 0.0
    y_l = 0.0
    for d in range(2):
        rev = d == 1
        ab_re, ab_im, f_re, f_im = _s5_discretise(a_re[d], a_im[d], log_dt[d])
        sc_re, sc_im = _s5_scan(ab_re, ab_im, f_re * bc_re - f_im * bc_im, f_re * bc_im + f_im * bc_re,
                                zero, zero, rev)
        edge = 0 if rev else -1
        sl_re, sl_im = _s5_scan(ab_re, ab_im, f_re * bl_re - f_im * bl_im, f_re * bl_im + f_im * bl_re,
                                sc_re[:, edge], sc_im[:, edge], rev)
        y_l = y_l + _s5_readout(sl_re, sl_im, c_re, c_im)
        if want_ctx:
            y_c = y_c + _s5_readout(sc_re, sc_im, c_re, c_im)
    out_l = _s5_output(y_l, ul, d_skip, glu_w, glu_b)
    out_c = _s5_output(y_c, uc, d_skip, glu_w, glu_b) if want_ctx else None
    return out_c, out_l


def _gla_prep(p, gate_up, gate_b):
    b, L, _ = p.shape
    q, k, v, g, gd_f, gd_b = _split(p.astype(F32), GLA_SPLITS)
    hk = lambda t: t.reshape(b, L, GLA_HEADS, GLA_HK)
    logs = tuple(hk(jax.nn.log_sigmoid(gd @ gate_up[d] + gate_b[d]) / GLA_GATE_NORM)
                 for d, gd in enumerate((gd_f, gd_b)))
    return hk(q) * (GLA_HK ** -0.5), hk(k), v.reshape(b, L, GLA_HEADS, GLA_HV), g, logs


def _gla_chunked(q, k, v, logg, s0):
    b, L, h, dk = q.shape
    dv = v.shape[-1]
    C = min(GLA_CHUNK, L)
    n = L // C
    q, k, v, logg = (t.reshape(b, n, C, h, t.shape[-1]) for t in (q, k, v, logg))
    cum = jnp.cumsum(logg, axis=2)
    ref = cum[:, :, C // 2 - 1:C // 2]
    last = cum[:, :, C - 1:]
    scores = jnp.einsum('bnihd,bnjhd->bnhij', q * jnp.exp(cum - ref), k * jnp.exp(ref - cum))
    scores = jnp.where(jnp.tril(jnp.ones((C, C), bool)), scores, 0.0)
    o = jnp.einsum('bnhij,bnjhe->bnihe', scores, v)
    u = jnp.einsum('bnjhd,bnjhe->bnhde', k * jnp.exp(last - cum), v)
    decay = jnp.exp(last[:, :, 0])

    def step(s, inp):
        u_n, g_n = inp
        return s * g_n[..., None] + u_n, s

    s_fin, s_start = lax.scan(step, s0, (jnp.swapaxes(u, 0, 1), jnp.swapaxes(decay, 0, 1)))
    o = o + jnp.einsum('bnihd,nbhde->bnihe', q * jnp.exp(cum), s_start)
    return o.reshape(b, L, h, dv), s_fin


def _gla_mixer(pc, pl, want_ctx, gate_up, gate_b, norm_g):
    qc, kc, vc, gc, lc = _gla_prep(pc, gate_up, gate_b)
    ql, kl, vl, gl, ll = _gla_prep(pl, gate_up, gate_b)
    s0 = jnp.zeros((pl.shape[0], GLA_HEADS, GLA_HK, GLA_HV), F32)
    o_c = 0.0
    o_l = 0.0
    for d in range(2):
        fl = _flip if d == 1 else _ident
        oc, s_c = _gla_chunked(fl(qc), fl(kc), fl(vc), fl(lc[d]), s0)
        ol, _ = _gla_chunked(fl(ql), fl(kl), fl(vl), fl(ll[d]), s_c)
        o_c = o_c + fl(oc)
        o_l = o_l + fl(ol)

    def readout(o, g):
        b, L = o.shape[:2]
        on = o * lax.rsqrt(jnp.mean(o * o, axis=-1, keepdims=True) + RMS_EPS) * norm_g
        return on.reshape(b, L, GLA_DV) * jax.nn.silu(g)

    return (readout(o_c, gc) if want_ctx else None), readout(o_l, gl)


def _merge(branches, gate_pre, w_branch, w_out):
    g = jax.nn.sigmoid(gate_pre.astype(F32))
    acc = 0.0
    for m, y in enumerate(branches):
        acc = acc + g[..., m * D_MODEL:(m + 1) * D_MODEL] * (y @ w_branch[m])
    return acc @ w_out


def _mixer_block(hc, hl, want_ctx, lp):
    pc = hc @ lp['w_in']
    pl = hl @ lp['w_in']
    hy_c, rw_c, s5_c, gla_c, gate_c = _split(pc, IN_SPLITS)
    hy_l, rw_l, s5_l, gla_l, gate_l = _split(pl, IN_SPLITS)
    y_rw_c, y_rw_l = _rwkv7_mixer(rw_c, rw_l, want_ctx, *lp['rw'])
    y_s5_c, y_s5_l = _s5_mixer(s5_c, s5_l, want_ctx, *lp['s5'])
    y_gla_c, y_gla_l = _gla_mixer(gla_c, _to_col_major(gla_l), want_ctx, *lp['gla'])
    branches_l = (_hyena_mixer(hy_l, *lp['hy']), y_rw_l, y_s5_l, _to_raster(y_gla_l))
    out_l = _merge(branches_l, gate_l, lp['w_branch'], lp['w_out'])
    if not want_ctx:
        return None, out_l
    branches_c = (_hyena_mixer(hy_c, *lp['hy']), y_rw_c, y_s5_c, y_gla_c)
    return _merge(branches_c, gate_c, lp['w_branch'], lp['w_out']), out_l


def _moe_ffn(h, router_w, router_b, w1, w3, w2):
    shape = h.shape
    tok = h.reshape(-1, shape[-1])
    n_tok = tok.shape[0]
    logits = tok.astype(F32) @ router_w + router_b
    top_v, top_i = lax.top_k(logits, TOP_K)
    gates = jax.nn.softmax(top_v, axis=-1)
    n_assign = n_tok * TOP_K
    e_flat = top_i.reshape(-1)
    order = jnp.argsort(e_flat)
    e_sorted = e_flat[order]
    counts = jnp.bincount(e_flat, length=N_EXPERTS)
    padded = (counts + MOE_BLOCK - 1) // MOE_BLOCK * MOE_BLOCK
    start = jnp.cumsum(counts) - counts
    pend = jnp.cumsum(padded)
    pstart = pend - padded
    dest = pstart[e_sorted] + jnp.arange(n_assign) - start[e_sorted]
    n_blocks = -(-n_assign // MOE_BLOCK) + N_EXPERTS
    row_tok = jnp.full((n_blocks * MOE_BLOCK,), n_tok, jnp.int32).at[dest].set((order // TOP_K).astype(jnp.int32))
    block_exp = jnp.minimum(jnp.searchsorted(pend, jnp.arange(n_blocks) * MOE_BLOCK, side='right'), N_EXPERTS - 1)
    tok_pad = jnp.concatenate([tok, jnp.zeros((1, shape[-1]), tok.dtype)], axis=0)
    xb = tok_pad[row_tok].reshape(n_blocks, MOE_BLOCK, shape[-1])
    yb = lax.map(lambda a: _swiglu(a[0], w1[a[1]], w3[a[1]], w2[a[1]]), (xb, block_exp))
    yb = yb.reshape(n_blocks * MOE_BLOCK, shape[-1])
    dest_orig = jnp.zeros((n_assign,), dest.dtype).at[order].set(dest)
    y = yb[dest_orig].reshape(n_tok, TOP_K, shape[-1])
    return jnp.einsum('tkd,tk->td', y, gates.astype(y.dtype)).reshape(shape)


def _trunk_layer(h, hc, mod_l, mod_c, g_mix, g_ffn, lp, ffn, last):
    sh1, sc1, gt1, sh2, sc2, gt2 = jnp.split(mod_l[:, None, :], 6, axis=-1)
    csh1, csc1, cgt1, csh2, csc2, cgt2 = jnp.split(mod_c, 6, axis=-1)
    yc, yl = _mixer_block(_rmsnorm(hc, g_mix) * (1.0 + csc1) + csh1,
                          _rmsnorm(h, g_mix) * (1.0 + sc1) + sh1, not last, lp)
    h = h + gt1 * yl
    h = h + gt2 * ffn(_rmsnorm(h, g_ffn) * (1.0 + sc2) + sh2)
    if not last:
        hc = hc + cgt1 * yc
        hc = hc + cgt2 * ffn(_rmsnorm(hc, g_ffn) * (1.0 + csc2) + csh2)
    return h, hc


def setup_inputs(seed: int = 0) -> dict:
    key = jax.random.key(seed)
    ks = jax.random.split(key, 64)
    ctr = [0]

    def nxt():
        k = ks[ctr[0]]
        ctr[0] += 1
        return k

    def nrm(shape, scale):
        return scale * jax.random.normal(nxt(), shape, F32)

    def unif(shape, lo, hi):
        return jax.random.uniform(nxt(), shape, F32, lo, hi)

    D = D_MODEL
    G, N = S5_GROUPS, S5_STATE
    a_im0 = jnp.broadcast_to(math.pi * jnp.arange(N, dtype=F32), (DEPTH, 2, G, N))
    return {
        'x': nrm((BATCH, SEQ, D), 1.0),
        'c': nrm((BATCH, D), 1.0),
        'ctx': nrm((BATCH, CTX_LEN, D), 1.0),
        'c_ctx': nrm((D,), 1.0),
        'ada_w': nrm((DEPTH, D, 6 * D), 0.5 * D ** -0.5),
        'ada_b': nrm((DEPTH, 6 * D), 0.02),
        'norm_mix_g': 1.0 + nrm((DEPTH, D), 0.02),
        'norm_ffn_g': 1.0 + nrm((DEPTH, D), 0.02),
        'w_in': nrm((DEPTH, D, IN_TOTAL), D ** -0.5),
        'hy_conv_w': nrm((DEPTH, 3, 3 * MIX_W), 3 ** -0.5),
        'hy_conv_b': nrm((DEPTH, 3 * MIX_W), 0.02),
        'hy_f_w1': nrm((DEPTH, HY_EMB, HY_FFN), HY_EMB ** -0.5),
        'hy_f_b1': nrm((DEPTH, HY_FFN), 0.1),
        'hy_f_w2': nrm((DEPTH, HY_FFN, HY_FFN), HY_FFN ** -0.5),
        'hy_f_b2': nrm((DEPTH, HY_FFN), 0.1),
        'hy_f_w3': nrm((DEPTH, HY_FFN, 2 * MIX_W), 0.02),
        'hy_f_b3': nrm((DEPTH, 2 * MIX_W), 0.01),
        'hy_bias': nrm((DEPTH, MIX_W), 0.5),
        'rw_mu': unif((DEPTH, 2, RW_IN), 0.0, 0.5),
        'rw_w0': unif((DEPTH, 2, MIX_W), -1.0, 2.0),
        'rw_w_up': nrm((DEPTH, 2, RW_DECAY_RANK, MIX_W), 0.1),
        'rw_a0': nrm((DEPTH, 2, MIX_W), 0.3),
        'rw_a_up': nrm((DEPTH, 2, RW_A_RANK, MIX_W), 0.1),
        'rw_g_up': nrm((DEPTH, RW_G_RANK, MIX_W), RW_G_RANK ** -0.5),
        'rw_k_k': 0.85 + nrm((DEPTH, MIX_W), 0.02),
        'rw_k_a': 1.0 + nrm((DEPTH, MIX_W), 0.02),
        'rw_r_k': nrm((DEPTH, RW_HEADS, HEAD_DIM), 0.1),
        'rw_ln_g': 1.0 + nrm((DEPTH, MIX_W), 0.02),
        'rw_ln_b': nrm((DEPTH, MIX_W), 0.02),
        's5_a_re': -0.5 + nrm((DEPTH, 2, G, N), 0.01),
        's5_a_im': a_im0 + nrm((DEPTH, 2, G, N), 0.01),
        's5_log_dt': unif((DEPTH, 2, G), math.log(S5_DT_MIN), math.log(S5_DT_MAX)),
        's5_b_re': nrm((DEPTH, G, N, S5_GROUP), (2 * S5_GROUP) ** -0.5),
        's5_b_im': nrm((DEPTH, G, N, S5_GROUP), (2 * S5_GROUP) ** -0.5),
        's5_c_re': nrm((DEPTH, G, S5_GROUP, N), (2 * N) ** -0.5),
        's5_c_im': nrm((DEPTH, G, S5_GROUP, N), (2 * N) ** -0.5),
        's5_d': nrm((DEPTH, MIX_W), 1.0),
        's5_glu_w': nrm((DEPTH, MIX_W, MIX_W), MIX_W ** -0.5),
        's5_glu_b': nrm((DEPTH, MIX_W), 0.02),
        'gla_gate_up': nrm((DEPTH, 2, GLA_GATE_RANK, GLA_DK), GLA_GATE_RANK ** -0.5),
        'gla_gate_b': nrm((DEPTH, 2, GLA_DK), 0.1),
        'gla_norm_g': 1.0 + nrm((DEPTH, GLA_HV), 0.02),
        'w_branch': nrm((DEPTH, N_BRANCH, MIX_W, D), MIX_W ** -0.5),
        'w_out': nrm((DEPTH, D, D), D ** -0.5),
        'ffn_w1': nrm((N_DENSE, D, D_FF), D ** -0.5),
        'ffn_w3': nrm((N_DENSE, D, D_FF), D ** -0.5),
        'ffn_w2': nrm((N_DENSE, D_FF, D), D_FF ** -0.5),
        'moe_router_w': nrm((N_MOE, D, N_EXPERTS), D ** -0.5),
        'moe_router_b': nrm((N_MOE, N_EXPERTS), 0.01),
        'moe_w1': nrm((N_MOE, N_EXPERTS, D, D_FF_EXPERT), D ** -0.5),
        'moe_w3': nrm((N_MOE, N_EXPERTS, D, D_FF_EXPERT), D ** -0.5),
        'moe_w2': nrm((N_MOE, N_EXPERTS, D_FF_EXPERT, D), D_FF_EXPERT ** -0.5),
        'final_norm_g': 1.0 + nrm((D,), 0.02),
    }


def reference(x, c, ctx, c_ctx, ada_w, ada_b, norm_mix_g, norm_ffn_g, w_in,
              hy_conv_w, hy_conv_b, hy_f_w1, hy_f_b1, hy_f_w2, hy_f_b2, hy_f_w3, hy_f_b3, hy_bias,
              rw_mu, rw_w0, rw_w_up, rw_a0, rw_a_up, rw_g_up, rw_k_k, rw_k_a, rw_r_k, rw_ln_g, rw_ln_b,
              s5_a_re, s5_a_im, s5_log_dt, s5_b_re, s5_b_im, s5_c_re, s5_c_im, s5_d, s5_glu_w, s5_glu_b,
              gla_gate_up, gla_gate_b, gla_norm_g, w_branch, w_out,
              ffn_w1, ffn_w3, ffn_w2, moe_router_w, moe_router_b, moe_w1, moe_w3, moe_w2,
              final_norm_g):
    s_lat = jax.nn.silu(c.astype(F32))
    s_ctx = jax.nn.silu(c_ctx.astype(F32))
    h = x.astype(F32)
    hc = ctx.astype(F32)
    for l in range(DEPTH):
        lp = {
            'w_in': w_in[l],
            'hy': (hy_conv_w[l], hy_conv_b[l], hy_f_w1[l], hy_f_b1[l], hy_f_w2[l], hy_f_b2[l],
                   hy_f_w3[l], hy_f_b3[l], hy_bias[l]),
            'rw': (rw_mu[l], rw_w0[l], rw_w_up[l], rw_a0[l], rw_a_up[l], rw_g_up[l], rw_k_k[l],
                   rw_k_a[l], rw_r_k[l], rw_ln_g[l], rw_ln_b[l]),
            's5': (s5_a_re[l], s5_a_im[l], s5_log_dt[l], s5_b_re[l], s5_b_im[l], s5_c_re[l],
                   s5_c_im[l], s5_d[l], s5_glu_w[l], s5_glu_b[l]),
            'gla': (gla_gate_up[l], gla_gate_b[l], gla_norm_g[l]),
            'w_branch': w_branch[l],
            'w_out': w_out[l],
        }
        i = l // 2
        if l % 2 == 0:
            ffn = functools.partial(_swiglu, w1=ffn_w1[i], w3=ffn_w3[i], w2=ffn_w2[i])
        else:
            ffn = functools.partial(_moe_ffn, router_w=moe_router_w[i], router_b=moe_router_b[i],
                                    w1=moe_w1[i], w3=moe_w3[i], w2=moe_w2[i])
        mod_l = s_lat @ ada_w[l] + ada_b[l]
        mod_c = s_ctx @ ada_w[l] + ada_b[l]
        h, hc = _trunk_layer(h, hc, mod_l, mod_c, norm_mix_g[l], norm_ffn_g[l], lp, ffn, l == DEPTH - 1)
    return _rmsnorm(h, final_norm_g).astype(x.dtype)
```

```cpp
#include <hip/hip_runtime.h>
#include <stdint.h>
#include <string.h>

typedef unsigned short u16;
typedef short bf16x8 __attribute__((ext_vector_type(8)));
typedef float f32x4 __attribute__((ext_vector_type(4)));
typedef unsigned u32x4 __attribute__((ext_vector_type(4)));
typedef unsigned u32x2 __attribute__((ext_vector_type(2)));

#define NT 512
#define MT 36864
#define RC 4096
#define LDS_BYTES 81920

enum { I_x, I_c, I_ctx, I_c_ctx, I_ada_w, I_ada_b, I_norm_mix_g, I_norm_ffn_g, I_w_in, I_hy_conv_w, I_hy_conv_b, I_hy_f_w1, I_hy_f_b1, I_hy_f_w2, I_hy_f_b2,
       I_hy_f_w3, I_hy_f_b3, I_hy_bias, I_rw_mu, I_rw_w0, I_rw_w_up, I_rw_a0, I_rw_a_up, I_rw_g_up, I_rw_k_k, I_rw_k_a, I_rw_r_k, I_rw_ln_g, I_rw_ln_b,
       I_s5_a_re, I_s5_a_im, I_s5_log_dt, I_s5_b_re, I_s5_b_im, I_s5_c_re, I_s5_c_im, I_s5_d, I_s5_glu_w, I_s5_glu_b, I_gla_gate_up, I_gla_gate_b, I_gla_norm_g,
       I_w_branch, I_w_out, I_ffn_w1, I_ffn_w3, I_ffn_w2, I_moe_router_w, I_moe_router_b, I_moe_w1, I_moe_w3, I_moe_w2, I_final_norm_g, N_IN };

struct P {
    const float* in[N_IN];
    float* out;
    float* mod;
    float* filt;
    int* moe_i;
    int* row_tok;
    int* dest_of;
    int* top_i;
    float* top_g;
    u16* wt_in;
    u16* wt_br;
    u16* wt_out;
    u16* wt_f13;
    u16* wt_f2;
    u16* wt_glu;
    float* hctx;
    u16* hn;
    u16* y;
    char* arena;
    u16* wt_m13;
    u16* wt_m2;
    u16* yb;
    u16* gch;
};

__device__ __forceinline__ float bf2f(u16 b) { return __uint_as_float(((unsigned)b) << 16); }
__device__ __forceinline__ u16 f2bf(float f) { unsigned u = __float_as_uint(f); u += 0x7FFFu + ((u >> 16) & 1u); return (u16)(u >> 16); }
__device__ __forceinline__ unsigned pk2(float lo, float hi) { unsigned r; asm volatile("v_cvt_pk_bf16_f32 %0, %1, %2" : "=v"(r) : "v"(lo), "v"(hi)); return r; }
__device__ __forceinline__ float sigm(float x) { return 1.f / (1.f + expf(-x)); }
__device__ __forceinline__ float wsum(float v) {
#pragma unroll
    for (int o = 32; o > 0; o >>= 1) v += __shfl_xor(v, o, 64);
    return v;
}
__device__ __forceinline__ int mrow_of(int row) { return row < RC ? 16 : ((row - RC) >> 11); }
#define LDSWAIT() asm volatile("s_waitcnt lgkmcnt(0)" ::: "memory")

__global__ void __launch_bounds__(NT) k_transpose(const float* src, int K, int N, long ldsrc, u16* dst, int G, int GS, int off) {
    __shared__ float t[64][65];
    const int tk = K / 64, tn = (N + 63) / 64;
    const int tx = threadIdx.x & 63, ty = threadIdx.x >> 6;
    for (int u = blockIdx.x; u < tk * tn; u += gridDim.x) {
        const int k0 = (u % tk) * 64, n0 = (u / tk) * 64;
        __syncthreads();
        for (int i = ty; i < 64; i += 8) { const int n = n0 + tx; t[i][tx] = n < N ? src[(long)(k0 + i) * ldsrc + n] : 0.f; }
        __syncthreads();
        for (int i = ty; i < 64; i += 8) { const int n = n0 + i; if (n < N) { const long dr = (long)(n / G) * GS + (n % G) + off; dst[dr * K + k0 + tx] = f2bf(t[tx][i]); } }
    }
}

__global__ void __launch_bounds__(NT) k_mod(P p) {
    extern __shared__ __attribute__((aligned(16))) char smem[];
    float* s = (float*)smem;
    for (int i = threadIdx.x; i < 17 * 1024; i += NT) { const int r = i >> 10, k = i & 1023; const float v = r < 16 ? p.in[I_c][r * 1024 + k] : p.in[I_c_ctx][k]; s[i] = v / (1.f + expf(-v)); }
    __syncthreads();
    for (int u = blockIdx.x; u < 24; u += gridDim.x) {
        const int l = u / 12, j = (u % 12) * 512 + threadIdx.x;
        float acc[17];
        const float bb = p.in[I_ada_b][l * 6144 + j];
#pragma unroll
        for (int r = 0; r < 17; ++r) acc[r] = bb;
        const float* w = p.in[I_ada_w] + (size_t)l * 1024 * 6144 + j;
        for (int k = 0; k < 1024; ++k) { const float wv = w[(size_t)k * 6144];
#pragma unroll
            for (int r = 0; r < 17; ++r) acc[r] += s[r * 1024 + k] * wv; }
#pragma unroll
        for (int r = 0; r < 17; ++r) p.mod[(size_t)(l * 17 + r) * 6144 + j] = acc[r];
    }
}

__global__ void __launch_bounds__(NT) k_filt(P p) {
    __shared__ float z[40], h1[64], h2[64];
    const int tid = threadIdx.x;
    for (int u = blockIdx.x; u < 2 * 2304; u += gridDim.x) {
        const int l = u / 2304, pi = u % 2304;
        const int L = pi < 256 ? 256 : 2048, pos = pi < 256 ? pi : pi - 256;
        const float t = (float)pos / (float)(L - 1);
        __syncthreads();
        if (tid == 0) z[0] = t;
        if (tid >= 1 && tid <= 16) { const int i = tid - 1; const float fr = 1e-4f + (float)i * ((15.f - 1e-4f) / 15.f); const float ang = (6.283185307179586f / (float)L) * (float)pos * fr; z[1 + i] = cosf(ang); z[17 + i] = -sinf(ang); }
        __syncthreads();
        if (tid < 64) { float a = p.in[I_hy_f_b1][l * 64 + tid]; for (int i = 0; i < 33; ++i) a += z[i] * p.in[I_hy_f_w1][(l * 33 + i) * 64 + tid]; h1[tid] = sinf(a); }
        __syncthreads();
        if (tid < 64) { float a = p.in[I_hy_f_b2][l * 64 + tid]; for (int i = 0; i < 64; ++i) a += h1[i] * p.in[I_hy_f_w2][(l * 64 + i) * 64 + tid]; h2[tid] = sinf(a); }
        __syncthreads();
        for (int c = tid; c < 1024; c += NT) {
            float a = p.in[I_hy_f_b3][l * 1024 + c];
            for (int i = 0; i < 64; ++i) a += h2[i] * p.in[I_hy_f_w3][(l * 64 + i) * 1024 + c];
            const float ra = 3.0701134573f, rb = 15.3505672867f;
            const float rate = ra + (float)(c & 511) * ((rb - ra) / 511.f);
            p.filt[((size_t)l * 2304 + pi) * 1024 + c] = a * expf(-t * rate);
        }
    }
}

__global__ void __launch_bounds__(NT) k_norm(P p, int l, int which, int r0, int r1, int first, int router) {
    const int wid = threadIdx.x >> 6, lane = threadIdx.x & 63;
    const float* g = p.in[which ? I_norm_ffn_g : I_norm_mix_g] + l * 1024;
    const int shoff = which ? 3072 : 0, scoff = which ? 4096 : 1024;
    for (int row = r0 + blockIdx.x * 8 + wid; row < r1; row += gridDim.x * 8) {
        const float* src = row < RC ? ((first ? p.in[I_ctx] : p.hctx) + (size_t)row * 1024) : ((first ? p.in[I_x] : p.out) + (size_t)(row - RC) * 1024);
        const float* md = p.mod + (size_t)(l * 17 + mrow_of(row)) * 6144;
        f32x4 v[4]; float ss = 0.f;
#pragma unroll
        for (int i = 0; i < 4; ++i) { v[i] = *(const f32x4*)(src + i * 256 + lane * 4); ss += v[i][0] * v[i][0] + v[i][1] * v[i][1] + v[i][2] * v[i][2] + v[i][3] * v[i][3]; }
        ss = wsum(ss);
        const float rs = rsqrtf(ss * (1.f / 1024.f) + 1e-6f);
        float lg[8];
#pragma unroll
        for (int e = 0; e < 8; ++e) lg[e] = 0.f;
#pragma unroll
        for (int i = 0; i < 4; ++i) {
            const int k = i * 256 + lane * 4;
            const f32x4 gg = *(const f32x4*)(g + k), sc = *(const f32x4*)(md + scoff + k), sh = *(const f32x4*)(md + shoff + k);
            f32x4 o;
#pragma unroll
            for (int j = 0; j < 4; ++j) o[j] = v[i][j] * rs * gg[j] * (1.f + sc[j]) + sh[j];
            u32x2 w; w.x = pk2(o[0], o[1]); w.y = pk2(o[2], o[3]);
            *(u32x2*)(p.hn + (size_t)row * 1024 + k) = w;
            if (router) {
#pragma unroll
                for (int j = 0; j < 4; ++j) { const float* rw = p.in[I_moe_router_w] + (size_t)(k + j) * 8;
#pragma unroll
                    for (int e = 0; e < 8; ++e) lg[e] += o[j] * rw[e]; }
            }
        }
        if (router) {
#pragma unroll
            for (int e = 0; e < 8; ++e) lg[e] = wsum(lg[e]) + p.in[I_moe_router_b][e];
            if (lane == 0) {
                int i0 = 0; float v0 = lg[0];
#pragma unroll
                for (int e = 1; e < 8; ++e) if (lg[e] > v0) { v0 = lg[e]; i0 = e; }
                int i1 = -1; float v1 = -3.4e38f;
#pragma unroll
                for (int e = 0; e < 8; ++e) if (e != i0 && lg[e] > v1) { v1 = lg[e]; i1 = e; }
                const float e1 = expf(v1 - v0), g0 = 1.f / (1.f + e1), g1 = e1 / (1.f + e1);
                const int tok = row - RC;
                p.top_i[tok * 2] = i0; p.top_i[tok * 2 + 1] = i1; p.top_g[tok * 2] = g0; p.top_g[tok * 2 + 1] = g1;
                atomicAdd(&p.moe_i[i0], 1); atomicAdd(&p.moe_i[i1], 1);
            }
        }
    }
}

typedef f32x4 Acc[2][2][4][2];
__device__ __forceinline__ int perm32(int rho) { const int n = rho >> 4, i = rho & 15; return 8 * (i >> 2) + 4 * n + (i & 3); }

template <class Pr>
__device__ __forceinline__ void gemm_v1(const Pr& pr, char* smem) {
    const int tid = threadIdx.x, wid = tid >> 6, lane = tid & 63, wr = wid >> 2, wc = wid & 3, fr = lane & 15, fq = lane >> 4;
    u16* sA = (u16*)smem; u16* sB = sA + 256 * 40;
    const int nu = pr.num_units();
    const int kp = (tid & 3) * 8;
    for (int u = blockIdx.x; u < nu; u += gridDim.x) {
        int pm, pn; if (!pr.unit(u, pm, pn)) continue;
        const u16* arow[2]; const u16* brow[2];
#pragma unroll
        for (int i = 0; i < 2; ++i) { const int row = (tid + i * 512) >> 2; arow[i] = pr.a_row(pm, row); brow[i] = pr.b_row(pm, pn, (row & ~31) + perm32(row & 31)); }
        Acc acc;
#pragma unroll
        for (int a = 0; a < 2; ++a)
#pragma unroll
            for (int b = 0; b < 2; ++b)
#pragma unroll
                for (int m = 0; m < 4; ++m)
#pragma unroll
                    for (int n = 0; n < 2; ++n) acc[a][b][m][n] = (f32x4){0.f, 0.f, 0.f, 0.f};
        const int K = pr.K();
        for (int k0 = 0; k0 < K; k0 += 32) {
            u32x4 ra[2], rb[2];
#pragma unroll
            for (int i = 0; i < 2; ++i) { ra[i] = arow[i] ? *(const u32x4*)(arow[i] + k0 + kp) : (u32x4){0u, 0u, 0u, 0u}; rb[i] = *(const u32x4*)(brow[i] + k0 + kp); }
            __syncthreads();
#pragma unroll
            for (int i = 0; i < 2; ++i) { const int row = (tid + i * 512) >> 2; *(u32x4*)(sA + row * 40 + kp) = ra[i]; *(u32x4*)(sB + row * 40 + kp) = rb[i]; }
            __syncthreads();
            bf16x8 af[2][4], bf[2][2];
#pragma unroll
            for (int a = 0; a < 2; ++a)
#pragma unroll
                for (int m = 0; m < 4; ++m) af[a][m] = *(const bf16x8*)(sA + (a * 128 + wr * 64 + m * 16 + fr) * 40 + fq * 8);
#pragma unroll
            for (int b = 0; b < 2; ++b)
#pragma unroll
                for (int n = 0; n < 2; ++n) bf[b][n] = *(const bf16x8*)(sB + (b * 128 + wc * 32 + n * 16 + fr) * 40 + fq * 8);
#pragma unroll
            for (int a = 0; a < 2; ++a)
#pragma unroll
                for (int b = 0; b < 2; ++b)
#pragma unroll
                    for (int m = 0; m < 4; ++m)
#pragma unroll
                        for (int n = 0; n < 2; ++n) acc[a][b][m][n] = __builtin_amdgcn_mfma_f32_16x16x32_bf16(bf[b][n], af[a][m], acc[a][b][m][n], 0, 0, 0);
        }
        pr.epi(acc, pm, pn, wr, wc, fr, fq);
    }
}

struct GPb {
    const u16* A; long lda; const u16* Bt; long ldb; int Kd; int tm0, ntm, ntn;
    __device__ int num_units() const { return ntm * ntn; }
    __device__ bool unit(int u, int& pm, int& pn) const { pm = tm0 + u / ntn; pn = u % ntn; return true; }
    __device__ const u16* a_row(int pm, int r) const { return A + (size_t)(pm * 256 + r) * lda; }
    __device__ const u16* b_row(int pm, int pn, int r) const { return Bt + (size_t)(pn * 256 + r) * ldb; }
    __device__ int K() const { return Kd; }
};
struct PrStore : GPb { u16* O; long ldo; int act; int pad_;
    __device__ void epi(Acc& acc, int pm, int pn, int wr, int wc, int fr, int fq) const {
#pragma unroll
        for (int a = 0; a < 2; ++a)
#pragma unroll
            for (int m = 0; m < 4; ++m) { const size_t row = (size_t)pm * 256 + a * 128 + wr * 64 + m * 16 + fr;
#pragma unroll
                for (int b = 0; b < 2; ++b) { const int col = pn * 256 + b * 128 + wc * 32 + fq * 8; f32x4 v0 = acc[a][b][m][0], v1 = acc[a][b][m][1];
                    if (act == 1) {
#pragma unroll
                        for (int j = 0; j < 4; ++j) { v0[j] = sigm(v0[j]); v1[j] = sigm(v1[j]); } }
                    u32x4 w; w.x = pk2(v0[0], v0[1]); w.y = pk2(v0[2], v0[3]); w.z = pk2(v1[0], v1[1]); w.w = pk2(v1[2], v1[3]);
                    *(u32x4*)(O + row * ldo + col) = w; } }
    }
};
struct PrBranch : GPb { const u16* g; float* ACC; u16* accb; int mi; int pad_;
    __device__ void epi(Acc& acc, int pm, int pn, int wr, int wc, int fr, int fq) const {
#pragma unroll
        for (int a = 0; a < 2; ++a)
#pragma unroll
            for (int m = 0; m < 4; ++m) { const size_t row = (size_t)pm * 256 + a * 128 + wr * 64 + m * 16 + fr;
#pragma unroll
                for (int b = 0; b < 2; ++b) { const int col = pn * 256 + b * 128 + wc * 32 + fq * 8;
                    const u32x4 gw = *(const u32x4*)(g + row * 1024 + col);
                    float gv[8]; gv[0] = __uint_as_float(gw.x << 16); gv[1] = __uint_as_float(gw.x & 0xffff0000u); gv[2] = __uint_as_float(gw.y << 16); gv[3] = __uint_as_float(gw.y & 0xffff0000u);
                    gv[4] = __uint_as_float(gw.z << 16); gv[5] = __uint_as_float(gw.z & 0xffff0000u); gv[6] = __uint_as_float(gw.w << 16); gv[7] = __uint_as_float(gw.w & 0xffff0000u);
                    float* ap = ACC + row * 1024 + col;
                    f32x4 o0, o1;
                    if (mi == 0) { o0 = (f32x4){0.f, 0.f, 0.f, 0.f}; o1 = o0; } else { o0 = *(f32x4*)ap; o1 = *(f32x4*)(ap + 4); }
#pragma unroll
                    for (int j = 0; j < 4; ++j) { o0[j] += gv[j] * acc[a][b][m][0][j]; o1[j] += gv[4 + j] * acc[a][b][m][1][j]; }
                    if (mi == 3) { u32x4 w; w.x = pk2(o0[0], o0[1]); w.y = pk2(o0[2], o0[3]); w.z = pk2(o1[0], o1[1]); w.w = pk2(o1[2], o1[3]); *(u32x4*)(accb + row * 1024 + col) = w; }
                    else { *(f32x4*)ap = o0; *(f32x4*)(ap + 4) = o1; } } }
    }
};
struct PrResid : GPb { const float* oc; const float* ol; float* nc; float* nl; const float* mod; int goff; int pad_;
    __device__ void epi(Acc& acc, int pm, int pn, int wr, int wc, int fr, int fq) const {
        const float* gt = mod + (size_t)mrow_of(pm * 256) * 6144 + goff;
#pragma unroll
        for (int a = 0; a < 2; ++a)
#pragma unroll
            for (int m = 0; m < 4; ++m) { const int row = pm * 256 + a * 128 + wr * 64 + m * 16 + fr;
                const float* op = row < RC ? oc + (size_t)row * 1024 : ol + (size_t)(row - RC) * 1024;
                float* np = row < RC ? nc + (size_t)row * 1024 : nl + (size_t)(row - RC) * 1024;
#pragma unroll
                for (int b = 0; b < 2; ++b) { const int col = pn * 256 + b * 128 + wc * 32 + fq * 8;
#pragma unroll
                    for (int n = 0; n < 2; ++n) { const f32x4 o = *(const f32x4*)(op + col + 4 * n), gg = *(const f32x4*)(gt + col + 4 * n); f32x4 r;
#pragma unroll
                        for (int j = 0; j < 4; ++j) r[j] = o[j] + gg[j] * acc[a][b][m][n][j];
                        *(f32x4*)(np + col + 4 * n) = r; } } }
    }
};
struct PrSwiglu : GPb { u16* G; long ldg;
    __device__ void epi(Acc& acc, int pm, int pn, int wr, int wc, int fr, int fq) const {
#pragma unroll
        for (int a = 0; a < 2; ++a)
#pragma unroll
            for (int m = 0; m < 4; ++m) { const size_t row = (size_t)pm * 256 + a * 128 + wr * 64 + m * 16 + fr; const int col = pn * 128 + wc * 32 + fq * 8;
                float o[8];
#pragma unroll
                for (int n = 0; n < 2; ++n)
#pragma unroll
                    for (int j = 0; j < 4; ++j) { const float x = acc[a][0][m][n][j]; o[n * 4 + j] = x / (1.f + expf(-x)) * acc[a][1][m][n][j]; }
                u32x4 w; w.x = pk2(o[0], o[1]); w.y = pk2(o[2], o[3]); w.z = pk2(o[4], o[5]); w.w = pk2(o[6], o[7]);
                *(u32x4*)(G + row * ldg + col) = w; }
    }
};
struct PrGlu : GPb { const u16* ya; const float* gb; u16* O;
    __device__ void epi(Acc& acc, int pm, int pn, int wr, int wc, int fr, int fq) const {
#pragma unroll
        for (int a = 0; a < 2; ++a)
#pragma unroll
            for (int m = 0; m < 4; ++m) { const size_t row = (size_t)pm * 256 + a * 128 + wr * 64 + m * 16 + fr;
#pragma unroll
                for (int b = 0; b < 2; ++b) { const int col = pn * 256 + b * 128 + wc * 32 + fq * 8;
                    const u32x4 yw = *(const u32x4*)(ya + row * 512 + col);
                    float yv[8]; yv[0] = __uint_as_float(yw.x << 16); yv[1] = __uint_as_float(yw.x & 0xffff0000u); yv[2] = __uint_as_float(yw.y << 16); yv[3] = __uint_as_float(yw.y & 0xffff0000u);
                    yv[4] = __uint_as_float(yw.z << 16); yv[5] = __uint_as_float(yw.z & 0xffff0000u); yv[6] = __uint_as_float(yw.w << 16); yv[7] = __uint_as_float(yw.w & 0xffff0000u);
                    float o[8];
#pragma unroll
                    for (int n = 0; n < 2; ++n)
#pragma unroll
                        for (int j = 0; j < 4; ++j) o[n * 4 + j] = yv[n * 4 + j] * sigm(acc[a][b][m][n][j] + gb[col + n * 4 + j]);
                    u32x4 w; w.x = pk2(o[0], o[1]); w.y = pk2(o[2], o[3]); w.z = pk2(o[4], o[5]); w.w = pk2(o[6], o[7]);
                    *(u32x4*)(O + row * 512 + col) = w; } }
    }
};
struct PrMoeUp { const u16* h2; const int* row_tok; const int* mi; const u16* W; u16* G; int t0, nt;
    __device__ int num_units() const { return nt * 28; }
    __device__ bool unit(int u, int& pm, int& pn) const { pm = t0 + u / 28; pn = u % 28; return pm < mi[25]; }
    __device__ const u16* a_row(int pm, int r) const { const int t = row_tok[pm * 256 + r]; return t >= 0 ? h2 + (size_t)(RC + t) * 1024 : (const u16*)0; }
    __device__ const u16* b_row(int pm, int pn, int r) const { return W + ((size_t)mi[32 + pm] * 7168 + pn * 256 + r) * 1024; }
    __device__ int K() const { return 1024; }
    __device__ void epi(Acc& acc, int pm, int pn, int wr, int wc, int fr, int fq) const {
#pragma unroll
        for (int a = 0; a < 2; ++a)
#pragma unroll
            for (int m = 0; m < 4; ++m) { const size_t row = (size_t)(pm - t0) * 256 + a * 128 + wr * 64 + m * 16 + fr; const int col = pn * 128 + wc * 32 + fq * 8;
                float o[8];
#pragma unroll
                for (int n = 0; n < 2; ++n)
#pragma unroll
                    for (int j = 0; j < 4; ++j) { const float x = acc[a][0][m][n][j]; o[n * 4 + j] = x / (1.f + expf(-x)) * acc[a][1][m][n][j]; }
                u32x4 w; w.x = pk2(o[0], o[1]); w.y = pk2(o[2], o[3]); w.z = pk2(o[4], o[5]); w.w = pk2(o[6], o[7]);
                *(u32x4*)(G + row * 3584 + col) = w; }
    }
};
struct PrMoeDown { const u16* G; const int* mi; const u16* W; u16* yb; int t0, nt;
    __device__ int num_units() const { return nt * 4; }
    __device__ bool unit(int u, int& pm, int& pn) const { pm = t0 + u / 4; pn = u % 4; return pm < mi[25]; }
    __device__ const u16* a_row(int pm, int r) const { return G + (size_t)((pm - t0) * 256 + r) * 3584; }
    __device__ const u16* b_row(int pm, int pn, int r) const { return W + ((size_t)mi[32 + pm] * 1024 + pn * 256 + r) * 3584; }
    __device__ int K() const { return 3584; }
    __device__ void epi(Acc& acc, int pm, int pn, int wr, int wc, int fr, int fq) const {
#pragma unroll
        for (int a = 0; a < 2; ++a)
#pragma unroll
            for (int m = 0; m < 4; ++m) { const size_t row = (size_t)pm * 256 + a * 128 + wr * 64 + m * 16 + fr;
#pragma unroll
                for (int b = 0; b < 2; ++b) { const int col = pn * 256 + b * 128 + wc * 32 + fq * 8; const f32x4 v0 = acc[a][b][m][0], v1 = acc[a][b][m][1];
                    u32x4 w; w.x = pk2(v0[0], v0[1]); w.y = pk2(v0[2], v0[3]); w.z = pk2(v1[0], v1[1]); w.w = pk2(v1[2], v1[3]);
                    *(u32x4*)(yb + row * 1024 + col) = w; } }
    }
};
template <class Pr> __global__ void __launch_bounds__(NT) k_gemm(Pr pr) { extern __shared__ __attribute__((aligned(16))) char smem[]; gemm_v1(pr, smem); }

__device__ __forceinline__ void seq_of(int row, int& base, int& t, int& L) {
    if (row < RC) { t = row & 255; L = 256; } else { t = (row - RC) & 2047; L = 2048; }
    base = row - t;
}
__global__ void __launch_bounds__(NT) k_hy_pre(P p, int l, int r0, const u16* ph, float* ub) {
    const int c = threadIdx.x;
    const float* cw = p.in[I_hy_conv_w] + l * 3 * 1536; const float* cb = p.in[I_hy_conv_b] + l * 1536;
    for (int row = r0 + blockIdx.x; row < MT; row += gridDim.x) {
        int base, t, L; seq_of(row, base, t, L);
        float r[3];
#pragma unroll
        for (int j = 0; j < 3; ++j) { const int col = j * 512 + c;
            const float pc = bf2f(ph[(size_t)row * 1536 + col]), pm = t > 0 ? bf2f(ph[(size_t)(row - 1) * 1536 + col]) : 0.f, pp = t < L - 1 ? bf2f(ph[(size_t)(row + 1) * 1536 + col]) : 0.f;
            r[j] = pm * cw[col] + pc * cw[1536 + col] + pp * cw[3072 + col] + cb[col]; }
        p.y[(size_t)row * 512 + c] = f2bf(r[0]);
        ub[(size_t)row * 512 + c] = r[2] * r[1];
    }
}
__global__ void __launch_bounds__(NT) k_hy_conv(P p, int l, int r0, const float* ub) {
    const int c = threadIdx.x;
    const float bias = p.in[I_hy_bias][l * 512 + c];
    for (int row = r0 + blockIdx.x; row < MT; row += gridDim.x) {
        int base, t, L; seq_of(row, base, t, L);
        const float* f = p.filt + ((size_t)l * 2304 + (L == 256 ? 0 : 256)) * 1024;
        float acc = 0.f;
        for (int s = 0; s <= t; ++s) acc += f[(size_t)(t - s) * 1024 + c] * ub[(size_t)(base + s) * 512 + c];
        for (int s = t + 1; s < L; ++s) acc += f[(size_t)(s - t) * 1024 + 512 + c] * ub[(size_t)(base + s) * 512 + c];
        acc += bias * ub[(size_t)row * 512 + c];
        u16* yp = p.y + (size_t)row * 512 + c;
        *yp = f2bf(bf2f(*yp) * acc);
    }
}

__global__ void __launch_bounds__(NT) k_rw_scan(P p, int l, const u16* pr, float* ob, float* bon) {
    extern __shared__ __attribute__((aligned(16))) char smem[];
    if (threadIdx.x >= 64) return;
    const int i = threadIdx.x;
    float* Wu = (float*)smem; float* Au = Wu + 4096; float* tw = Au + 4096; float* adv = tw + 64; float* kkv = adv + 64; float* wv = kkv + 64; float* bv = wv + 64; float* kdv = bv + 64; float* rv = kdv + 64;
    for (int sid = blockIdx.x; sid < 256; sid += gridDim.x) {
        const int b = sid >> 4, h = (sid >> 1) & 7, d = sid & 1, hc = h * 64 + i;
        for (int m = 0; m < 64; ++m) { Wu[m * 64 + i] = p.in[I_rw_w_up][((size_t)(l * 2 + d) * 64 + m) * 512 + hc]; Au[m * 64 + i] = p.in[I_rw_a_up][((size_t)(l * 2 + d) * 64 + m) * 512 + hc]; }
        const float w0 = p.in[I_rw_w0][(l * 2 + d) * 512 + hc], a0 = p.in[I_rw_a0][(l * 2 + d) * 512 + hc], k_k = p.in[I_rw_k_k][l * 512 + hc], k_a = p.in[I_rw_k_a][l * 512 + hc], r_k = p.in[I_rw_r_k][l * 512 + hc];
        const int cols[5] = {hc, 512 + hc, 1024 + hc, 1536 + d * 64 + i, 1664 + d * 64 + i};
        float mu0[5], mu1[5];
#pragma unroll
        for (int j = 0; j < 5; ++j) { mu0[j] = p.in[I_rw_mu][(l * 2 + 0) * 1920 + cols[j]]; mu1[j] = p.in[I_rw_mu][(l * 2 + 1) * 1920 + cols[j]]; }
        float S[64];
#pragma unroll
        for (int k = 0; k < 64; ++k) S[k] = 0.f;
        for (int seg = 0; seg < 2; ++seg) {
            const int L = seg ? 2048 : 256, base = seg ? RC + b * 2048 : b * 256;
            for (int st = 0; st < L; ++st) {
                const int t = d ? L - 1 - st : st; const size_t row = (size_t)base + t;
                float x[5];
#pragma unroll
                for (int j = 0; j < 5; ++j) { const float pc = bf2f(pr[row * 2048 + cols[j]]), pm = t > 0 ? bf2f(pr[(row - 1) * 2048 + cols[j]]) : 0.f, pp = t < L - 1 ? bf2f(pr[(row + 1) * 2048 + cols[j]]) : 0.f;
                    x[j] = pc + mu0[j] * (pm - pc) + mu1[j] * (pp - pc); }
                const float r_i = x[0], k_i = x[1], v_i = x[2];
                LDSWAIT();
                tw[i] = tanhf(x[3]); adv[i] = x[4];
                const float kraw = k_i * k_k; const float nrm = sqrtf(wsum(kraw * kraw)); const float kk_i = kraw / fmaxf(nrm, 1e-12f);
                LDSWAIT();
                float wa = 0.f, aa = 0.f;
                for (int m = 0; m < 64; ++m) { wa += tw[m] * Wu[m * 64 + i]; aa += adv[m] * Au[m * 64 + i]; }
                const float w_i = expf(-0.606531f * sigm(w0 + wa)), a_i = sigm(a0 + aa);
                const float kd_i = k_i * (1.f + (a_i - 1.f) * k_a);
                const float bs = wsum(r_i * kd_i * r_k);
                if (i == 0) bon[((size_t)d * MT + row) * 8 + h] = bs;
                kkv[i] = kk_i; wv[i] = w_i; bv[i] = kk_i * a_i; kdv[i] = kd_i; rv[i] = r_i;
                LDSWAIT();
                float sa = 0.f;
#pragma unroll
                for (int k = 0; k < 64; ++k) sa += S[k] * kkv[k];
                float o = 0.f;
#pragma unroll
                for (int k = 0; k < 64; ++k) { S[k] = S[k] * wv[k] - sa * bv[k] + v_i * kdv[k]; o += S[k] * rv[k]; }
                ob[((size_t)d * MT + row) * 512 + hc] = o;
            }
        }
    }
}
__global__ void __launch_bounds__(NT) k_rw_out(P p, int l, int r0, const u16* pr, const float* ob, const float* bon) {
    __shared__ float sg[128];
    const int c = threadIdx.x, h = c >> 6;
    const float* mu = p.in[I_rw_mu] + (size_t)l * 2 * 1920;
    for (int row = r0 + blockIdx.x; row < MT; row += gridDim.x) {
        int base, t, L; seq_of(row, base, t, L);
        __syncthreads();
        if (c < 128) { const int col = 1792 + c; const float pc = bf2f(pr[(size_t)row * 2048 + col]), pm = t > 0 ? bf2f(pr[(size_t)(row - 1) * 2048 + col]) : 0.f, pp = t < L - 1 ? bf2f(pr[(size_t)(row + 1) * 2048 + col]) : 0.f;
            sg[c] = sigm(pc + mu[col] * (pm - pc) + mu[1920 + col] * (pp - pc)); }
        __syncthreads();
        float g = 0.f;
        for (int m = 0; m < 128; ++m) g += sg[m] * p.in[I_rw_g_up][((size_t)l * 128 + m) * 512 + c];
        const int col = 1024 + c; const float pc = bf2f(pr[(size_t)row * 2048 + col]), pm = t > 0 ? bf2f(pr[(size_t)(row - 1) * 2048 + col]) : 0.f, pp = t < L - 1 ? bf2f(pr[(size_t)(row + 1) * 2048 + col]) : 0.f;
        const float v = pc + mu[col] * (pm - pc) + mu[1920 + col] * (pp - pc);
        const float o = ob[(size_t)row * 512 + c] + ob[((size_t)MT + row) * 512 + c];
        const float mean = wsum(o) * (1.f / 64.f); const float dlt = o - mean; const float var = wsum(dlt * dlt) * (1.f / 64.f);
        const float on = dlt * rsqrtf(var + 64e-5f) * p.in[I_rw_ln_g][l * 512 + c] + p.in[I_rw_ln_b][l * 512 + c];
        const float bonus = (bon[(size_t)row * 8 + h] + bon[((size_t)MT + row) * 8 + h]) * v;
        p.y[((size_t)MT + row) * 512 + c] = f2bf((on + bonus) * g);
    }
}

__global__ void __launch_bounds__(NT) k_s5_scan(P p, int l, const u16* ps, float* ys) {
    extern __shared__ __attribute__((aligned(16))) char smem[];
    const int wid = threadIdx.x >> 6, n = threadIdx.x & 63;
    float* part = (float*)smem + wid * (16 * 65);
    for (int sid = blockIdx.x + wid * gridDim.x; sid < 1024; sid += gridDim.x * 8) {
        const int b = sid >> 6, g = (sid >> 1) & 31, d = sid & 1;
        const float dt = expf(p.in[I_s5_log_dt][(l * 2 + d) * 32 + g]);
        const float are = p.in[I_s5_a_re][((l * 2 + d) * 32 + g) * 64 + n], aim = p.in[I_s5_a_im][((l * 2 + d) * 32 + g) * 64 + n];
        const float mag = expf(are * dt), ang = aim * dt, abr = mag * cosf(ang), abi = mag * sinf(ang);
        const float nr = abr - 1.f, ni = abi, den = are * are + aim * aim, fre = (nr * are + ni * aim) / den, fim = (ni * are - nr * aim) / den;
        float Br[16], Bi[16], Cr[16], Ci[16];
#pragma unroll
        for (int q = 0; q < 16; ++q) { const float br = p.in[I_s5_b_re][((size_t)(l * 32 + g) * 64 + n) * 16 + q], bi = p.in[I_s5_b_im][((size_t)(l * 32 + g) * 64 + n) * 16 + q];
            Br[q] = fre * br - fim * bi; Bi[q] = fre * bi + fim * br;
            Cr[q] = p.in[I_s5_c_re][((size_t)(l * 32 + g) * 16 + q) * 64 + n]; Ci[q] = p.in[I_s5_c_im][((size_t)(l * 32 + g) * 16 + q) * 64 + n]; }
        float hr = 0.f, hi = 0.f;
        for (int seg = 0; seg < 2; ++seg) {
            const int L = seg ? 2048 : 256, base = seg ? RC + b * 2048 : b * 256;
            for (int st = 0; st < L; ++st) {
                const int t = d ? L - 1 - st : st; const size_t row = (size_t)base + t;
                const u32x4 u0 = *(const u32x4*)(ps + row * 512 + g * 16), u1 = *(const u32x4*)(ps + row * 512 + g * 16 + 8);
                float uu[16];
                uu[0] = __uint_as_float(u0.x << 16); uu[1] = __uint_as_float(u0.x & 0xffff0000u); uu[2] = __uint_as_float(u0.y << 16); uu[3] = __uint_as_float(u0.y & 0xffff0000u);
                uu[4] = __uint_as_float(u0.z << 16); uu[5] = __uint_as_float(u0.z & 0xffff0000u); uu[6] = __uint_as_float(u0.w << 16); uu[7] = __uint_as_float(u0.w & 0xffff0000u);
                uu[8] = __uint_as_float(u1.x << 16); uu[9] = __uint_as_float(u1.x & 0xffff0000u); uu[10] = __uint_as_float(u1.y << 16); uu[11] = __uint_as_float(u1.y & 0xffff0000u);
                uu[12] = __uint_as_float(u1.z << 16); uu[13] = __uint_as_float(u1.z & 0xffff0000u); uu[14] = __uint_as_float(u1.w << 16); uu[15] = __uint_as_float(u1.w & 0xffff0000u);
                float xr = 0.f, xi = 0.f;
#pragma unroll
                for (int q = 0; q < 16; ++q) { xr += Br[q] * uu[q]; xi += Bi[q] * uu[q]; }
                const float nhr = abr * hr - abi * hi + xr, nhi = abr * hi + abi * hr + xi; hr = nhr; hi = nhi;
                LDSWAIT();
#pragma unroll
                for (int q = 0; q < 16; ++q) part[q * 65 + n] = Cr[q] * hr - Ci[q] * hi;
                LDSWAIT();
                const int q = n & 15, qq = n >> 4; float s = 0.f;
#pragma unroll
                for (int j = 0; j < 16; ++j) s += part[q * 65 + qq * 16 + j];
                s += __shfl_xor(s, 16, 64); s += __shfl_xor(s, 32, 64);
                if (qq == 0) ys[((size_t)d * MT + row) * 512 + g * 16 + q] = s;
            }
        }
    }
}
__global__ void __launch_bounds__(NT) k_s5_act(P p, int l, int r0, const u16* ps, const float* ys, u16* ya) {
    const int c = threadIdx.x; const float dsk = p.in[I_s5_d][l * 512 + c];
    for (int row = r0 + blockIdx.x; row < MT; row += gridDim.x) {
        const float x = ys[(size_t)row * 512 + c] + ys[((size_t)MT + row) * 512 + c] + dsk * bf2f(ps[(size_t)row * 512 + c]);
        const float gl = 0.5f * x * (1.f + tanhf(0.7978845608028654f * (x + 0.044715f * x * x * x)));
        ya[(size_t)row * 512 + c] = f2bf(gl);
    }
}

__global__ void __launch_bounds__(NT) k_gla_scan(P p, int l, const u16* pg, float* og) {
    __shared__ float qv[64], kv[64], al[64], part[4][128];
    const int tid = threadIdx.x, e = tid & 127, dq = tid >> 7;
    for (int sid = blockIdx.x; sid < 128; sid += gridDim.x) {
        const int b = sid >> 3, h = (sid >> 1) & 3, d = sid & 1;
        float gu[16], gb = 0.f;
        if (tid < 64) { for (int m = 0; m < 16; ++m) gu[m] = p.in[I_gla_gate_up][((size_t)(l * 2 + d) * 16 + m) * 256 + h * 64 + tid]; gb = p.in[I_gla_gate_b][(l * 2 + d) * 256 + h * 64 + tid]; }
        float S[16];
#pragma unroll
        for (int k = 0; k < 16; ++k) S[k] = 0.f;
        for (int seg = 0; seg < 2; ++seg) {
            const int L = seg ? 2048 : 256, base = seg ? RC + b * 2048 : b * 256;
            for (int st = 0; st < L; ++st) {
                const int j = d ? L - 1 - st : st; const int t = seg ? ((j & 31) * 64 + (j >> 5)) : j; const size_t row = (size_t)base + t;
                if (tid < 64) {
                    float lg = gb;
#pragma unroll
                    for (int m = 0; m < 16; ++m) lg += bf2f(pg[row * 1792 + 1536 + d * 16 + m]) * gu[m];
                    const float ls = fminf(lg, 0.f) - log1pf(expf(-fabsf(lg)));
                    al[tid] = expf(ls * (1.f / 16.f)); kv[tid] = bf2f(pg[row * 1792 + 256 + h * 64 + tid]); qv[tid] = bf2f(pg[row * 1792 + h * 64 + tid]) * 0.125f;
                }
                const float ve = bf2f(pg[row * 1792 + 512 + h * 128 + e]);
                __syncthreads();
                float po = 0.f;
#pragma unroll
                for (int k = 0; k < 16; ++k) { const int di = dq * 16 + k; S[k] = al[di] * S[k] + kv[di] * ve; po += qv[di] * S[k]; }
                part[dq][e] = po;
                __syncthreads();
                if (tid < 128) og[((size_t)d * MT + row) * 512 + h * 128 + e] = part[0][e] + part[1][e] + part[2][e] + part[3][e];
            }
        }
    }
}
__global__ void __launch_bounds__(NT) k_gla_out(P p, int l, int r0, const u16* pg, const float* og) {
    __shared__ float ws[8];
    const int c = threadIdx.x, wid = c >> 6, lane = c & 63;
    for (int row = r0 + blockIdx.x; row < MT; row += gridDim.x) {
        const float o = og[(size_t)row * 512 + c] + og[((size_t)MT + row) * 512 + c];
        const float s = wsum(o * o);
        __syncthreads();
        if (lane == 0) ws[wid] = s;
        __syncthreads();
        const float tot = ws[(wid & ~1)] + ws[(wid | 1)];
        const float on = o * rsqrtf(tot * (1.f / 128.f) + 1e-6f) * p.in[I_gla_norm_g][l * 128 + (c & 127)];
        const float gg = bf2f(pg[(size_t)row * 1792 + 1024 + c]);
        p.y[((size_t)3 * MT + row) * 512 + c] = f2bf(on * gg / (1.f + expf(-gg)));
    }
}

__global__ void k_moe_init(P p) {
    const int i = blockIdx.x * blockDim.x + threadIdx.x;
    if (i < 512) p.moe_i[i] = 0;
    for (int j = i; j < 67584; j += gridDim.x * blockDim.x) p.row_tok[j] = -1;
}
__global__ void k_moe_plan(P p) {
    if (threadIdx.x == 0 && blockIdx.x == 0) {
        int ps = 0, nt = 0;
        for (int e = 0; e < 8; ++e) { const int c = p.moe_i[e]; const int tl = (c + 255) / 256; p.moe_i[16 + e] = ps; for (int j = 0; j < tl; ++j) p.moe_i[32 + nt + j] = e; nt += tl; ps += tl * 256; p.moe_i[8 + e] = 0; }
        p.moe_i[24] = ps; p.moe_i[25] = nt;
    }
}
__global__ void k_moe_slot(P p) {
    const int a = blockIdx.x * blockDim.x + threadIdx.x;
    if (a < 65536) { const int e = p.top_i[a]; const int s = atomicAdd(&p.moe_i[8 + e], 1); const int dst = p.moe_i[16 + e] + s; p.row_tok[dst] = a >> 1; p.dest_of[a] = dst; }
}
__global__ void __launch_bounds__(NT) k_final(P p) {
    const int wid = threadIdx.x >> 6, lane = threadIdx.x & 63;
    const float* g = p.in[I_final_norm_g];
    for (int tok = blockIdx.x * 8 + wid; tok < 32768; tok += gridDim.x * 8) {
        const float* gt = p.mod + (size_t)(17 + (tok >> 11)) * 6144 + 5120;
        const int d0 = p.dest_of[tok * 2], d1 = p.dest_of[tok * 2 + 1]; const float g0 = p.top_g[tok * 2], g1 = p.top_g[tok * 2 + 1];
        float* hp = p.out + (size_t)tok * 1024;
        f32x4 v[4]; float ss = 0.f;
#pragma unroll
        for (int i = 0; i < 4; ++i) { const int k = i * 256 + lane * 4;
            const u32x2 a = *(const u32x2*)(p.yb + (size_t)d0 * 1024 + k), b = *(const u32x2*)(p.yb + (size_t)d1 * 1024 + k);
            const f32x4 hh = *(const f32x4*)(hp + k), gg = *(const f32x4*)(gt + k);
            float ya[4] = {__uint_as_float(a.x << 16), __uint_as_float(a.x & 0xffff0000u), __uint_as_float(a.y << 16), __uint_as_float(a.y & 0xffff0000u)};
            float yc[4] = {__uint_as_float(b.x << 16), __uint_as_float(b.x & 0xffff0000u), __uint_as_float(b.y << 16), __uint_as_float(b.y & 0xffff0000u)};
#pragma unroll
            for (int j = 0; j < 4; ++j) { v[i][j] = hh[j] + gg[j] * (g0 * ya[j] + g1 * yc[j]); ss += v[i][j] * v[i][j]; } }
        ss = wsum(ss); const float rs = rsqrtf(ss * (1.f / 1024.f) + 1e-6f);
#pragma unroll
        for (int i = 0; i < 4; ++i) { const int k = i * 256 + lane * 4; const f32x4 gg = *(const f32x4*)(g + k); f32x4 o;
#pragma unroll
            for (int j = 0; j < 4; ++j) o[j] = v[i][j] * rs * gg[j];
            *(f32x4*)(hp + k) = o; }
    }
}

static inline size_t al256(size_t x) { return (x + 255) & ~(size_t)255; }
template <class Pr> static void launch_gemm(const Pr& pr, int grid, hipStream_t st) {
    hipFuncSetAttribute((const void*)k_gemm<Pr>, hipFuncAttributeMaxDynamicSharedMemorySize, LDS_BYTES);
    k_gemm<Pr><<<grid, NT, LDS_BYTES, st>>>(pr);
}
static GPb mkg(const u16* A, long lda, const u16* Bt, long ldb, int K, int tm0, int ntm, int ntn) { GPb g; g.A = A; g.lda = lda; g.Bt = Bt; g.ldb = ldb; g.Kd = K; g.tm0 = tm0; g.ntm = ntm; g.ntn = ntn; return g; }

extern "C" void kernel_launch(void* const* d_in, const int* in_sizes, int n_in, void* d_out, int out_size, void* d_ws, size_t ws_size, hipStream_t stream) {
    P p; memset(&p, 0, sizeof(p));
    for (int i = 0; i < N_IN; ++i) p.in[i] = (const float*)d_in[i];
    p.out = (float*)d_out;
    char* ws = (char*)d_ws; size_t o = 0;
    auto take = [&](size_t bytes) { char* r = ws + o; o = al256(o + bytes); return r; };
    take(16384);
    p.mod = (float*)take((size_t)2 * 17 * 6144 * 4);
    p.filt = (float*)take((size_t)2 * 2304 * 1024 * 4);
    p.moe_i = (int*)take(4096);
    p.row_tok = (int*)take((size_t)67584 * 4);
    p.dest_of = (int*)take((size_t)65536 * 4);
    p.top_i = (int*)take((size_t)65536 * 4);
    p.top_g = (float*)take((size_t)65536 * 4);
    p.wt_in = (u16*)take((size_t)2 * 9984 * 1024 * 2);
    p.wt_br = (u16*)take((size_t)2 * 4 * 1024 * 512 * 2);
    p.wt_out = (u16*)take((size_t)2 * 1024 * 1024 * 2);
    p.wt_f13 = (u16*)take((size_t)5632 * 1024 * 2);
    p.wt_f2 = (u16*)take((size_t)1024 * 2816 * 2);
    p.wt_glu = (u16*)take((size_t)2 * 512 * 512 * 2);
    p.hctx = (float*)take((size_t)RC * 1024 * 4);
    p.hn = (u16*)take((size_t)MT * 1024 * 2);
    const size_t off_y = o;
    p.y = (u16*)take((size_t)4 * MT * 512 * 2);
    p.arena = ws + o;
    const size_t arena_need = (size_t)MT * 2048 * 2 + (size_t)2 * MT * 512 * 4 + (size_t)2 * MT * 8 * 4 + 4096;
    size_t mo = off_y;
    p.wt_m13 = (u16*)(ws + mo); mo = al256(mo + (size_t)8 * 7168 * 1024 * 2);
    p.wt_m2 = (u16*)(ws + mo); mo = al256(mo + (size_t)8 * 1024 * 3584 * 2);
    p.yb = (u16*)(ws + mo); mo = al256(mo + (size_t)67584 * 1024 * 2);
    p.gch = (u16*)(ws + mo); mo = al256(mo + (size_t)66 * 256 * 3584 * 2);
    if (o + arena_need > ws_size || mo > ws_size) return;
    const int G = 256;
    hipFuncSetAttribute((const void*)k_mod, hipFuncAttributeMaxDynamicSharedMemorySize, LDS_BYTES);
    hipFuncSetAttribute((const void*)k_rw_scan, hipFuncAttributeMaxDynamicSharedMemorySize, LDS_BYTES);
    hipFuncSetAttribute((const void*)k_s5_scan, hipFuncAttributeMaxDynamicSharedMemorySize, LDS_BYTES);

    k_mod<<<24, NT, LDS_BYTES, stream>>>(p);
    k_filt<<<1024, NT, 0, stream>>>(p);
    hipMemsetAsync(p.wt_in, 0, (size_t)2 * 9984 * 1024 * 2, stream);
    const int BIG = 1 << 30;
    for (int l = 0; l < 2; ++l) {
        const float* wi = p.in[I_w_in] + (size_t)l * 1024 * 9632; u16* wt = p.wt_in + (size_t)l * 9984 * 1024;
        k_transpose<<<G, NT, 0, stream>>>(wi + 0, 1024, 1536, 9632, wt, BIG, 0, 0);
        k_transpose<<<G, NT, 0, stream>>>(wi + 1536, 1024, 1920, 9632, wt, BIG, 0, 1536);
        k_transpose<<<G, NT, 0, stream>>>(wi + 3456, 1024, 512, 9632, wt, BIG, 0, 3584);
        k_transpose<<<G, NT, 0, stream>>>(wi + 3968, 1024, 1568, 9632, wt, BIG, 0, 4096);
        k_transpose<<<G, NT, 0, stream>>>(wi + 5536, 1024, 4096, 9632, wt, BIG, 0, 5888);
        for (int m = 0; m < 4; ++m) k_transpose<<<G, NT, 0, stream>>>(p.in[I_w_branch] + (size_t)(l * 4 + m) * 512 * 1024, 512, 1024, 1024, p.wt_br + (size_t)(l * 4 + m) * 1024 * 512, BIG, 0, 0);
        k_transpose<<<G, NT, 0, stream>>>(p.in[I_w_out] + (size_t)l * 1024 * 1024, 1024, 1024, 1024, p.wt_out + (size_t)l * 1024 * 1024, BIG, 0, 0);
        k_transpose<<<G, NT, 0, stream>>>(p.in[I_s5_glu_w] + (size_t)l * 512 * 512, 512, 512, 512, p.wt_glu + (size_t)l * 512 * 512, BIG, 0, 0);
    }
    k_transpose<<<G, NT, 0, stream>>>(p.in[I_ffn_w1], 1024, 2816, 2816, p.wt_f13, 128, 256, 0);
    k_transpose<<<G, NT, 0, stream>>>(p.in[I_ffn_w3], 1024, 2816, 2816, p.wt_f13, 128, 256, 128);
    k_transpose<<<G, NT, 0, stream>>>(p.in[I_ffn_w2], 2816, 1024, 1024, p.wt_f2, BIG, 0, 0);

    for (int l = 0; l < 2; ++l) {
        const int first = (l == 0), last = (l == 1);
        const float* modl = p.mod + (size_t)l * 17 * 6144;
        const u16* wt = p.wt_in + (size_t)l * 9984 * 1024;
        const int tmL = last ? 16 : 0, ntmL = last ? 128 : 144, r0L = last ? RC : 0;
        k_norm<<<1024, NT, 0, stream>>>(p, l, 0, 0, MT, first, 0);
        { u16* ph = (u16*)p.arena; float* ub = (float*)(p.arena + (size_t)MT * 1536 * 2);
          PrStore g; memset(&g, 0, sizeof(g)); (GPb&)g = mkg(p.hn, 1024, wt, 1024, 1024, tmL, ntmL, 6); g.O = ph; g.ldo = 1536; g.act = 0; launch_gemm(g, G, stream);
          k_hy_pre<<<2048, NT, 0, stream>>>(p, l, r0L, ph, ub);
          k_hy_conv<<<4096, NT, 0, stream>>>(p, l, r0L, ub); }
        { u16* pr = (u16*)p.arena; float* ob = (float*)(p.arena + (size_t)MT * 2048 * 2); float* bon = ob + (size_t)2 * MT * 512;
          PrStore g; memset(&g, 0, sizeof(g)); (GPb&)g = mkg(p.hn, 1024, wt + (size_t)1536 * 1024, 1024, 1024, 0, 144, 8); g.O = pr; g.ldo = 2048; g.act = 0; launch_gemm(g, G, stream);
          k_rw_scan<<<256, NT, LDS_BYTES, stream>>>(p, l, pr, ob, bon);
          k_rw_out<<<2048, NT, 0, stream>>>(p, l, r0L, pr, ob, bon); }
        { u16* ps = (u16*)p.arena; float* ys = (float*)(p.arena + (size_t)MT * 512 * 2); u16* ya = (u16*)(p.arena + (size_t)MT * 512 * 2 + (size_t)2 * MT * 512 * 4);
          PrStore g; memset(&g, 0, sizeof(g)); (GPb&)g = mkg(p.hn, 1024, wt + (size_t)3584 * 1024, 1024, 1024, 0, 144, 2); g.O = ps; g.ldo = 512; g.act = 0; launch_gemm(g, G, stream);
          k_s5_scan<<<256, NT, LDS_BYTES, stream>>>(p, l, ps, ys);
          k_s5_act<<<2048, NT, 0, stream>>>(p, l, r0L, ps, ys, ya);
          PrGlu q; memset(&q, 0, sizeof(q)); (GPb&)q = mkg(ya, 512, p.wt_glu + (size_t)l * 512 * 512, 512, 512, tmL, ntmL, 2); q.ya = ya; q.gb = p.in[I_s5_glu_b] + l * 512; q.O = p.y + (size_t)2 * MT * 512; launch_gemm(q, G, stream); }
        { u16* pg = (u16*)p.arena; float* og = (float*)(p.arena + (size_t)MT * 1792 * 2);
          PrStore g; memset(&g, 0, sizeof(g)); (GPb&)g = mkg(p.hn, 1024, wt + (size_t)4096 * 1024, 1024, 1024, 0, 144, 7); g.O = pg; g.ldo = 1792; g.act = 0; launch_gemm(g, G, stream);
          k_gla_scan<<<128, NT, 0, stream>>>(p, l, pg, og);
          k_gla_out<<<2048, NT, 0, stream>>>(p, l, r0L, pg, og); }
        { u16* gb = (u16*)p.arena; float* ACC = (float*)(p.arena + (size_t)MT * 1024 * 2); u16* accb = (u16*)(p.arena + (size_t)MT * 1024 * 2 + (size_t)MT * 1024 * 4);
          for (int m = 0; m < 4; ++m) {
              PrStore g; memset(&g, 0, sizeof(g)); (GPb&)g = mkg(p.hn, 1024, wt + (size_t)(5888 + m * 1024) * 1024, 1024, 1024, tmL, ntmL, 4); g.O = gb; g.ldo = 1024; g.act = 1; launch_gemm(g, G, stream);
              PrBranch q; memset(&q, 0, sizeof(q)); (GPb&)q = mkg(p.y + (size_t)m * MT * 512, 512, p.wt_br + (size_t)(l * 4 + m) * 1024 * 512, 512, 512, tmL, ntmL, 4); q.g = gb; q.ACC = ACC; q.accb = accb; q.mi = m; launch_gemm(q, G, stream);
          }
          PrResid r; memset(&r, 0, sizeof(r)); (GPb&)r = mkg(accb, 1024, p.wt_out + (size_t)l * 1024 * 1024, 1024, 1024, tmL, ntmL, 4);
          r.oc = first ? p.in[I_ctx] : p.hctx; r.ol = first ? p.in[I_x] : p.out; r.nc = p.hctx; r.nl = p.out; r.mod = modl; r.goff = 2048; launch_gemm(r, G, stream); }
        if (!last) {
            k_norm<<<1024, NT, 0, stream>>>(p, l, 1, 0, MT, 0, 0);
            u16* Gb = (u16*)p.arena;
            PrSwiglu s; memset(&s, 0, sizeof(s)); (GPb&)s = mkg(p.hn, 1024, p.wt_f13, 1024, 1024, 0, 144, 22); s.G = Gb; s.ldg = 2816; launch_gemm(s, G, stream);
            PrResid r; memset(&r, 0, sizeof(r)); (GPb&)r = mkg(Gb, 2816, p.wt_f2, 2816, 2816, 0, 144, 4); r.oc = p.hctx; r.ol = p.out; r.nc = p.hctx; r.nl = p.out; r.mod = modl; r.goff = 5120; launch_gemm(r, G, stream);
        } else {
            for (int e = 0; e < 8; ++e) {
                k_transpose<<<G, NT, 0, stream>>>(p.in[I_moe_w1] + (size_t)e * 1024 * 3584, 1024, 3584, 3584, p.wt_m13 + (size_t)e * 7168 * 1024, 128, 256, 0);
                k_transpose<<<G, NT, 0, stream>>>(p.in[I_moe_w3] + (size_t)e * 1024 * 3584, 1024, 3584, 3584, p.wt_m13 + (size_t)e * 7168 * 1024, 128, 256, 128);
                k_transpose<<<G, NT, 0, stream>>>(p.in[I_moe_w2] + (size_t)e * 3584 * 1024, 3584, 1024, 1024, p.wt_m2 + (size_t)e * 1024 * 3584, BIG, 0, 0);
            }
            k_moe_init<<<64, 256, 0, stream>>>(p);
            k_norm<<<1024, NT, 0, stream>>>(p, l, 1, RC, MT, 0, 1);
            k_moe_plan<<<1, 64, 0, stream>>>(p);
            k_moe_slot<<<256, 256, 0, stream>>>(p);
            for (int ch = 0; ch < 4; ++ch) {
                PrMoeUp u; memset(&u, 0, sizeof(u)); u.h2 = p.hn; u.row_tok = p.row_tok; u.mi = p.moe_i; u.W = p.wt_m13; u.G = p.gch; u.t0 = ch * 66; u.nt = 66; launch_gemm(u, G, stream);
                PrMoeDown dn; memset(&dn, 0, sizeof(dn)); dn.G = p.gch; dn.mi = p.moe_i; dn.W = p.wt_m2; dn.yb = p.yb; dn.t0 = ch * 66; dn.nt = 66; launch_gemm(dn, G, stream);
            }
            k_final<<<1024, NT, 0, stream>>>(p);
        }
    }
}
```

```cpp
#define REPMASK 0
#define FP8IN_LAST 0
#define RWREP 0
#include <hip/hip_runtime.h>
#include <stdint.h>
#include <string.h>

typedef unsigned short u16;
typedef short bf16x8 __attribute__((ext_vector_type(8)));
typedef float f32x4 __attribute__((ext_vector_type(4)));
typedef unsigned u32x4 __attribute__((ext_vector_type(4)));
typedef unsigned u32x2 __attribute__((ext_vector_type(2)));

#define NT 512
#define MT 36864
#define RC 4096
#define LDS_BYTES 155648
#define SM_OFF 128

enum { I_x, I_c, I_ctx, I_c_ctx, I_ada_w, I_ada_b, I_norm_mix_g, I_norm_ffn_g, I_w_in, I_hy_conv_w, I_hy_conv_b, I_hy_f_w1, I_hy_f_b1, I_hy_f_w2, I_hy_f_b2,
       I_hy_f_w3, I_hy_f_b3, I_hy_bias, I_rw_mu, I_rw_w0, I_rw_w_up, I_rw_a0, I_rw_a_up, I_rw_g_up, I_rw_k_k, I_rw_k_a, I_rw_r_k, I_rw_ln_g, I_rw_ln_b,
       I_s5_a_re, I_s5_a_im, I_s5_log_dt, I_s5_b_re, I_s5_b_im, I_s5_c_re, I_s5_c_im, I_s5_d, I_s5_glu_w, I_s5_glu_b, I_gla_gate_up, I_gla_gate_b, I_gla_norm_g,
       I_w_branch, I_w_out, I_ffn_w1, I_ffn_w3, I_ffn_w2, I_moe_router_w, I_moe_router_b, I_moe_w1, I_moe_w3, I_moe_w2, I_final_norm_g, N_IN };

struct P {
    const float* in[N_IN];
    float* out;
    unsigned* bar;
    float* mod;
    u16* rvl;
    u16* rvc;
    int* moe_i;
    int* row_tok;
    int* dest_of;
    int* top_i;
    float* top_g;
    u16* wt_in;
    u16* wt_br;
    u16* wt_out;
    u16* wt_f13;
    u16* wt_f2;
    u16* wt_glu;
    u16* wt_g;
    float* hctx;
    u16* hn;
    u16* y;
    char* arena;
    u16* wt_m13;
    u16* wt_m2;
    u16* yb;
    u16* xb8;
    u16* wt_gate8;
    u16* wt_in8;
    u16* gch;
};

typedef const __attribute__((address_space(4))) P* PP;
#define PREF asm volatile("" : "+s"(pp)); const __attribute__((address_space(4))) P& p = *pp; extern __shared__ __attribute__((aligned(16))) char smem_raw[]; char* smem = smem_raw + SM_OFF; (void)smem; const int tix = ltid(); (void)tix
__device__ __forceinline__ int ltid() { int t = threadIdx.x; asm volatile("" : "+v"(t)); return t; }
__device__ __forceinline__ int uni(int v) { return __builtin_amdgcn_readfirstlane(v); }
__device__ __forceinline__ float bf2f(u16 b) { return __uint_as_float(((unsigned)b) << 16); }

#define RLXA __ATOMIC_RELAXED, __HIP_MEMORY_SCOPE_AGENT
#ifndef COH
#define COH 0
#endif
#if COH
__device__ __forceinline__ unsigned ldc_u32(const void* q) { return __hip_atomic_load((unsigned*)q, RLXA); }
__device__ __forceinline__ unsigned long long ldc_u64(const void* q) { return __hip_atomic_load((unsigned long long*)q, RLXA); }
__device__ __forceinline__ float ldc_f32(const void* q) { return __uint_as_float(ldc_u32(q)); }
__device__ __forceinline__ u32x2 ldc_8(const void* q) { const unsigned long long v = ldc_u64(q); u32x2 r; r.x = (unsigned)v; r.y = (unsigned)(v >> 32); return r; }
__device__ __forceinline__ u32x4 ldc_16(const void* q) { const unsigned long long a = ldc_u64(q), b = ldc_u64((const char*)q + 8); u32x4 r; r.x = (unsigned)a; r.y = (unsigned)(a >> 32); r.z = (unsigned)b; r.w = (unsigned)(b >> 32); return r; }
__device__ __forceinline__ f32x4 ldc_f4(const void* q) { const u32x4 v = ldc_16(q); return (f32x4){__uint_as_float(v.x), __uint_as_float(v.y), __uint_as_float(v.z), __uint_as_float(v.w)}; }
__device__ __forceinline__ void stc_u32(void* q, unsigned v) { __hip_atomic_store((unsigned*)q, v, RLXA); }
__device__ __forceinline__ void stc_f32(void* q, float v) { __hip_atomic_store((unsigned*)q, __float_as_uint(v), RLXA); }
__device__ __forceinline__ void stc_8(void* q, u32x2 v) { __hip_atomic_store((unsigned long long*)q, ((unsigned long long)v.y << 32) | v.x, RLXA); }
__device__ __forceinline__ void stc_16(void* q, u32x4 v) { __hip_atomic_store((unsigned long long*)q, ((unsigned long long)v.y << 32) | v.x, RLXA); __hip_atomic_store((unsigned long long*)q + 1, ((unsigned long long)v.w << 32) | v.z, RLXA); }
__device__ __forceinline__ void stc_u16(void* q, u16 v) { __hip_atomic_store((unsigned short*)q, v, RLXA); }
__device__ __forceinline__ void stc_f4(void* q, f32x4 v) { stc_16(q, (u32x4){__float_as_uint(v[0]), __float_as_uint(v[1]), __float_as_uint(v[2]), __float_as_uint(v[3])}); }
__device__ __forceinline__ float ldc_bf(const u16* q) { const unsigned w = ldc_u32((const void*)((size_t)q & ~(size_t)3)); return ((size_t)q & 2) ? __uint_as_float(w & 0xffff0000u) : __uint_as_float(w << 16); }
#define SC1_AUX 16
#else
__device__ __forceinline__ unsigned ldc_u32(const void* q) { return *(const unsigned*)q; }
__device__ __forceinline__ float ldc_f32(const void* q) { return *(const float*)q; }
__device__ __forceinline__ u32x2 ldc_8(const void* q) { return *(const u32x2*)q; }
__device__ __forceinline__ u32x4 ldc_16(const void* q) { return *(const u32x4*)q; }
__device__ __forceinline__ f32x4 ldc_f4(const void* q) { return *(const f32x4*)q; }
__device__ __forceinline__ void stc_u32(void* q, unsigned v) { *(unsigned*)q = v; }
__device__ __forceinline__ void stc_f32(void* q, float v) { *(float*)q = v; }
__device__ __forceinline__ void stc_8(void* q, u32x2 v) { *(u32x2*)q = v; }
__device__ __forceinline__ void stc_16(void* q, u32x4 v) { *(u32x4*)q = v; }
__device__ __forceinline__ void stc_u16(void* q, u16 v) { *(u16*)q = v; }
__device__ __forceinline__ void stc_f4(void* q, f32x4 v) { *(f32x4*)q = v; }
__device__ __forceinline__ float ldc_bf(const u16* q) { return __uint_as_float(((unsigned)*q) << 16); }
#define SC1_AUX 0
#endif
__device__ __forceinline__ u16 f2bf(float f) { unsigned u = __float_as_uint(f); u += 0x7FFFu + ((u >> 16) & 1u); return (u16)(u >> 16); }
typedef __bf16 bf16x2_t __attribute__((ext_vector_type(2)));
typedef float f32x2_t __attribute__((ext_vector_type(2)));
__device__ __forceinline__ unsigned pk2(float lo, float hi) { const f32x2_t v = {lo, hi}; return __builtin_bit_cast(unsigned, __builtin_convertvector(v, bf16x2_t)); }
__device__ __forceinline__ float fexp(float x) { return __builtin_amdgcn_exp2f(x * 1.4426950408889634f); }
__device__ __forceinline__ float frcp(float x) { return __builtin_amdgcn_rcpf(x); }
__device__ __forceinline__ float sigm(float x) { return frcp(1.f + fexp(-x)); }
__device__ __forceinline__ float ftanh(float x) { return 1.f - 2.f * frcp(1.f + fexp(2.f * x)); }
template <int CTRL> __device__ __forceinline__ float dppf(float v) { return __int_as_float(__builtin_amdgcn_update_dpp(0, __float_as_int(v), CTRL, 0xF, 0xF, true)); }
__device__ __forceinline__ float rowsum16(float v) { v += dppf<0xB1>(v); v += dppf<0x4E>(v); v += dppf<0x141>(v); v += dppf<0x140>(v); return v; }
__device__ __forceinline__ float rdl(float v, int l) { return __int_as_float(__builtin_amdgcn_readlane(__float_as_int(v), l)); }
__device__ __forceinline__ float wsum(float v) { v = rowsum16(v); return (rdl(v, 0) + rdl(v, 16)) + (rdl(v, 32) + rdl(v, 48)); }

__device__ __forceinline__ void unpack8(const u32x4 w, float (&o)[8]) { o[0] = __uint_as_float(w.x << 16); o[1] = __uint_as_float(w.x & 0xffff0000u); o[2] = __uint_as_float(w.y << 16); o[3] = __uint_as_float(w.y & 0xffff0000u);
    o[4] = __uint_as_float(w.z << 16); o[5] = __uint_as_float(w.z & 0xffff0000u); o[6] = __uint_as_float(w.w << 16); o[7] = __uint_as_float(w.w & 0xffff0000u); }
__device__ __forceinline__ u32x4 pack8(const float (&o)[8]) { u32x4 w; w.x = pk2(o[0], o[1]); w.y = pk2(o[2], o[3]); w.z = pk2(o[4], o[5]); w.w = pk2(o[6], o[7]); return w; }
__device__ __forceinline__ unsigned pk4_fp8(float a, float b, float c, float d) {
    a = fminf(fmaxf(a, -448.f), 448.f); b = fminf(fmaxf(b, -448.f), 448.f); c = fminf(fmaxf(c, -448.f), 448.f); d = fminf(fmaxf(d, -448.f), 448.f);
    const unsigned w = __builtin_amdgcn_cvt_pk_fp8_f32(a, b, 0, false); return __builtin_amdgcn_cvt_pk_fp8_f32(c, d, w, true); }
__device__ __forceinline__ u32x2 pk4bf(const f32x4 v) { u32x2 w; w.x = pk2(v[0], v[1]); w.y = pk2(v[2], v[3]); return w; }
__device__ __forceinline__ void ld8bf(const u16* q, f32x4& lo, f32x4& hi) { float t[8]; unpack8(ldc_16(q), t); lo = (f32x4){t[0], t[1], t[2], t[3]}; hi = (f32x4){t[4], t[5], t[6], t[7]}; }
__device__ __forceinline__ float sum8lanes(float v) { v += dppf<0xB1>(v); v += dppf<0x4E>(v); v += dppf<0x141>(v); return v; }
__device__ __forceinline__ int mrow_of(int row) { return row < RC ? 16 : ((row - RC) >> 11); }
#define LDSWAIT() asm volatile("s_waitcnt lgkmcnt(0)" ::: "memory")

#define XB_TMO      128
#define XB_XCNT(j)  (256  + 64 * (j))
#define XB_XSUB(j)  (1280 + 64 * (j))
#define XB_XGEN(j)  (2304 + 64 * (j))
#define XB_TOP      3328
#define XB_TOPGEN   3392
#define XCD_BAR_WORDS 3456
#define XB_SPIN_CAP (1u << 18)
#define LAS __attribute__((address_space(3)))

__device__ __forceinline__ unsigned xb_ld(unsigned* p)              { return __hip_atomic_load(p, __ATOMIC_RELAXED, __HIP_MEMORY_SCOPE_AGENT); }
__device__ __forceinline__ unsigned xb_add(unsigned* p, unsigned v) { return __hip_atomic_fetch_add(p, v, __ATOMIC_RELAXED, __HIP_MEMORY_SCOPE_AGENT); }
__device__ __forceinline__ unsigned xb_xcc_id() { return (unsigned)__builtin_amdgcn_s_getreg((3 << 11) | 20) & 0xFu; }
#define XB_SPIN(cond, bar) do { unsigned _sp = 0; while (cond) { __builtin_amdgcn_s_sleep(1); \
    if ((++_sp & 255u) == 0u) { if (xb_ld(&(bar)[XB_TMO])) break; if (_sp > XB_SPIN_CAP) { atomicAdd(&(bar)[XB_TMO], 1u); break; } } } } while (0)

struct XcdBarrier {
    unsigned* bar; unsigned x;
    volatile LAS unsigned* st;
};

__device__ __forceinline__ XcdBarrier xcd_barrier_post(unsigned* bar, volatile LAS unsigned* st) {
    XcdBarrier b; b.bar = bar; b.x = xb_xcc_id(); b.st = st;
    if (threadIdx.x == 0) (void)xb_add(&bar[XB_XCNT(b.x)], 1u);
    return b;
}
__device__ __forceinline__ void xcd_barrier_complete(unsigned* bar, unsigned x, unsigned& nloc, unsigned& nx) {
    const unsigned G = gridDim.x * gridDim.y * gridDim.z;
    unsigned sum, cnt, mine, sp = 0u;
    for (;;) {
        sum = 0u; cnt = 0u; mine = 0u;
#pragma unroll
        for (unsigned j = 0; j < 16; ++j) { const unsigned c = xb_ld(&bar[XB_XCNT(j)]); sum += c; cnt += (c > 0u) ? 1u : 0u; mine = (j == x) ? c : mine; }
        if (sum == G) break;
        __builtin_amdgcn_s_sleep(1);
        if ((++sp & 255u) == 0u) { if (xb_ld(&bar[XB_TMO])) break; if (sp > XB_SPIN_CAP) { atomicAdd(&bar[XB_TMO], 1u); break; } }
    }
    nloc = mine > 0u ? mine : 1u; nx = cnt > 0u ? cnt : 1u;
}

__device__ __forceinline__ void xcd_barrier(const XcdBarrier& b) {
    asm volatile("s_waitcnt vmcnt(0)" ::: "memory");
    __syncthreads();
    if (threadIdx.x == 0) {
        unsigned* bar = b.bar; unsigned bx = b.x; asm volatile("" : "+s"(bar), "+s"(bx));
        __builtin_amdgcn_s_waitcnt(0);
        unsigned nloc = b.st[0], nx = b.st[1];
        if (nloc == 0u) { xcd_barrier_complete(bar, bx, nloc, nx); b.st[0] = nloc; b.st[1] = nx; }
        const unsigned old = xb_add(&bar[XB_XSUB(bx)], 1u);
        const unsigned gen = old / nloc;
        if (old + 1u == (gen + 1u) * nloc) {
            __builtin_amdgcn_fence(__ATOMIC_RELEASE, "agent");
            asm volatile("s_waitcnt vmcnt(0)" ::: "memory");
            const unsigned og = xb_add(&bar[XB_TOP], 1u);
            const unsigned tg = og / nx;
            if (og + 1u == (tg + 1u) * nx) xb_add(&bar[XB_TOPGEN], 1u);
            else XB_SPIN(xb_ld(&bar[XB_TOPGEN]) == tg, bar);
            __builtin_amdgcn_fence(__ATOMIC_ACQUIRE, "agent");
            xb_add(&bar[XB_XGEN(bx)], 1u);
            asm volatile("s_waitcnt vmcnt(0)" ::: "memory");
        } else {
            XB_SPIN(xb_ld(&bar[XB_XGEN(bx)]) == gen, bar);
            __builtin_amdgcn_fence(__ATOMIC_ACQUIRE, "agent");
            asm volatile("s_waitcnt vmcnt(0)" ::: "memory");
        }
    }
    __syncthreads();
}

__device__ __forceinline__ void do_transpose(const float* src, int K, int N, long ldsrc, u16* dst, int G, int GS, int off, char* smem, int f8 = 0) {
    const int tix = ltid();
    float (*t)[65] = (float (*)[65])smem;
    const int tk = K / 64, tn = (N + 63) / 64;
    const int sn = tix >> 3, sk = (tix & 7) * 8;
    for (int u = blockIdx.x; u < tk * tn; u += gridDim.x) {
        const int k0 = (u % tk) * 64, n0 = (u / tk) * 64;
        __syncthreads();
#pragma unroll
        for (int q2 = 0; q2 < 2; ++q2) { const int q = tix + q2 * NT, i = q >> 4, c4 = (q & 15) * 4, n = n0 + c4;
            f32x4 v = (f32x4){0.f, 0.f, 0.f, 0.f};
            if (n < N) v = *(const f32x4*)(src + (long)(k0 + i) * ldsrc + n);
            t[i][c4] = v[0]; t[i][c4 + 1] = v[1]; t[i][c4 + 2] = v[2]; t[i][c4 + 3] = v[3]; }
        __syncthreads();
        { const int n = n0 + sn;
          if (n < N) { float o[8];
#pragma unroll
              for (int e = 0; e < 8; ++e) o[e] = t[sk + e][sn];
              const long dr = (long)(n / G) * GS + (n % G) + off;
              if (f8) { u32x2 w8; w8.x = pk4_fp8(o[0] * 32.f, o[1] * 32.f, o[2] * 32.f, o[3] * 32.f); w8.y = pk4_fp8(o[4] * 32.f, o[5] * 32.f, o[6] * 32.f, o[7] * 32.f); *(u32x2*)((char*)dst + dr * K + k0 + sk) = w8; }
              else *(u32x4*)(dst + dr * K + k0 + sk) = pack8(o); } }
    }
}

__device__ __forceinline__ void ph_mod(PP pp) {
    PREF;
    float* s = (float*)smem; float* red = s + 17 * 1024;
    const int G = (int)gridDim.x, bsh = (int)((blockIdx.x + 64u) % gridDim.x);
    if (bsh >= 192) return;
    for (int i = tix; i < 17 * 1024; i += NT) { const int r = i >> 10, k = i & 1023; const float v = r < 16 ? p.in[I_c][r * 1024 + k] : p.in[I_c_ctx][k]; s[i] = v / (1.f + expf(-v)); }
    __syncthreads();
    const int j = tix & 63, kq = tix >> 6;
    for (int u = bsh; u < 192; u += G) {
        const int l = u / 96, jc = (u % 96) * 64;
        float acc[17];
#pragma unroll
        for (int r = 0; r < 17; ++r) acc[r] = 0.f;
        const float* w = p.in[I_ada_w] + ((size_t)l * 1024 + kq * 128) * 6144 + jc + j;
#pragma unroll 8
        for (int k = 0; k < 128; ++k) { const float wv = w[(size_t)k * 6144];
#pragma unroll
            for (int r = 0; r < 17; ++r) acc[r] += s[r * 1024 + kq * 128 + k] * wv; }
        __syncthreads();
#pragma unroll
        for (int r = 0; r < 17; ++r) red[(kq * 17 + r) * 64 + j] = acc[r];
        __syncthreads();
        for (int o = tix; o < 17 * 64; o += NT) { const int r = o >> 6, jj = o & 63; float a = p.in[I_ada_b][l * 6144 + jc + jj];
#pragma unroll
            for (int q = 0; q < 8; ++q) a += red[(q * 17 + r) * 64 + jj];
            p.mod[(size_t)(l * 17 + r) * 6144 + jc + jj] = a; }
    }
}

__device__ __forceinline__ void ph_filt(PP pp) {
    PREF;
    float* z = (float*)smem; float* h1 = z + 65 * 36; float* h2 = h1 + 65 * 64; u16* tile = (u16*)(h2 + 65 * 64);
    const int tid = tix, wid = tid >> 6, lane = tid & 63;
    const int G = (int)gridDim.x;
    for (int u = (int)((blockIdx.x + 128u) % gridDim.x); u < 288; u += G) {
        const int l = u / 144, r = (u % 144) >> 2, cq = u & 3;
        const int L = r < 4 ? 256 : 2048, k = r < 4 ? r : r - 4;
        __syncthreads();
        for (int idx = tid; idx < 65 * 17; idx += NT) { const int pj = idx / 17, i = idx - pj * 17; const int pos = 64 * k + pj;
            if (i == 16) z[pj * 36] = (float)pos / (float)(L - 1);
            else { const float fr = 1e-4f + (float)i * ((15.f - 1e-4f) / 15.f); const float ang = (6.283185307179586f / (float)L) * (float)pos * fr; z[pj * 36 + 1 + i] = cosf(ang); z[pj * 36 + 17 + i] = -sinf(ang); } }
        __syncthreads();
        for (int idx = tid; idx < 65 * 64; idx += NT) { const int pj = idx >> 6, uu = idx & 63; float a = p.in[I_hy_f_b1][l * 64 + uu];
            for (int i = 0; i < 33; ++i) a += z[pj * 36 + i] * p.in[I_hy_f_w1][(l * 33 + i) * 64 + uu];
            h1[idx] = sinf(a); }
        __syncthreads();
        for (int idx = tid; idx < 65 * 64; idx += NT) { const int pj = idx >> 6, uu = idx & 63; float a = p.in[I_hy_f_b2][l * 64 + uu];
            for (int i = 0; i < 64; ++i) a += h1[pj * 64 + i] * p.in[I_hy_f_w2][(l * 64 + i) * 64 + uu];
            h2[idx] = sinf(a); }
        __syncthreads();
        {
            const int c = tid & 255, ph = tid >> 8, cg = (c < 128 ? 0 : 512) + cq * 128 + (c & 127);
            float wc[64];
#pragma unroll
            for (int i = 0; i < 64; ++i) wc[i] = p.in[I_hy_f_w3][(l * 64 + i) * 1024 + cg];
            const float b3 = p.in[I_hy_f_b3][l * 1024 + cg];
            const float ra = 3.0701134573f, rb = 15.3505672867f;
            const float rate = ra + (float)(cg & 511) * ((rb - ra) / 511.f);
            const float bias0 = cg < 512 ? p.in[I_hy_bias][l * 512 + cg] : 0.f;
            for (int pj = ph * 33; pj < (ph ? 65 : 33); ++pj) {
                const int pos = 64 * k + pj; const float t = (float)pos / (float)(L - 1);
                float a = b3;
#pragma unroll
                for (int i4 = 0; i4 < 16; ++i4) { const f32x4 hv = *(const f32x4*)(h2 + pj * 64 + i4 * 4); a += hv[0] * wc[i4 * 4] + hv[1] * wc[i4 * 4 + 1] + hv[2] * wc[i4 * 4 + 2] + hv[3] * wc[i4 * 4 + 3]; }
                float val = a * expf(-t * rate);
                if (pos == 0) val += bias0;
                if (pos >= L) val = 0.f;
                tile[c * 66 + pj] = f2bf(val);
            }
        }
        __syncthreads();
        u16* rv = L == 2048 ? p.rvl + (size_t)l * 512 * 4096 : p.rvc + (size_t)l * 512 * 512;
        for (int cl = wid; cl < 128; cl += 8) {
            u16* row = rv + (size_t)(cq * 128 + cl) * (2 * L);
            row[L - 64 * k - 64 + lane] = tile[cl * 66 + 64 - lane];
            row[L + 64 * k + lane] = (k == 0 && lane == 0) ? tile[cl * 66] : tile[(128 + cl) * 66 + lane];
        }
    }
}

#define HN8(p) ((char*)(p).arena + (size_t)MT * 4096 * 2)
__device__ __forceinline__ void ph_norm(PP pp, int l, int which, int r0, int r1, int first, int router, int f8) {
    PREF; l = uni(l); which = uni(which); r0 = uni(r0); r1 = uni(r1); first = uni(first); router = uni(router); f8 = uni(f8);
    const int wid = tix >> 6, lane = tix & 63;
    const float* g = p.in[which ? I_norm_ffn_g : I_norm_mix_g] + l * 1024;
    const int shoff = which ? 3072 : 0, scoff = which ? 4096 : 1024;
    LAS int* lc = (LAS int*)smem;
    float* rwT = (float*)smem + 64;
    if (router) { __syncthreads(); if (tix < 8) lc[tix] = 0;
        for (int i = tix; i < 8192; i += NT) rwT[(i & 7) * 1024 + (i >> 3)] = p.in[I_moe_router_w][i];
        __syncthreads(); }
    for (int row = r0 + blockIdx.x * 8 + wid; row < r1; row += gridDim.x * 8) {
        const float* src = row < RC ? ((first ? p.in[I_ctx] : p.hctx) + (size_t)row * 1024) : ((first ? p.in[I_x] : p.out) + (size_t)(row - RC) * 1024);
        const float* md = p.mod + (size_t)(l * 17 + mrow_of(row)) * 6144;
        f32x4 v[4]; float ss = 0.f;
#pragma unroll
        for (int i = 0; i < 4; ++i) { v[i] = ldc_f4(src + i * 256 + lane * 4); ss += v[i][0] * v[i][0] + v[i][1] * v[i][1] + v[i][2] * v[i][2] + v[i][3] * v[i][3]; }
        ss = wsum(ss);
        const float rs = rsqrtf(ss * (1.f / 1024.f) + 1e-6f);
        float lg[8];
#pragma unroll
        for (int e = 0; e < 8; ++e) lg[e] = 0.f;
        f32x4 gg4[4], sc4[4], sh4[4];
#pragma unroll
        for (int i = 0; i < 4; ++i) { const int k = i * 256 + lane * 4; gg4[i] = *(const f32x4*)(g + k); sc4[i] = *(const f32x4*)(md + scoff + k); sh4[i] = *(const f32x4*)(md + shoff + k); }
#pragma unroll
        for (int i = 0; i < 4; ++i) {
            const int k = i * 256 + lane * 4;
            const f32x4 gg = gg4[i], sc = sc4[i], sh = sh4[i];
            f32x4 o;
#pragma unroll
            for (int j = 0; j < 4; ++j) o[j] = v[i][j] * rs * gg[j] * (1.f + sc[j]) + sh[j];
            if (f8) stc_u32((char*)p.hn + (size_t)row * 1024 + k, pk4_fp8(o[0], o[1], o[2], o[3]));
            else { u32x2 w; w.x = pk2(o[0], o[1]); w.y = pk2(o[2], o[3]); stc_8(p.hn + (size_t)row * 1024 + k, w);
                   if (!which) stc_u32(HN8(p) + (size_t)row * 1024 + k, pk4_fp8(o[0], o[1], o[2], o[3])); }
            if (router) {
#pragma unroll
                for (int e = 0; e < 8; ++e) { const f32x4 wv = *(const f32x4*)(rwT + e * 1024 + k); lg[e] += (o[0] * wv[0] + o[1] * wv[1]) + (o[2] * wv[2] + o[3] * wv[3]); }
            }
        }
        if (router) {
#pragma unroll
            for (int e = 0; e < 8; ++e) lg[e] = wsum(lg[e]) + p.in[I_moe_router_b][e];
            if (lane == 0) {
                int i0 = 0; float v0 = lg[0];
#pragma unroll
                for (int e = 1; e < 8; ++e) if (lg[e] > v0) { v0 = lg[e]; i0 = e; }
                int i1 = -1; float v1 = -3.4e38f;
#pragma unroll
                for (int e = 0; e < 8; ++e) if (e != i0 && lg[e] > v1) { v1 = lg[e]; i1 = e; }
                const float e1 = expf(v1 - v0), g0 = 1.f / (1.f + e1), g1 = e1 / (1.f + e1);
                const int tok = row - RC;
                stc_u32(p.top_i + tok * 2, (unsigned)i0); stc_u32(p.top_i + tok * 2 + 1, (unsigned)i1); stc_f32(p.top_g + tok * 2, g0); stc_f32(p.top_g + tok * 2 + 1, g1);
                const int k0 = __hip_atomic_fetch_add(lc + i0, 1, __ATOMIC_RELAXED, __HIP_MEMORY_SCOPE_WORKGROUP), k1 = __hip_atomic_fetch_add(lc + i1, 1, __ATOMIC_RELAXED, __HIP_MEMORY_SCOPE_WORKGROUP);
                stc_u32(p.row_tok + tok * 2, (unsigned)k0); stc_u32(p.row_tok + tok * 2 + 1, (unsigned)k1);
            }
        }
    }
    if (router) { __syncthreads(); if (tix < 8) stc_u32(p.moe_i + 1024 + blockIdx.x * 8 + tix, (unsigned)lc[tix]); }
}

typedef f32x4 Acc[2][2][4][2];
__device__ __forceinline__ int perm32(int rho) { const int n = rho >> 4, i = rho & 15; return 8 * (i >> 2) + 4 * n + (i & 3); }

template <class Pr>
__device__ __forceinline__ void gemm_v1(const Pr& pr, char* smem) {
    const int tid = ltid(), wid = tid >> 6, lane = tid & 63, wr = wid >> 2, wc = wid & 3, fr = lane & 15, fq = lane >> 4;
    u16* sA = (u16*)smem; u16* sB = sA + 256 * 40;
    const int nu = pr.num_units();
    const int kp = (tid & 3) * 8;
    for (int u = blockIdx.x; u < nu; u += gridDim.x) {
        int pm, pn; if (!pr.unit(u, pm, pn)) continue;
        const u16* arow[2]; const u16* brow[2];
#pragma unroll
        for (int i = 0; i < 2; ++i) { const int row = (tid + i * 512) >> 2; arow[i] = pr.a_row(pm, row); brow[i] = pr.b_row(pm, pn, (row & ~31) + perm32(row & 31)); }
        Acc acc;
#pragma unroll
        for (int a = 0; a < 2; ++a)
#pragma unroll
            for (int b = 0; b < 2; ++b)
#pragma unroll
                for (int m = 0; m < 4; ++m)
#pragma unroll
                    for (int n = 0; n < 2; ++n) acc[a][b][m][n] = (f32x4){0.f, 0.f, 0.f, 0.f};
        const int K = pr.K();
        for (int k0 = 0; k0 < K; k0 += 32) {
            u32x4 ra[2], rb[2];
#pragma unroll
            for (int i = 0; i < 2; ++i) { ra[i] = arow[i] ? *(const u32x4*)(arow[i] + k0 + kp) : (u32x4){0u, 0u, 0u, 0u}; rb[i] = *(const u32x4*)(brow[i] + k0 + kp); }
            __syncthreads();
#pragma unroll
            for (int i = 0; i < 2; ++i) { const int row = (tid + i * 512) >> 2; *(u32x4*)(sA + row * 40 + kp) = ra[i]; *(u32x4*)(sB + row * 40 + kp) = rb[i]; }
            __syncthreads();
            bf16x8 af[2][4], bf[2][2];
#pragma unroll
            for (int a = 0; a < 2; ++a)
#pragma unroll
                for (int m = 0; m < 4; ++m) af[a][m] = *(const bf16x8*)(sA + (a * 128 + wr * 64 + m * 16 + fr) * 40 + fq * 8);
#pragma unroll
            for (int b = 0; b < 2; ++b)
#pragma unroll
                for (int n = 0; n < 2; ++n) bf[b][n] = *(const bf16x8*)(sB + (b * 128 + wc * 32 + n * 16 + fr) * 40 + fq * 8);
#pragma unroll
            for (int a = 0; a < 2; ++a)
#pragma unroll
                for (int b = 0; b < 2; ++b)
#pragma unroll
                    for (int m = 0; m < 4; ++m)
#pragma unroll
                        for (int n = 0; n < 2; ++n) acc[a][b][m][n] = __builtin_amdgcn_mfma_f32_16x16x32_bf16(bf[b][n], af[a][m], acc[a][b][m][n], 0, 0, 0);
        }
        pr.epi(acc, pm, pn, wr, wc, fr, fq);
    }
}

struct GPb {
    const u16* A; long lda; const u16* Bt; long ldb; int Kd; int tm0, ntm, ntn;
    __device__ int num_units() const { return ntm * ntn; }
    __device__ bool unit(int u, int& pm, int& pn) const { pm = tm0 + u / ntn; pn = u % ntn; return true; }
    __device__ const u16* a_row(int pm, int r) const { return A + (size_t)(pm * 256 + r) * lda; }
    __device__ const u16* b_row(int pm, int pn, int r) const { return Bt + (size_t)(pn * 256 + r) * ldb; }
    __device__ int K() const { return Kd; }
};
struct PrStore : GPb { u16* O; long ldo; int act; int pad_;
    __device__ void epi(Acc& acc, int pm, int pn, int wr, int wc, int fr, int fq) const {
#pragma unroll
        for (int a = 0; a < 2; ++a)
#pragma unroll
            for (int m = 0; m < 4; ++m) { const size_t row = (size_t)pm * 256 + a * 128 + wr * 64 + m * 16 + fr;
#pragma unroll
                for (int b = 0; b < 2; ++b) { const int col = pn * 256 + b * 128 + wc * 32 + fq * 8; f32x4 v0 = acc[a][b][m][0], v1 = acc[a][b][m][1];
                    if (act == 1) {
#pragma unroll
                        for (int j = 0; j < 4; ++j) { v0[j] = sigm(v0[j]); v1[j] = sigm(v1[j]); } }
                    u32x4 w; w.x = pk2(v0[0], v0[1]); w.y = pk2(v0[2], v0[3]); w.z = pk2(v1[0], v1[1]); w.w = pk2(v1[2], v1[3]);
                    stc_16(O + row * ldo + col, w); } }
    }
};
struct PrBranch : GPb { const u16* g; float* ACC; u16* accb; int mi; float scale;
    __device__ void epi(Acc& acc, int pm, int pn, int wr, int wc, int fr, int fq) const {
#pragma unroll
        for (int a = 0; a < 2; ++a)
#pragma unroll
            for (int m = 0; m < 4; ++m) { const size_t row = (size_t)pm * 256 + a * 128 + wr * 64 + m * 16 + fr;
#pragma unroll
                for (int b = 0; b < 2; ++b) { const int col = pn * 256 + b * 128 + wc * 32 + fq * 8;
                    const u32x4 gw = ldc_16(g + row * 1024 + col);
                    float gv[8]; gv[0] = __uint_as_float(gw.x << 16); gv[1] = __uint_as_float(gw.x & 0xffff0000u); gv[2] = __uint_as_float(gw.y << 16); gv[3] = __uint_as_float(gw.y & 0xffff0000u);
                    gv[4] = __uint_as_float(gw.z << 16); gv[5] = __uint_as_float(gw.z & 0xffff0000u); gv[6] = __uint_as_float(gw.w << 16); gv[7] = __uint_as_float(gw.w & 0xffff0000u);
                    float* ap = ACC + row * 1024 + col;
                    f32x4 o0, o1;
                    if (mi == 0) { o0 = (f32x4){0.f, 0.f, 0.f, 0.f}; o1 = o0; } else { o0 = ldc_f4(ap); o1 = ldc_f4(ap + 4); }
#pragma unroll
                    for (int j = 0; j < 4; ++j) { o0[j] += scale * gv[j] * acc[a][b][m][0][j]; o1[j] += scale * gv[4 + j] * acc[a][b][m][1][j]; }
                    if (mi == 3) { u32x4 w; w.x = pk2(o0[0], o0[1]); w.y = pk2(o0[2], o0[3]); w.z = pk2(o1[0], o1[1]); w.w = pk2(o1[2], o1[3]); stc_16(accb + row * 1024 + col, w); }
                    else { stc_f4(ap, o0); stc_f4(ap + 4, o1); } } }
    }
};
struct PrResid : GPb { const float* oc; const float* ol; float* nc; float* nl; const float* mod; int goff; float scale;
    __device__ void epi(Acc& acc, int pm, int pn, int wr, int wc, int fr, int fq) const {
        const float* gt = mod + (size_t)mrow_of(pm * 256) * 6144 + goff;
#pragma unroll
        for (int a = 0; a < 2; ++a)
#pragma unroll
            for (int m = 0; m < 4; ++m) { const int row = pm * 256 + a * 128 + wr * 64 + m * 16 + fr;
                const float* op = row < RC ? oc + (size_t)row * 1024 : ol + (size_t)(row - RC) * 1024;
                float* np = row < RC ? nc + (size_t)row * 1024 : nl + (size_t)(row - RC) * 1024;
#pragma unroll
                for (int b = 0; b < 2; ++b) { const int col = pn * 256 + b * 128 + wc * 32 + fq * 8;
#pragma unroll
                    for (int n = 0; n < 2; ++n) { const f32x4 o = ldc_f4(op + col + 4 * n), gg = *(const f32x4*)(gt + col + 4 * n); f32x4 r;
#pragma unroll
                        for (int j = 0; j < 4; ++j) r[j] = o[j] + scale * gg[j] * acc[a][b][m][n][j];
                        stc_f4(np + col + 4 * n, r); } } }
    }
};
struct PrSwiglu : GPb { u16* G; long ldg;
    __device__ void epi(Acc& acc, int pm, int pn, int wr, int wc, int fr, int fq) const {
#pragma unroll
        for (int a = 0; a < 2; ++a)
#pragma unroll
            for (int m = 0; m < 4; ++m) { const size_t row = (size_t)pm * 256 + a * 128 + wr * 64 + m * 16 + fr; const int col = pn * 128 + wc * 32 + fq * 8;
                float o[8];
#pragma unroll
                for (int n = 0; n < 2; ++n)
#pragma unroll
                    for (int j = 0; j < 4; ++j) { const float x = acc[a][0][m][n][j]; o[n * 4 + j] = x * sigm(x) * acc[a][1][m][n][j]; }
                stc_16(G + row * ldg + col, pack8(o)); }
    }
};
struct PrGlu : GPb { const u16* ya; const float* gb; u16* O;
    __device__ void epi(Acc& acc, int pm, int pn, int wr, int wc, int fr, int fq) const {
#pragma unroll
        for (int a = 0; a < 2; ++a)
#pragma unroll
            for (int m = 0; m < 4; ++m) { const size_t row = (size_t)pm * 256 + a * 128 + wr * 64 + m * 16 + fr;
#pragma unroll
                for (int b = 0; b < 2; ++b) { const int col = pn * 256 + b * 128 + wc * 32 + fq * 8;
                    const u32x4 yw = ldc_16(ya + row * 512 + col);
                    float yv[8]; yv[0] = __uint_as_float(yw.x << 16); yv[1] = __uint_as_float(yw.x & 0xffff0000u); yv[2] = __uint_as_float(yw.y << 16); yv[3] = __uint_as_float(yw.y & 0xffff0000u);
                    yv[4] = __uint_as_float(yw.z << 16); yv[5] = __uint_as_float(yw.z & 0xffff0000u); yv[6] = __uint_as_float(yw.w << 16); yv[7] = __uint_as_float(yw.w & 0xffff0000u);
                    float o[8];
#pragma unroll
                    for (int n = 0; n < 2; ++n)
#pragma unroll
                        for (int j = 0; j < 4; ++j) o[n * 4 + j] = yv[n * 4 + j] * sigm(acc[a][b][m][n][j] + gb[col + n * 4 + j]);
                    u32x4 w; w.x = pk2(o[0], o[1]); w.y = pk2(o[2], o[3]); w.z = pk2(o[4], o[5]); w.w = pk2(o[6], o[7]);
                    stc_16(O + row * 512 + col, w); } }
    }
};
struct PrMoeUp { const u16* h2; const int* row_tok; const int* mi; const u16* W; u16* G; int t0, nt;
    __device__ int num_units() const { return nt * 28; }
    __device__ bool unit(int u, int& pm, int& pn) const { pm = t0 + u / 28; pn = u % 28; return pm < mi[25]; }
    __device__ const u16* a_row(int pm, int r) const { const int t = row_tok[pm * 256 + r]; return t >= 0 ? h2 + (size_t)(RC + t) * 1024 : (const u16*)0; }
    __device__ const u16* b_row(int pm, int pn, int r) const { return W + ((size_t)mi[32 + pm] * 7168 + pn * 256 + r) * 1024; }
    __device__ int K() const { return 1024; }
    __device__ void epi(Acc& acc, int pm, int pn, int wr, int wc, int fr, int fq) const {
#pragma unroll
        for (int a = 0; a < 2; ++a)
#pragma unroll
            for (int m = 0; m < 4; ++m) { const size_t row = (size_t)(pm - t0) * 256 + a * 128 + wr * 64 + m * 16 + fr; const int col = pn * 128 + wc * 32 + fq * 8;
                float o[8];
#pragma unroll
                for (int n = 0; n < 2; ++n)
#pragma unroll
                    for (int j = 0; j < 4; ++j) { const float x = acc[a][0][m][n][j]; o[n * 4 + j] = x * sigm(x) * acc[a][1][m][n][j]; }
                u32x4 w; w.x = pk2(o[0], o[1]); w.y = pk2(o[2], o[3]); w.z = pk2(o[4], o[5]); w.w = pk2(o[6], o[7]);
                stc_16(G + row * 3584 + col, w); }
    }
};
struct PrMoeDown { const u16* G; const int* mi; const u16* W; u16* yb; int t0, nt;
    __device__ int num_units() const { return nt * 4; }
    __device__ bool unit(int u, int& pm, int& pn) const { pm = t0 + u / 4; pn = u % 4; return pm < mi[25]; }
    __device__ const u16* a_row(int pm, int r) const { return G + (size_t)((pm - t0) * 256 + r) * 3584; }
    __device__ const u16* b_row(int pm, int pn, int r) const { return W + ((size_t)mi[32 + pm] * 1024 + pn * 256 + r) * 3584; }
    __device__ int K() const { return 3584; }
    __device__ void epi(Acc& acc, int pm, int pn, int wr, int wc, int fr, int fq) const {
#pragma unroll
        for (int a = 0; a < 2; ++a)
#pragma unroll
            for (int m = 0; m < 4; ++m) { const size_t row = (size_t)pm * 256 + a * 128 + wr * 64 + m * 16 + fr;
#pragma unroll
                for (int b = 0; b < 2; ++b) { const int col = pn * 256 + b * 128 + wc * 32 + fq * 8; const f32x4 v0 = acc[a][b][m][0], v1 = acc[a][b][m][1];
                    u32x4 w; w.x = pk2(v0[0], v0[1]); w.y = pk2(v0[2], v0[3]); w.z = pk2(v1[0], v1[1]); w.w = pk2(v1[2], v1[3]);
                    stc_16(yb + row * 1024 + col, w); } }
    }
};


#define LAS3 __attribute__((address_space(3)))
#ifndef G8_AUXA
#define G8_AUXA 0
#endif
namespace g8 {
constexpr int BK = 64, HALF = 128, HTB = HALF * BK * 2, STAGE_BYTES = 8 * HTB;
__device__ __forceinline__ int lds_byte(int r, int c) { const int st = (r >> 4) * 2 + (c >> 5), rr = r & 15, cc = c & 31, ob = rr * 64 + cc * 2; return st * 1024 + (ob ^ (((ob >> 9) & 1) << 5)); }
__device__ __forceinline__ void stage_rc(int b, int& R, int& C) { const int st = b / 1024, sb = b % 1024, swz = sb ^ (((sb >> 9) & 1) << 5); R = (st >> 1) * 16 + swz / 64; C = (st & 1) * 32 + (swz % 64) / 2; }
struct U8 { const char* a; const char* b; int kb, kbb; int nt; int pm, pn, kind; };
__device__ __forceinline__ bool order8(int L, int nM, int nN, int& pm, int& pn) {
    const int nwg = nM * nN; if (L >= nwg) return false;
    int wgid = L; { const int q = nwg / 8, r = nwg % 8, xcd = wgid % 8, off = wgid / 8; wgid = (xcd < r ? xcd * (q + 1) : r * (q + 1) + (xcd - r) * q) + off; }
    const int nig = 8 * nN, gid = wgid / nig, fm = gid * 8, gsz = (nM - fm) < 8 ? (nM - fm) : 8;
    pm = fm + ((wgid % nig) % gsz); pn = (wgid % nig) / gsz; return true;
}
template <class Pr>
__device__ __forceinline__ void gemm8(LAS3 unsigned char* lds, const Pr& pr) {
    const int tid = ltid(), wid = __builtin_amdgcn_readfirstlane(tid >> 6), lane = tid & 63, wr = wid >> 2, wc = wid & 3, fr = lane & 15, fq = lane >> 4;
    unsigned RA[2], RB[2], C2[2];
#pragma unroll
    for (int i = 0; i < 2; ++i) { int R, C; stage_rc(tid * 16 + i * 8192, R, C); RA[i] = (unsigned)R; RB[i] = (unsigned)((R & ~31) + perm32(R & 31)); C2[i] = (unsigned)C * 2u; }
    const size_t kstep = (size_t)(BK * 2);
    const unsigned ldsw = (unsigned)wid * 1024u;
    const int aoff = lds_byte(wr * 64 + fr, fq * 8), boff = lds_byte(wc * 32 + fr, fq * 8);
#define G8_SA(b, h) (((b) * 2 + (h)) * HTB)
#define G8_SB(b, h) ((4 + (b) * 2 + (h)) * HTB)
#define G8_STAGE(bufoff, gbase, RR, kb) do { _Pragma("unroll") for (int _i = 0; _i < 2; ++_i) { \
        if ((const void*)RR == (const void*)RA) __builtin_amdgcn_global_load_lds((const unsigned*)((const char*)(gbase) + (RR[_i] * (unsigned)(kb) + C2[_i])), (LAS3 unsigned*)(lds + (bufoff) + ldsw + _i * 8192), 16, 0, G8_AUXA); \
        else __builtin_amdgcn_global_load_lds((const unsigned*)((const char*)(gbase) + (RR[_i] * (unsigned)(kb) + C2[_i])), (LAS3 unsigned*)(lds + (bufoff) + ldsw + _i * 8192), 16, 0, 0); } } while (0)
#define G8_LDA(dst, b, h) do { _Pragma("unroll") for (int m = 0; m < 4; ++m) _Pragma("unroll") for (int k = 0; k < 2; ++k) dst[m][k] = *(const LAS3 bf16x8*)(lds + G8_SA(b, h) + aoff + m * 2048 + k * 1024); } while (0)
#define G8_LDB(dst, b, h) do { _Pragma("unroll") for (int n = 0; n < 2; ++n) _Pragma("unroll") for (int k = 0; k < 2; ++k) dst[n][k] = *(const LAS3 bf16x8*)(lds + G8_SB(b, h) + boff + n * 2048 + k * 1024); } while (0)
#define G8_MMA(ai, bj, At, Bt) do { __builtin_amdgcn_s_setprio(1); _Pragma("unroll") for (int m = 0; m < 4; ++m) _Pragma("unroll") for (int n = 0; n < 2; ++n) _Pragma("unroll") for (int k = 0; k < 2; ++k) \
        acc[ai][bj][m][n] = __builtin_amdgcn_mfma_f32_16x16x32_bf16(Bt[n][k], At[m][k], acc[ai][bj][m][n], 0, 0, 0); __builtin_amdgcn_s_setprio(0); } while (0)
#define G8_WAIT_V(n) asm volatile("s_waitcnt vmcnt(" #n ")" ::: "memory")
#define G8_WAIT_L(n) asm volatile("s_waitcnt lgkmcnt(" #n ")" ::: "memory")
#define G8_BAR __builtin_amdgcn_s_barrier()
#define G8_SCHED __builtin_amdgcn_sched_barrier(0)
    U8 cur, nxt; int ui = 0;
    if (!pr.unit8(0, cur)) return;
    nxt = cur;
    f32x4 acc[2][2][4][2];
#pragma unroll
    for (int a = 0; a < 2; ++a)
#pragma unroll
        for (int b = 0; b < 2; ++b)
#pragma unroll
            for (int m = 0; m < 4; ++m)
#pragma unroll
                for (int n = 0; n < 2; ++n) acc[a][b][m][n] = (f32x4){0.f, 0.f, 0.f, 0.f};
    bf16x8 At[4][2], B0[2][2], B1[2][2];
    const char* cA = cur.a; const char* cB = cur.b; int ckb = cur.kb, ckbb = cur.kbb; size_t chs = (size_t)HALF * ckb, chsb = (size_t)HALF * ckbb;
    G8_STAGE(G8_SB(0, 0), cB, RB, ckbb); G8_STAGE(G8_SB(0, 1), cB + chsb, RB, ckbb); G8_STAGE(G8_SA(0, 0), cA, RA, ckb); G8_STAGE(G8_SA(0, 1), cA + chs, RA, ckb);
    if (wr == 1) G8_BAR;
    G8_WAIT_V(2); G8_BAR;
    G8_STAGE(G8_SB(1, 0), cB + kstep, RB, ckbb); G8_STAGE(G8_SA(1, 0), cA + kstep, RA, ckb); G8_STAGE(G8_SB(1, 1), cB + chsb + kstep, RB, ckbb);
    G8_WAIT_V(6); G8_BAR;
    for (;;) {
        const bool has_next = pr.unit8(ui + 1, nxt);
        const char* nA = has_next ? nxt.a : cA; const char* nB = has_next ? nxt.b : cB; const int nkb = has_next ? nxt.kb : ckb, nkbb = has_next ? nxt.kbb : ckbb;
        const int nt = cur.nt;
        for (int t = 0; t < nt; t += 2) {
            const bool last = (t == nt - 2);
            const char* a1 = cA + (size_t)(t + 1) * kstep;
            const char* a2 = last ? nA : cA + (size_t)(t + 2) * kstep; const char* b2 = last ? nB : cB + (size_t)(t + 2) * kstep;
            const int kb2 = last ? nkb : ckb, kbb2 = last ? nkbb : ckbb; const size_t hs2 = (size_t)HALF * kb2, hsb2 = (size_t)HALF * kbb2;
            const char* a3 = a2 + kstep; const char* b3 = b2 + kstep;
            G8_LDB(B0, 0, 0); G8_LDB(B1, 0, 1); G8_SCHED; G8_LDA(At, 0, 0); G8_STAGE(G8_SA(1, 1), a1 + chs, RA, ckb);
            G8_WAIT_V(8); G8_WAIT_L(0); G8_BAR; G8_MMA(0, 0, At, B0); G8_MMA(0, 1, At, B1); G8_BAR; G8_SCHED;
            G8_LDA(At, 0, 1); G8_STAGE(G8_SB(0, 0), b2, RB, kbb2); G8_STAGE(G8_SB(0, 1), b2 + hsb2, RB, kbb2); G8_STAGE(G8_SA(0, 0), a2, RA, kb2);
            G8_WAIT_V(8); G8_WAIT_L(0); G8_BAR; G8_MMA(1, 0, At, B0); G8_MMA(1, 1, At, B1); G8_BAR; G8_SCHED;
            G8_LDB(B0, 1, 0); G8_LDB(B1, 1, 1); G8_SCHED; G8_LDA(At, 1, 0); G8_STAGE(G8_SA(0, 1), a2 + hs2, RA, kb2);
            G8_WAIT_V(8); G8_WAIT_L(0); G8_BAR; G8_MMA(0, 0, At, B0); G8_MMA(0, 1, At, B1); G8_BAR; G8_SCHED;
            G8_LDA(At, 1, 1); G8_STAGE(G8_SB(1, 0), b3, RB, kbb2); G8_STAGE(G8_SB(1, 1), b3 + hsb2, RB, kbb2); G8_STAGE(G8_SA(1, 0), a3, RA, kb2);
            G8_WAIT_V(8); G8_WAIT_L(0); G8_BAR; G8_MMA(1, 0, At, B0); G8_MMA(1, 1, At, B1); G8_BAR; G8_SCHED;
        }
        if (wr == 0) G8_BAR;
        const bool clr = pr.epi8(acc, cur, wr, wc, fr, fq);
        if (!has_next) break;
        if (clr) {
#pragma unroll
            for (int a = 0; a < 2; ++a)
#pragma unroll
                for (int b = 0; b < 2; ++b)
#pragma unroll
                    for (int m = 0; m < 4; ++m)
#pragma unroll
                        for (int n = 0; n < 2; ++n) acc[a][b][m][n] = (f32x4){0.f, 0.f, 0.f, 0.f};
        }
        cur = nxt; cA = nA; cB = nB; ckb = nkb; ckbb = nkbb; chs = (size_t)HALF * ckb; chsb = (size_t)HALF * ckbb; ++ui;
        if (wr == 1) G8_BAR;
    }
    G8_WAIT_V(0);
    G8_BAR;
#undef G8_SA
#undef G8_SB
#undef G8_STAGE
#undef G8_LDA
#undef G8_LDB
#undef G8_MMA
#undef G8_WAIT_V
#undef G8_WAIT_L
#undef G8_BAR
#undef G8_SCHED
}
typedef int i32x8 __attribute__((ext_vector_type(8)));
typedef short s16x16a __attribute__((ext_vector_type(16), aligned(16)));
template <class Pr>
__device__ __forceinline__ void gemm8f(LAS3 unsigned char* lds, const Pr& pr) {
    const int tid = ltid(), wid = __builtin_amdgcn_readfirstlane(tid >> 6), lane = tid & 63, wr = wid >> 2, wc = wid & 3, fr = lane & 15, fq = lane >> 4;
    unsigned RA[2], RB[2], C2[2];
#pragma unroll
    for (int i = 0; i < 2; ++i) { int R, C; stage_rc(tid * 16 + i * 8192, R, C); RA[i] = (unsigned)R; RB[i] = (unsigned)((R & ~31) + perm32(R & 31)); C2[i] = (unsigned)C * 2u; }
    const size_t kstep = (size_t)(BK * 2);
    const unsigned ldsw = (unsigned)wid * 1024u;
    const int aoff = lds_byte(wr * 64 + fr, fq * 16), boff = lds_byte(wc * 32 + fr, fq * 16);
    const int sca = pr.scale_a(), scb = pr.scale_b();
#define G8_SA(b, h) (((b) * 2 + (h)) * HTB)
#define G8_SB(b, h) ((4 + (b) * 2 + (h)) * HTB)
#define G8_STAGE(bufoff, gbase, RR, kb) do { _Pragma("unroll") for (int _i = 0; _i < 2; ++_i) { \
        if ((const void*)RR == (const void*)RA) __builtin_amdgcn_global_load_lds((const unsigned*)((const char*)(gbase) + (RR[_i] * (unsigned)(kb) + C2[_i])), (LAS3 unsigned*)(lds + (bufoff) + ldsw + _i * 8192), 16, 0, G8_AUXA); \
        else __builtin_amdgcn_global_load_lds((const unsigned*)((const char*)(gbase) + (RR[_i] * (unsigned)(kb) + C2[_i])), (LAS3 unsigned*)(lds + (bufoff) + ldsw + _i * 8192), 16, 0, 0); } } while (0)
#define G8_LDA(dst, b, h) do { _Pragma("unroll") for (int m = 0; m < 4; ++m) { const bf16x8 lo_ = *(const LAS3 bf16x8*)(lds + G8_SA(b, h) + aoff + m * 2048), hi_ = *(const LAS3 bf16x8*)(lds + G8_SA(b, h) + aoff + m * 2048 + 16); dst[m] = __builtin_bit_cast(i32x8, __builtin_shufflevector(lo_, hi_, 0, 1, 2, 3, 4, 5, 6, 7, 8, 9, 10, 11, 12, 13, 14, 15)); } } while (0)
#define G8_LDB(dst, b, h) do { _Pragma("unroll") for (int n = 0; n < 2; ++n) { const bf16x8 lo_ = *(const LAS3 bf16x8*)(lds + G8_SB(b, h) + boff + n * 2048), hi_ = *(const LAS3 bf16x8*)(lds + G8_SB(b, h) + boff + n * 2048 + 16); dst[n] = __builtin_bit_cast(i32x8, __builtin_shufflevector(lo_, hi_, 0, 1, 2, 3, 4, 5, 6, 7, 8, 9, 10, 11, 12, 13, 14, 15)); } } while (0)
#define G8_MMA(ai, bj, At, Bt) do { __builtin_amdgcn_s_setprio(1); asm volatile("s_nop 1"); _Pragma("unroll") for (int m = 0; m < 4; ++m) _Pragma("unroll") for (int n = 0; n < 2; ++n) \
        asm volatile("v_mfma_scale_f32_16x16x128_f8f6f4 %0, %1, %2, %0, %3, %4 op_sel_hi:[0,0,0]" : "+v"(acc[ai][bj][m][n]) : "v"(Bt[n]), "v"(At[m]), "v"(scb), "v"(sca)); __builtin_amdgcn_s_setprio(0); } while (0)
#define G8_WAIT_V(n) asm volatile("s_waitcnt vmcnt(" #n ")" ::: "memory")
#define G8_WAIT_L(n) asm volatile("s_waitcnt lgkmcnt(" #n ")" ::: "memory")
#define G8_BAR __builtin_amdgcn_s_barrier()
#define G8_SCHED __builtin_amdgcn_sched_barrier(0)
    U8 cur, nxt; int ui = 0;
    if (!pr.unit8(0, cur)) return;
    nxt = cur;
    f32x4 acc[2][2][4][2];
#pragma unroll
    for (int a = 0; a < 2; ++a)
#pragma unroll
        for (int b = 0; b < 2; ++b)
#pragma unroll
            for (int m = 0; m < 4; ++m)
#pragma unroll
                for (int n = 0; n < 2; ++n) acc[a][b][m][n] = (f32x4){0.f, 0.f, 0.f, 0.f};
    i32x8 At[4], B0[2], B1[2];
    const char* cA = cur.a; const char* cB = cur.b; int ckb = cur.kb, ckbb = cur.kbb; size_t chs = (size_t)HALF * ckb, chsb = (size_t)HALF * ckbb;
    G8_STAGE(G8_SB(0, 0), cB, RB, ckbb); G8_STAGE(G8_SB(0, 1), cB + chsb, RB, ckbb); G8_STAGE(G8_SA(0, 0), cA, RA, ckb); G8_STAGE(G8_SA(0, 1), cA + chs, RA, ckb);
    if (wr == 1) G8_BAR;
    G8_WAIT_V(2); G8_BAR;
    G8_STAGE(G8_SB(1, 0), cB + kstep, RB, ckbb); G8_STAGE(G8_SA(1, 0), cA + kstep, RA, ckb); G8_STAGE(G8_SB(1, 1), cB + chsb + kstep, RB, ckbb);
    G8_WAIT_V(6); G8_BAR;
    for (;;) {
        const bool has_next = pr.unit8(ui + 1, nxt);
        const char* nA = has_next ? nxt.a : cA; const char* nB = has_next ? nxt.b : cB; const int nkb = has_next ? nxt.kb : ckb, nkbb = has_next ? nxt.kbb : ckbb;
        const int nt = cur.nt;
        for (int t = 0; t < nt; t += 2) {
            const bool last = (t == nt - 2);
            const char* a1 = cA + (size_t)(t + 1) * kstep;
            const char* a2 = last ? nA : cA + (size_t)(t + 2) * kstep; const char* b2 = last ? nB : cB + (size_t)(t + 2) * kstep;
            const int kb2 = last ? nkb : ckb, kbb2 = last ? nkbb : ckbb; const size_t hs2 = (size_t)HALF * kb2, hsb2 = (size_t)HALF * kbb2;
            const char* a3 = a2 + kstep; const char* b3 = b2 + kstep;
            G8_LDB(B0, 0, 0); G8_LDB(B1, 0, 1); G8_SCHED; G8_LDA(At, 0, 0); G8_STAGE(G8_SA(1, 1), a1 + chs, RA, ckb);
            G8_WAIT_V(8); G8_WAIT_L(0); G8_BAR; G8_MMA(0, 0, At, B0); G8_MMA(0, 1, At, B1); G8_BAR; G8_SCHED;
            G8_LDA(At, 0, 1); G8_STAGE(G8_SB(0, 0), b2, RB, kbb2); G8_STAGE(G8_SB(0, 1), b2 + hsb2, RB, kbb2); G8_STAGE(G8_SA(0, 0), a2, RA, kb2);
            G8_WAIT_V(8); G8_WAIT_L(0); G8_BAR; G8_MMA(1, 0, At, B0); G8_MMA(1, 1, At, B1); G8_BAR; G8_SCHED;
            G8_LDB(B0, 1, 0); G8_LDB(B1, 1, 1); G8_SCHED; G8_LDA(At, 1, 0); G8_STAGE(G8_SA(0, 1), a2 + hs2, RA, kb2);
            G8_WAIT_V(8); G8_WAIT_L(0); G8_BAR; G8_MMA(0, 0, At, B0); G8_MMA(0, 1, At, B1); G8_BAR; G8_SCHED;
            G8_LDA(At, 1, 1); G8_STAGE(G8_SB(1, 0), b3, RB, kbb2); G8_STAGE(G8_SB(1, 1), b3 + hsb2, RB, kbb2); G8_STAGE(G8_SA(1, 0), a3, RA, kb2);
            G8_WAIT_V(8); G8_WAIT_L(0); G8_BAR; G8_MMA(1, 0, At, B0); G8_MMA(1, 1, At, B1); G8_BAR; G8_SCHED;
        }
        asm volatile("s_nop 7\n\ts_nop 7\n\ts_nop 7" : "+v"(acc[1][0][0][0]), "+v"(acc[1][0][0][1]), "+v"(acc[1][0][1][0]), "+v"(acc[1][0][1][1]), "+v"(acc[1][0][2][0]), "+v"(acc[1][0][2][1]), "+v"(acc[1][0][3][0]), "+v"(acc[1][0][3][1]), "+v"(acc[1][1][0][0]), "+v"(acc[1][1][0][1]), "+v"(acc[1][1][1][0]), "+v"(acc[1][1][1][1]), "+v"(acc[1][1][2][0]), "+v"(acc[1][1][2][1]), "+v"(acc[1][1][3][0]), "+v"(acc[1][1][3][1]) :: "memory");
        if (wr == 0) G8_BAR;
        const bool clr = pr.epi8(acc, cur, wr, wc, fr, fq);
        if (!has_next) break;
        if (clr) {
#pragma unroll
            for (int a = 0; a < 2; ++a)
#pragma unroll
                for (int b = 0; b < 2; ++b)
#pragma unroll
                    for (int m = 0; m < 4; ++m)
#pragma unroll
                        for (int n = 0; n < 2; ++n) acc[a][b][m][n] = (f32x4){0.f, 0.f, 0.f, 0.f};
        }
        cur = nxt; cA = nA; cB = nB; ckb = nkb; ckbb = nkbb; chs = (size_t)HALF * ckb; chsb = (size_t)HALF * ckbb; ++ui;
        if (wr == 1) G8_BAR;
    }
    G8_WAIT_V(0);
    G8_BAR;
#undef G8_SA
#undef G8_SB
#undef G8_STAGE
#undef G8_LDA
#undef G8_LDB
#undef G8_MMA
#undef G8_WAIT_V
#undef G8_WAIT_L
#undef G8_BAR
#undef G8_SCHED
}
}

template <class Base> struct Dense8 : Base {
    __device__ bool unit8(int i, g8::U8& u) const { int pm, pn; if (!g8::order8(i * (int)gridDim.x + (int)blockIdx.x, this->ntm, this->ntn, pm, pn)) return false; pm += this->tm0;
        u.pm = pm; u.pn = pn; u.kind = 0; u.kb = (int)this->lda * 2; u.kbb = (int)this->ldb * 2; u.nt = this->Kd / 64; u.a = (const char*)(this->A + (size_t)pm * 256 * this->lda); u.b = (const char*)(this->Bt + (size_t)pn * 256 * this->ldb); return true; }
    __device__ bool epi8(Acc& acc, const g8::U8& u, int wr, int wc, int fr, int fq) const { this->epi(acc, u.pm, u.pn, wr, wc, fr, fq); return true; }
};
template <class Base> struct Dense8F : Base {
    int sa_, sb_;
    __device__ int scale_a() const { return sa_; }
    __device__ int scale_b() const { return sb_; }
    __device__ bool unit8(int i, g8::U8& u) const { int pm, pn; if (!g8::order8(i * (int)gridDim.x + (int)blockIdx.x, this->ntm, this->ntn, pm, pn)) return false; pm += this->tm0;
        u.pm = pm; u.pn = pn; u.kind = 0; u.kb = (int)this->lda; u.kbb = (int)this->ldb; u.nt = this->Kd / 128; u.a = (const char*)this->A + (size_t)pm * 256 * this->lda; u.b = (const char*)this->Bt + (size_t)pn * 256 * this->ldb; return true; }
    __device__ bool epi8(Acc& acc, const g8::U8& u, int wr, int wc, int fr, int fq) const { this->epi(acc, u.pm, u.pn, wr, wc, fr, fq); return true; }
};
struct In12 { const u16* A; const u16* Wt; u16* Orw; u16* Os5;
    __device__ bool unit8(int i, g8::U8& u) const { int pm, pn; if (!g8::order8(i * (int)gridDim.x + (int)blockIdx.x, 144, 10, pm, pn)) return false;
        u.pm = pm; u.pn = pn; u.kind = 0; u.kb = 2048; u.kbb = 2048; u.nt = 16; u.a = (const char*)(A + (size_t)pm * 256 * 1024);
        u.b = (const char*)(Wt + (size_t)((pn < 8 ? 1536 + pn * 256 : 3584 + (pn - 8) * 256)) * 1024); return true; }
    __device__ bool epi8(Acc& acc, const g8::U8& u, int wr, int wc, int fr, int fq) const {
        u16* O = u.pn < 8 ? Orw : Os5; const long ldo = u.pn < 8 ? 2048 : 512; const int cb = (u.pn < 8 ? u.pn : u.pn - 8) * 256;
#pragma unroll
        for (int a = 0; a < 2; ++a)
#pragma unroll
            for (int m = 0; m < 4; ++m) { const size_t row = (size_t)u.pm * 256 + a * 128 + wr * 64 + m * 16 + fr;
#pragma unroll
                for (int b = 0; b < 2; ++b) { const int col = cb + b * 128 + wc * 32 + fq * 8; const f32x4 v0 = acc[a][b][m][0], v1 = acc[a][b][m][1];
                    u32x4 w; w.x = pk2(v0[0], v0[1]); w.y = pk2(v0[2], v0[3]); w.z = pk2(v1[0], v1[1]); w.w = pk2(v1[2], v1[3]);
                    stc_16(O + row * ldo + col, w); } }
        return true; }
};
struct MoeUp8 : PrMoeUp { const u16* xb;
    __device__ bool unit8(int i, g8::U8& u) const { int nM = uni((int)ldc_u32(mi + 25)) - t0; nM = nM < 0 ? 0 : (nM > nt ? nt : nM); int pm, pn; if (!g8::order8(i * (int)gridDim.x + (int)blockIdx.x, nM, 28, pm, pn)) return false; pm += t0;
        u.pm = pm; u.pn = pn; u.kind = 0; u.kb = 2048; u.kbb = 2048; u.nt = 16; u.a = (const char*)(xb + (size_t)pm * 256 * 1024); u.b = (const char*)(W + ((size_t)uni((int)ldc_u32(mi + 32 + pm)) * 7168 + pn * 256) * 1024); return true; }
    __device__ bool epi8(Acc& acc, const g8::U8& u, int wr, int wc, int fr, int fq) const { this->epi(acc, u.pm, u.pn, wr, wc, fr, fq); return true; }
};
struct MoeDown8 : PrMoeDown {
    __device__ bool unit8(int i, g8::U8& u) const { int nM = uni((int)ldc_u32(mi + 25)) - t0; nM = nM < 0 ? 0 : (nM > nt ? nt : nM); int pm, pn; if (!g8::order8(i * (int)gridDim.x + (int)blockIdx.x, nM, 4, pm, pn)) return false; pm += t0;
        u.pm = pm; u.pn = pn; u.kind = 0; u.kb = 7168; u.kbb = 7168; u.nt = 56; u.a = (const char*)(G + (size_t)(pm - t0) * 256 * 3584); u.b = (const char*)(W + ((size_t)uni((int)ldc_u32(mi + 32 + pm)) * 1024 + pn * 256) * 3584); return true; }
    __device__ bool epi8(Acc& acc, const g8::U8& u, int wr, int wc, int fr, int fq) const { this->epi(acc, u.pm, u.pn, wr, wc, fr, fq); return true; }
};
struct Branch8 { const u16* y; const u16* wt; const u16* G; u16* acc; int tm0, ntm;
    __device__ bool unit8(int i, g8::U8& u) const { const int ti = i >> 2, m = i & 3; int pm, pn; if (!g8::order8(ti * (int)gridDim.x + (int)blockIdx.x, ntm, 4, pm, pn)) return false; pm += tm0;
        u.pm = pm; u.pn = pn; u.kind = m; u.kb = 1024; u.kbb = 1024; u.nt = 8; u.a = (const char*)(y + ((size_t)m * MT + (size_t)pm * 256) * 512); u.b = (const char*)(wt + ((size_t)m * 1024 + pn * 256) * 512); return true; }
    __device__ bool epi8(Acc& acc_, const g8::U8& u, int wr, int wc, int fr, int fq) const {
        const int m = u.kind;
#pragma unroll
        for (int a = 0; a < 2; ++a)
#pragma unroll
            for (int mm = 0; mm < 4; ++mm) { const size_t row = (size_t)u.pm * 256 + a * 128 + wr * 64 + mm * 16 + fr;
#pragma unroll
                for (int b = 0; b < 2; ++b) { const int col = u.pn * 256 + b * 128 + wc * 32 + fq * 8;
                    float gv[8], o[8]; unpack8(ldc_16(G + row * 4096 + m * 1024 + col), gv);
                    u16* ap = acc + row * 1024 + col;
                    if (m == 0) {
#pragma unroll
                        for (int j = 0; j < 8; ++j) o[j] = 0.f; }
                    else unpack8(*(const u32x4*)ap, o);
#pragma unroll
                    for (int j = 0; j < 4; ++j) { o[j] += gv[j] * acc_[a][b][mm][0][j]; o[4 + j] += gv[4 + j] * acc_[a][b][mm][1][j]; }
                    const u32x4 w = pack8(o);
                    if (m == 3) stc_16(ap, w); else *(u32x4*)ap = w; } }
        return true; }
};
struct MoeUp8F { const char* xb8; const int* mi; const char* W8; char* G8; int t0, nt;
    __device__ int scale_a() const { return 127; }
    __device__ int scale_b() const { return 122; }
    __device__ bool unit8(int i, g8::U8& u) const { int nM = uni((int)ldc_u32(mi + 25)) - t0; nM = nM < 0 ? 0 : (nM > nt ? nt : nM); int pm, pn; if (!g8::order8(i * (int)gridDim.x + (int)blockIdx.x, nM, 28, pm, pn)) return false; pm += t0;
        u.pm = pm; u.pn = pn; u.kind = 0; u.kb = 1024; u.kbb = 1024; u.nt = 8; u.a = xb8 + (size_t)pm * 256 * 1024; u.b = W8 + ((size_t)uni((int)ldc_u32(mi + 32 + pm)) * 7168 + pn * 256) * 1024; return true; }
    __device__ bool epi8(Acc& acc, const g8::U8& u, int wr, int wc, int fr, int fq) const {
#pragma unroll
        for (int a = 0; a < 2; ++a)
#pragma unroll
            for (int m = 0; m < 4; ++m) { const size_t row = (size_t)(u.pm - t0) * 256 + a * 128 + wr * 64 + m * 16 + fr; const int col = u.pn * 128 + wc * 32 + fq * 8;
                float o[8];
#pragma unroll
                for (int n = 0; n < 2; ++n)
#pragma unroll
                    for (int j = 0; j < 4; ++j) { const float x = acc[a][0][m][n][j]; o[n * 4 + j] = 4.f * x * sigm(x) * acc[a][1][m][n][j]; }
                u32x2 w; w.x = pk4_fp8(o[0], o[1], o[2], o[3]); w.y = pk4_fp8(o[4], o[5], o[6], o[7]);
                stc_8(G8 + row * 3584 + col, w); }
        return true; }
};
struct MoeDown8F { const char* G8; const int* mi; const char* W8; u16* yb; int t0, nt;
    __device__ int scale_a() const { return 125; }
    __device__ int scale_b() const { return 122; }
    __device__ bool unit8(int i, g8::U8& u) const { int nM = uni((int)ldc_u32(mi + 25)) - t0; nM = nM < 0 ? 0 : (nM > nt ? nt : nM); int pm, pn; if (!g8::order8(i * (int)gridDim.x + (int)blockIdx.x, nM, 4, pm, pn)) return false; pm += t0;
        u.pm = pm; u.pn = pn; u.kind = 0; u.kb = 3584; u.kbb = 3584; u.nt = 28; u.a = G8 + (size_t)(pm - t0) * 256 * 3584; u.b = W8 + ((size_t)uni((int)ldc_u32(mi + 32 + pm)) * 1024 + pn * 256) * 3584; return true; }
    __device__ bool epi8(Acc& acc, const g8::U8& u, int wr, int wc, int fr, int fq) const {
#pragma unroll
        for (int a = 0; a < 2; ++a)
#pragma unroll
            for (int m = 0; m < 4; ++m) { const size_t row = (size_t)u.pm * 256 + a * 128 + wr * 64 + m * 16 + fr;
#pragma unroll
                for (int b = 0; b < 2; ++b) { const int col = u.pn * 256 + b * 128 + wc * 32 + fq * 8; const f32x4 v0 = acc[a][b][m][0], v1 = acc[a][b][m][1];
                    u32x4 w; w.x = pk2(v0[0], v0[1]); w.y = pk2(v0[2], v0[3]); w.z = pk2(v1[0], v1[1]); w.w = pk2(v1[2], v1[3]);
                    stc_16(yb + row * 1024 + col, w); } }
        return true; }
};
#define GEMM8(pr) g8::gemm8((LAS3 unsigned char*)smem, pr)
#define GEMM8F(pr) g8::gemm8f((LAS3 unsigned char*)smem, pr)

__device__ __forceinline__ void seq_of(int row, int& base, int& t, int& L) {
    if (row < RC) { t = row & 255; L = 256; } else { t = (row - RC) & 2047; L = 2048; }
    base = row - t;
}
__device__ __forceinline__ void mfma_safe(f32x4& acc, const bf16x8 a, const bf16x8 b) {
    acc = __builtin_amdgcn_mfma_f32_16x16x32_bf16(a, b, acc, 0, 0, 0);
    asm volatile("" :: "v"(acc), "v"(a), "v"(b));
}
__device__ __forceinline__ void mfma_ip(f32x4& acc, const bf16x8 a, const bf16x8 b) { asm volatile("v_mfma_f32_16x16x32_bf16 %0, %1, %2, %0" : "+v"(acc) : "v"(a), "v"(b)); }
__device__ __forceinline__ void mfma_settle() { asm volatile("s_nop 7\n\ts_nop 7\n\ts_nop 3" ::: "memory"); }
#define HY_UTL(p) ((u16*)((p).arena + (size_t)MT * 1536 * 2))
#define HY_UTC(p) (HY_UTL(p) + (size_t)512 * 16 * 2048)
#define HY_YTL(p) (HY_UTC(p) + (size_t)512 * 16 * 256)
#define HY_YTC(p) (HY_YTL(p) + (size_t)512 * 16 * 2048)
__device__ __forceinline__ void ph_hy_pre(PP pp, int l) {
    PREF; l = uni(l); const u16* ph = (const u16*)p.arena;
    u16* T = (u16*)smem;
    const int w = tix >> 6, lane = tix & 63, tg = lane >> 3, cg = lane & 7, c0 = w * 64 + cg * 8, s0 = tg * 8;
    const float* cw = p.in[I_hy_conv_w] + l * 3 * 1536; const float* cb = p.in[I_hy_conv_b] + l * 1536;
    for (int tt = (l ? 64 : 0) + blockIdx.x; tt < 576; tt += gridDim.x) {
        const int row0 = tt * 64; int b, t0, L; u16* utb;
        if (row0 < RC) { b = row0 >> 8; t0 = row0 & 255; L = 256; utb = HY_UTC(p) + (size_t)b * 256 + t0; }
        else { b = (row0 - RC) >> 11; t0 = (row0 - RC) & 2047; L = 2048; utb = HY_UTL(p) + (size_t)b * 2048 + t0; }
        float uu[8][8];
#pragma unroll
        for (int j = 0; j < 3; ++j) {
            float w0[8], w1[8], w2[8], bb[8];
#pragma unroll
            for (int e4 = 0; e4 < 2; ++e4) { const f32x4 a0 = *(const f32x4*)(cw + j * 512 + c0 + e4 * 4), a1 = *(const f32x4*)(cw + 1536 + j * 512 + c0 + e4 * 4), a2 = *(const f32x4*)(cw + 3072 + j * 512 + c0 + e4 * 4), a3 = *(const f32x4*)(cb + j * 512 + c0 + e4 * 4);
#pragma unroll
                for (int e = 0; e < 4; ++e) { w0[e4 * 4 + e] = a0[e]; w1[e4 * 4 + e] = a1[e]; w2[e4 * 4 + e] = a2[e]; bb[e4 * 4 + e] = a3[e]; } }
            u32x4 raw[10];
#pragma unroll
            for (int r = 0; r < 10; ++r) { const int t = t0 + s0 - 1 + r; raw[r] = (u32x4){0u, 0u, 0u, 0u};
                if (t >= 0 && t < L) raw[r] = ldc_16(ph + (size_t)(row0 + s0 - 1 + r) * 1536 + j * 512 + c0); }
            float xr[10][8];
#pragma unroll
            for (int r = 0; r < 10; ++r) unpack8(raw[r], xr[r]);
#pragma unroll
            for (int i = 0; i < 8; ++i) {
                float r8[8];
#pragma unroll
                for (int e = 0; e < 8; ++e) r8[e] = xr[i][e] * w0[e] + xr[i + 1][e] * w1[e] + xr[i + 2][e] * w2[e] + bb[e];
                if (j == 0) stc_16(p.y + ((size_t)row0 + s0 + i) * 512 + c0, pack8(r8));
                else if (j == 1) {
#pragma unroll
                    for (int e = 0; e < 8; ++e) uu[i][e] = r8[e]; }
                else {
#pragma unroll
                    for (int e = 0; e < 8; ++e) uu[i][e] = r8[e] * uu[i][e]; }
            }
        }
        __syncthreads();
#pragma unroll
        for (int e = 0; e < 8; ++e) { u32x4 wv; wv.x = pk2(uu[0][e], uu[1][e]); wv.y = pk2(uu[2][e], uu[3][e]); wv.z = pk2(uu[4][e], uu[5][e]); wv.w = pk2(uu[6][e], uu[7][e]); *(u32x4*)(T + (c0 + e) * 72 + s0) = wv; }
        __syncthreads();
        { const int c = tix;
#pragma unroll
          for (int k8 = 0; k8 < 8; ++k8) stc_16(utb + (size_t)c * 16 * L + k8 * 8, *(const u32x4*)(T + c * 72 + k8 * 8)); }
    }
}
template <int L>
__device__ __forceinline__ void hy_conv_items(const u16* rvg, const u16* utg, u16* ytg, char* smem, const int tix) {
    constexpr int TPW = L / 128, CPN = 2 * L + 16, OFS = L + 8, RS = L + 8, NKS = L / 32, UNR = TPW / 2;
    u16* cp = (u16*)smem; u16* us = cp + 8 * CPN;
    const int wid = tix >> 6, lane = tix & 63, r = lane & 15, q = lane >> 4;
    const int a = (8 - (r & 7)) & 7;
    const int tb = a * CPN + 8 * q - r - a + OFS;
    const int ubs = r * RS + 8 * q;
    const int t_w = wid * (TPW * 16);
    for (int c = blockIdx.x; c < 512; c += gridDim.x) {
        __syncthreads();
        for (int idx = tix; idx < 8 * CPN; idx += NT) { const int a_ = idx / CPN, xi = idx - a_ * CPN; const int g = xi - OFS + a_ + L; cp[idx] = (g >= 0 && g < 2 * L) ? rvg[(size_t)c * (2 * L) + g] : (u16)0; }
        for (int pc = tix; pc < 16 * (L / 8); pc += NT) { const int b = pc / (L / 8), k8 = pc - b * (L / 8); *(u32x4*)(us + b * RS + k8 * 8) = ldc_16(utg + ((size_t)c * 16 + b) * L + k8 * 8); }
        __syncthreads();
        f32x4 acc[TPW]; bf16x8 W[TPW];
#pragma unroll
        for (int i = 0; i < TPW; ++i) { acc[i] = (f32x4){0.f, 0.f, 0.f, 0.f}; W[i] = *(const bf16x8*)(cp + tb - (t_w + 16 * i)); }
        for (int ks0 = 0; ks0 < NKS; ks0 += UNR) {
#pragma unroll
            for (int u = 0; u < UNR; ++u) {
                const int ks = ks0 + u;
                const bf16x8 U = *(const bf16x8*)(us + ubs + 32 * ks);
#pragma unroll
                for (int i = TPW - 2; i < TPW; ++i) mfma_safe(acc[i], W[(i - 2 * u + 2 * TPW) % TPW], U);
#pragma unroll
                for (int i = 0; i < 2; ++i) W[(i - 2 * (u + 1) + 2 * TPW) % TPW] = *(const bf16x8*)(cp + tb + 32 * (ks + 1) - (t_w + 16 * i));
#pragma unroll
                for (int i = 0; i < TPW - 2; ++i) mfma_safe(acc[i], W[(i - 2 * u + 2 * TPW) % TPW], U);
            }
        }
#pragma unroll
        for (int i = 0; i < TPW; ++i) { u32x2 w; w.x = pk2(acc[i][0], acc[i][1]); w.y = pk2(acc[i][2], acc[i][3]); stc_8(ytg + ((size_t)c * 16 + r) * L + t_w + 16 * i + 4 * q, w); }
    }
}
__device__ __forceinline__ void ph_hy_conv(PP pp, int l) {
    PREF; l = uni(l);
    hy_conv_items<2048>(p.rvl + (size_t)l * 512 * 4096, HY_UTL(p), HY_YTL(p), smem, tix);
    if (l == 0) hy_conv_items<256>(p.rvc + (size_t)l * 512 * 512, HY_UTC(p), HY_YTC(p), smem, tix);
}
__device__ __forceinline__ void ph_hy_post(PP pp, int l, int shadow) {
    PREF; l = uni(l); (void)shadow;
    u16* T = (u16*)smem;
    const int w = tix >> 6, lane = tix & 63, tg = lane >> 3, cg = lane & 7, c0 = w * 64 + cg * 8, s0 = tg * 8;
    for (int tt = (l ? 64 : 0) + blockIdx.x; tt < 576; tt += gridDim.x) {
        const int row0 = tt * 64; const u16* yt;
        if (row0 < RC) yt = HY_YTC(p) + ((size_t)tix * 16 + (row0 >> 8)) * 256 + (row0 & 255);
        else yt = HY_YTL(p) + ((size_t)tix * 16 + ((row0 - RC) >> 11)) * 2048 + ((row0 - RC) & 2047);
        u32x4 v[8], xr[8];
#pragma unroll
        for (int k = 0; k < 8; ++k) v[k] = ldc_16(yt + 8 * k);
#pragma unroll
        for (int i = 0; i < 8; ++i) xr[i] = ldc_16(p.y + ((size_t)row0 + s0 + i) * 512 + c0);
        __syncthreads();
#pragma unroll
        for (int k = 0; k < 8; ++k) *(u32x4*)(T + tix * 72 + 8 * k) = v[k];
        __syncthreads();
#pragma unroll
        for (int i = 0; i < 8; ++i) { float x0[8], o[8]; unpack8(xr[i], x0);
#pragma unroll
            for (int e = 0; e < 8; ++e) o[e] = x0[e] * bf2f(T[(c0 + e) * 72 + s0 + i]);
            stc_16(p.y + ((size_t)row0 + s0 + i) * 512 + c0, pack8(o)); }
    }
}

__device__ __forceinline__ void ph_rw_scan(PP pp, int l) {
    PREF; l = uni(l); const u16* pr = (const u16*)p.arena; u16* ob = (u16*)(p.arena + (size_t)MT * 2048 * 2); float* bon = (float*)(p.arena + (size_t)MT * 2048 * 2 + (size_t)2 * MT * 512 * 2);
    const int tid = tix, wid = tid >> 6, lane = tid & 63;
    u16* WUt = (u16*)smem;
    u16* AUt = WUt + 64 * 72;
    u16* RAW = AUt + 64 * 72;
    u16* TWb = RAW + 34 * 320;
    u16* ADb = TWb + 32 * 72;
    float* Ks = (float*)(ADb + 32 * 72);
    float* KKv = Ks + 2048; float* Rv = KKv + 2048; float* Vv = Rv + 2048; float* Wv = Vv + 2048; float* Bv = Wv + 2048; float* KDv = Bv + 2048;
    float* bonp = KDv + 2048;
    float* Oc = bonp + 128;
    u16* KT = RAW; u16* BT = KT + 32 * 72; u16* KD = BT + 32 * 72; u16* RT = KD + 32 * 72; u16* AB = RT + 32 * 72; u16* CC = AB + 2 * 16 * 40; u16* Tm = CC + 2 * 16 * 40;
    float* Amat = (float*)(Tm + 2 * 16 * 40);
    float* CUMS = Ks;
    u16* MtT = (u16*)KKv;
    u16* BKt = (u16*)(Oc + 2048);
    u16* UVt = BKt + 2 * 64 * 40;
    u16* Sb = UVt + 2 * 64 * 40;
    float* MUs = (float*)(Sb + 64 * 72);
    float* KKs = MUs + 640;
    float* PC = KKs + 64;
    const int pt = tid >> 4, pc4 = (tid & 15) * 4;
    const int r4 = lane >> 4, kq = lane & 15, v0 = wid * 8 + r4 * 2;
    const int tt = wid >> 2, ct = wid & 3, ech = ct * 16 + (lane & 15), eq = lane >> 4;
    for (int sid = blockIdx.x; sid < 256; sid += gridDim.x) {
        const int b = sid >> 4, h = (sid >> 1) & 7, d = sid & 1;
        __syncthreads();
        for (int i = tid; i < 4096; i += NT) { const int m = i >> 6, ch = i & 63;
            WUt[ch * 72 + m] = f2bf(p.in[I_rw_w_up][((size_t)(l * 2 + d) * 64 + m) * 512 + h * 64 + ch]);
            AUt[ch * 72 + m] = f2bf(p.in[I_rw_a_up][((size_t)(l * 2 + d) * 64 + m) * 512 + h * 64 + ch]); }
        const int cbase[5] = {h * 64, 512 + h * 64, 1024 + h * 64, 1536 + d * 64, 1664 + d * 64};
        for (int i = tid; i < 704; i += NT) { const int ch = i & 63, j = (i >> 6) % 5, wh = i / 320;
            MUs[i] = i < 640 ? p.in[I_rw_mu][(size_t)(l * 2 + wh) * 1920 + cbase[j] + ch] : p.in[I_rw_k_k][l * 512 + h * 64 + ch]; }
        const float e_w0 = p.in[I_rw_w0][(l * 2 + d) * 512 + h * 64 + ech], e_a0 = p.in[I_rw_a0][(l * 2 + d) * 512 + h * 64 + ech], e_ka = p.in[I_rw_k_a][l * 512 + h * 64 + ech], e_rk = p.in[I_rw_r_k][l * 512 + h * 64 + ech];
        f32x4 SS[4];
#pragma unroll
        for (int i = 0; i < 4; ++i) SS[i] = (f32x4){0.f, 0.f, 0.f, 0.f};
        for (int i = tid; i < 2 * 64 * 40 + 64 * 72; i += NT) UVt[i] = (u16)0;
        int prev_row0 = -1;
#define RW_GEOM(fc, L_, base_, tlo_) const int L_ = (fc) < 8 ? 256 : 2048, base_ = (fc) < 8 ? b * 256 : RC + b * 2048, tlo_ = d ? L_ - 32 * (((fc) < 8 ? (fc) : (fc) - 8) + 1) : 32 * ((fc) < 8 ? (fc) : (fc) - 8)
#define RW_FETCH(fc) do { RW_GEOM(fc, Lf, basef, tlof); _Pragma("unroll") for (int i3 = 0; i3 < 3; ++i3) { const int i = tid + i3 * NT; const int rr = i / 40, c8 = i - rr * 40; const int t = tlof - 1 + rr; const int j = c8 >> 3; \
            u32x4 v = (u32x4){0u, 0u, 0u, 0u}; if (i < 34 * 40 && t >= 0 && t < Lf) v = ldc_16(pr + ((size_t)basef + t) * 2048 + cbase[j] + (c8 & 7) * 8); rawreg[i3] = v; } } while (0)
        u32x4 rawreg[3];
        RW_FETCH(0);
        for (int fc = 0; fc < 72; ++fc) {
            {
                RW_GEOM(fc, L, base, t_lo); (void)L;
                __syncthreads();
                if (prev_row0 >= 0) { const f32x4 o = *(const f32x4*)(Oc + pt * 64 + pc4); stc_8(ob + ((size_t)d * MT + prev_row0 + pt) * 512 + h * 64 + pc4, pk4bf(o)); }
#pragma unroll
                for (int i3 = 0; i3 < 3; ++i3) { const int i = tid + i3 * NT; const int rr = i / 40, c8 = i - rr * 40; if (i < 34 * 40) *(u32x4*)(RAW + rr * 320 + c8 * 8) = rawreg[i3]; }
                __syncthreads();
                for (int rwr_ = 0; rwr_ < 1 + ((RWREP >> 0) & 1); ++rwr_) { if (rwr_) __syncthreads();
                {
                    float x[5][4];
#pragma unroll
                    for (int j = 0; j < 5; ++j) { const u32x2 a = *(const u32x2*)(RAW + pt * 320 + j * 64 + pc4), c = *(const u32x2*)(RAW + (pt + 1) * 320 + j * 64 + pc4), n = *(const u32x2*)(RAW + (pt + 2) * 320 + j * 64 + pc4);
                        const float pm[4] = {__uint_as_float(a.x << 16), __uint_as_float(a.x & 0xffff0000u), __uint_as_float(a.y << 16), __uint_as_float(a.y & 0xffff0000u)};
                        const float pc[4] = {__uint_as_float(c.x << 16), __uint_as_float(c.x & 0xffff0000u), __uint_as_float(c.y << 16), __uint_as_float(c.y & 0xffff0000u)};
                        const float pn[4] = {__uint_as_float(n.x << 16), __uint_as_float(n.x & 0xffff0000u), __uint_as_float(n.y << 16), __uint_as_float(n.y & 0xffff0000u)};
                        const f32x4 m0 = *(const f32x4*)(MUs + j * 64 + pc4), m1 = *(const f32x4*)(MUs + 320 + j * 64 + pc4);
#pragma unroll
                        for (int e = 0; e < 4; ++e) x[j][e] = pc[e] + m0[e] * (pm[e] - pc[e]) + m1[e] * (pn[e] - pc[e]); }
                    float kr[4], ss = 0.f;
                    const f32x4 kk_k = *(const f32x4*)(KKs + pc4);
#pragma unroll
                    for (int e = 0; e < 4; ++e) { kr[e] = x[1][e] * kk_k[e]; ss += kr[e] * kr[e]; }
                    ss = rowsum16(ss);
                    const float inv = frcp(fmaxf(__builtin_amdgcn_sqrtf(ss), 1e-12f));
                    *(f32x4*)(Rv + pt * 64 + pc4) = (f32x4){x[0][0], x[0][1], x[0][2], x[0][3]};
                    *(f32x4*)(Ks + pt * 64 + pc4) = (f32x4){x[1][0], x[1][1], x[1][2], x[1][3]};
                    *(f32x4*)(Vv + pt * 64 + pc4) = (f32x4){x[2][0], x[2][1], x[2][2], x[2][3]};
                    *(f32x4*)(KKv + pt * 64 + pc4) = (f32x4){kr[0] * inv, kr[1] * inv, kr[2] * inv, kr[3] * inv};
                    u32x2 tw, ad; tw.x = pk2(ftanh(x[3][0]), ftanh(x[3][1])); tw.y = pk2(ftanh(x[3][2]), ftanh(x[3][3])); ad.x = pk2(x[4][0], x[4][1]); ad.y = pk2(x[4][2], x[4][3]);
                    *(u32x2*)(TWb + pt * 72 + pc4) = tw; *(u32x2*)(ADb + pt * 72 + pc4) = ad;
                }
                }
                __syncthreads();
                for (int rwr_ = 0; rwr_ < 1 + ((RWREP >> 1) & 1); ++rwr_) { if (rwr_) __syncthreads();
                {
                    f32x4 dw = (f32x4){0.f, 0.f, 0.f, 0.f}, da = dw;
#pragma unroll
                    for (int ks = 0; ks < 2; ++ks) {
                        const bf16x8 aw = *(const bf16x8*)(TWb + (tt * 16 + (lane & 15)) * 72 + ks * 32 + eq * 8), aa = *(const bf16x8*)(ADb + (tt * 16 + (lane & 15)) * 72 + ks * 32 + eq * 8);
                        const bf16x8 bw = *(const bf16x8*)(WUt + ech * 72 + ks * 32 + eq * 8), ba = *(const bf16x8*)(AUt + ech * 72 + ks * 32 + eq * 8);
                        mfma_safe(dw, aw, bw); mfma_safe(da, aa, ba);
                    }
                    float lw[4], kap[4], bet[4], kdv[4], rr[4], vvv[4];
#pragma unroll
                    for (int j = 0; j < 4; ++j) { const int tok = tt * 16 + eq * 4 + j;
                        const float wv = -0.606531f * sigm(e_w0 + dw[j]), av = sigm(e_a0 + da[j]);
                        const float ks_ = Ks[tok * 64 + ech], kkv = KKv[tok * 64 + ech], rs = Rv[tok * 64 + ech];
                        const float kd = ks_ * (1.f + (av - 1.f) * e_ka);
                        lw[j] = wv; kap[j] = kkv; bet[j] = kkv * av; kdv[j] = kd; rr[j] = rs; vvv[j] = Vv[tok * 64 + ech];
                        const float bs = rowsum16(rs * kd * e_rk);
                        if ((lane & 15) == 0) bonp[ct * 32 + tok] = bs; }
                    {
                        float pf[4];
                        if (!d) { pf[0] = lw[0]; pf[1] = pf[0] + lw[1]; pf[2] = pf[1] + lw[2]; pf[3] = pf[2] + lw[3]; }
                        else { pf[3] = lw[3]; pf[2] = pf[3] + lw[2]; pf[1] = pf[2] + lw[1]; pf[0] = pf[1] + lw[0]; }
                        const float gt = d ? pf[0] : pf[3];
                        float inc = gt;
                        { const float u1 = __int_as_float(__builtin_amdgcn_ds_bpermute((lane - 16) * 4, __float_as_int(inc))); if (eq >= 1) inc += u1; }
                        { const float u2 = __int_as_float(__builtin_amdgcn_ds_bpermute((lane - 32) * 4, __float_as_int(inc))); if (eq >= 2) inc += u2; }
                        const float tile_tot = __int_as_float(__builtin_amdgcn_ds_bpermute((48 + (lane & 15)) * 4, __float_as_int(inc)));
                        const float excl = d ? tile_tot - inc : inc - gt;
                        const int c = d ? 1 - tt : tt;
                        const int i0 = d ? 12 - 4 * eq : 4 * eq;
                        float bt4[4], kd4[4], vv4[4];
#pragma unroll
                        for (int j = 0; j < 4; ++j) { const float cum = pf[j] + excl, P = fexp(cum), Pm1 = fexp(cum - lw[j]), rP = fexp(-cum);
                            const int ii = d ? 3 - j : j, sp = c * 16 + i0 + ii;
                            KT[sp * 72 + ech] = f2bf(kap[j] * Pm1); BT[sp * 72 + ech] = f2bf(bet[j] * rP); KD[sp * 72 + ech] = f2bf(kdv[j] * rP); RT[sp * 72 + ech] = f2bf(rr[j] * P);
                            bt4[ii] = bet[j] * rP; kd4[ii] = kdv[j] * rP; vv4[ii] = vvv[j];
                            if (i0 + ii == 15) PC[c * 64 + ech] = P; }
                        u32x2 w2;
                        w2.x = pk2(bt4[0], bt4[1]); w2.y = pk2(bt4[2], bt4[3]); *(u32x2*)(BKt + (c * 64 + ech) * 40 + i0) = w2;
                        w2.x = pk2(kd4[0], kd4[1]); w2.y = pk2(kd4[2], kd4[3]); *(u32x2*)(BKt + (c * 64 + ech) * 40 + 16 + i0) = w2;
                        w2.x = pk2(vv4[0], vv4[1]); w2.y = pk2(vv4[2], vv4[3]); *(u32x2*)(UVt + (c * 64 + ech) * 40 + 16 + i0) = w2;
                    }
                }
                }
                __syncthreads();
                if (tid < 32) stc_f32(bon + ((size_t)d * MT + base + t_lo + tid) * 8 + h, (bonp[tid] + bonp[32 + tid]) + (bonp[64 + tid] + bonp[96 + tid]));
                if (fc + 1 < 72) RW_FETCH(fc + 1);
                int tid_o = tid; asm volatile("" : "+v"(tid_o));
                const int tid = tid_o, wid = __builtin_amdgcn_readfirstlane(tid_o >> 6), lane = tid_o & 63;
                for (int rwr_ = 0; rwr_ < 1 + ((RWREP >> 3) & 1); ++rwr_) { if (rwr_) __syncthreads();
                {
                    const int c = wid >> 2, which = wid & 3, c16 = lane & 15, q = lane >> 4;
                    const u16* X = (which < 2) ? KT : RT; const u16* Y = (which & 1) ? KD : BT;
                    f32x4 pa = (f32x4){0.f, 0.f, 0.f, 0.f};
#pragma unroll
                    for (int ks = 0; ks < 2; ++ks) { const bf16x8 a = *(const bf16x8*)(X + (c * 16 + c16) * 72 + ks * 32 + q * 8), bb = *(const bf16x8*)(Y + (c * 16 + c16) * 72 + ks * 32 + q * 8); mfma_safe(pa, a, bb); }
#pragma unroll
                    for (int j = 0; j < 4; ++j) { const int t = 4 * q + j, sx = c16; const bool keep = (which < 2) ? (sx < t) : (sx <= t); const float val = keep ? pa[j] : 0.f;
                        if (which == 0) { Amat[c * 256 + sx * 16 + t] = val; AB[(c * 16 + t) * 40 + sx] = (u16)0; }
                        else if (which == 1) AB[(c * 16 + t) * 40 + 16 + sx] = f2bf(val);
                        else if (which == 2) CC[(c * 16 + t) * 40 + sx] = f2bf(val);
                        else CC[(c * 16 + t) * 40 + 16 + sx] = f2bf(val); }
                    if (which == 0) {
                        LDSWAIT(); const int jcol = lane & 15; float part[16], an[16];
#pragma unroll
                        for (int t = 0; t < 16; ++t) part[t] = (t == jcol) ? 1.f : 0.f;
#pragma unroll
                        for (int t4 = 0; t4 < 4; ++t4) { const f32x4 av = *(const f32x4*)(Amat + c * 256 + t4 * 4); an[t4 * 4] = av[0]; an[t4 * 4 + 1] = av[1]; an[t4 * 4 + 2] = av[2]; an[t4 * 4 + 3] = av[3]; }
#pragma unroll
                        for (int sx = 0; sx < 16; ++sx) { const float xs = part[sx];
                            float acol[16];
#pragma unroll
                            for (int t = 0; t < 16; ++t) acol[t] = an[t];
                            if (sx + 1 < 16) {
#pragma unroll
                                for (int t4 = 0; t4 < 4; ++t4) { const f32x4 av = *(const f32x4*)(Amat + c * 256 + (sx + 1) * 16 + t4 * 4); an[t4 * 4] = av[0]; an[t4 * 4 + 1] = av[1]; an[t4 * 4 + 2] = av[2]; an[t4 * 4 + 3] = av[3]; } }
                            if (lane < 32) Tm[(c * 16 + sx) * 40 + lane] = lane < 16 ? f2bf(xs) : (u16)0;
#pragma unroll
                            for (int t = sx + 1; t < 16; ++t) part[t] -= acol[t] * xs; }
                    }
                }
                }
                __syncthreads();
                if (wid < 4) {
                    const int w = wid, c16 = lane & 15, q = lane >> 4;
#pragma unroll 1
                    for (int c = 0; c < 2; ++c) {
                        *(u32x2*)(MtT + (w * 16 + c16) * 40 + 16 + 4 * q) = (u32x2){0u, 0u};
                        f32x4 m = (f32x4){0.f, 0.f, 0.f, 0.f};
#pragma unroll
                        for (int ks = 0; ks < 2; ++ks) { const bf16x8 a = *(const bf16x8*)(KT + (c * 16 + c16) * 72 + ks * 32 + q * 8), bb = *(const bf16x8*)(Sb + (w * 16 + c16) * 72 + ks * 32 + q * 8); mfma_safe(m, a, bb); }
                        { const bf16x8 a = *(const bf16x8*)(AB + (c * 16 + c16) * 40 + q * 8), bb = *(const bf16x8*)(UVt + (c * 64 + w * 16 + c16) * 40 + q * 8); mfma_safe(m, a, bb); }
                        { u32x2 w2; w2.x = pk2(m[0], m[1]); w2.y = pk2(m[2], m[3]); *(u32x2*)(MtT + (w * 16 + c16) * 40 + 4 * q) = w2; }
                        LDSWAIT();
                        f32x4 u = (f32x4){0.f, 0.f, 0.f, 0.f};
                        { const bf16x8 a = *(const bf16x8*)(Tm + (c * 16 + c16) * 40 + q * 8), bb = *(const bf16x8*)(MtT + (w * 16 + c16) * 40 + q * 8); mfma_safe(u, a, bb); }
                        { u32x2 w2; w2.x = pk2(-u[0], -u[1]); w2.y = pk2(-u[2], -u[3]); *(u32x2*)(UVt + (c * 64 + w * 16 + c16) * 40 + 4 * q) = w2; }
                        LDSWAIT();
                        f32x4 o = (f32x4){0.f, 0.f, 0.f, 0.f};
#pragma unroll
                        for (int ks = 0; ks < 2; ++ks) { const bf16x8 a = *(const bf16x8*)(Sb + (w * 16 + c16) * 72 + ks * 32 + q * 8), bb = *(const bf16x8*)(RT + (c * 16 + c16) * 72 + ks * 32 + q * 8); mfma_safe(o, a, bb); }
                        { const bf16x8 a = *(const bf16x8*)(UVt + (c * 64 + w * 16 + c16) * 40 + q * 8), bb = *(const bf16x8*)(CC + (c * 16 + c16) * 40 + q * 8); mfma_safe(o, a, bb); }
                        { const int sp = c * 16 + c16, tk = d ? 31 - sp : sp; *(f32x4*)(Oc + tk * 64 + w * 16 + 4 * q) = o; }
#pragma unroll
                        for (int kt = 0; kt < 4; ++kt) {
                            const bf16x8 a = *(const bf16x8*)(BKt + (c * 64 + kt * 16 + c16) * 40 + q * 8), bb = *(const bf16x8*)(UVt + (c * 64 + w * 16 + c16) * 40 + q * 8);
                            mfma_safe(SS[kt], a, bb);
                            const f32x4 pc = *(const f32x4*)(PC + c * 64 + kt * 16 + 4 * q);
#pragma unroll
                            for (int j = 0; j < 4; ++j) SS[kt][j] *= pc[j];
                            u32x2 w2; w2.x = pk2(SS[kt][0], SS[kt][1]); w2.y = pk2(SS[kt][2], SS[kt][3]); *(u32x2*)(Sb + (w * 16 + c16) * 72 + kt * 16 + 4 * q) = w2;
                        }
                        LDSWAIT();
                    }
                }
                prev_row0 = base + t_lo;
            }
        }
#undef RW_FETCH
#undef RW_GEOM
        __syncthreads();
        { const f32x4 o = *(const f32x4*)(Oc + pt * 64 + pc4); stc_8(ob + ((size_t)d * MT + prev_row0 + pt) * 512 + h * 64 + pc4, pk4bf(o)); }
    }
}
#define RW_GG(p) ((u16*)((p).arena + (size_t)MT * 2048 * 2 + (size_t)2 * MT * 512 * 2 + (size_t)2 * MT * 8 * 4 + 4096))
__device__ __forceinline__ void rw_sg_rows(PP pp, int l, int r0) {
    PREF; l = uni(l); r0 = uni(r0); u16* pr = (u16*)p.arena;
    const int wid = tix >> 6, lane = tix & 63, l16 = lane & 15, sub = lane >> 4;
    const float* mu = p.in[I_rw_mu] + (size_t)l * 2 * 1920;
    float m0[8], m1[8];
#pragma unroll
    for (int e = 0; e < 8; ++e) { m0[e] = mu[1792 + l16 * 8 + e]; m1[e] = mu[1920 + 1792 + l16 * 8 + e]; }
    for (int row = r0 + ((int)blockIdx.x * 8 + wid) * 4 + sub; row < MT; row += (int)gridDim.x * 32) {
        int base, t, L; seq_of(row, base, t, L);
        const u16* q0 = pr + (size_t)row * 2048 + 1792 + l16 * 8;
        float pc[8], pm[8], pn[8], o[8];
        u32x4 vm = (u32x4){0u, 0u, 0u, 0u}, vn = vm; const u32x4 vc = ldc_16(q0);
        if (t > 0) vm = ldc_16(q0 - 2048);
        if (t < L - 1) vn = ldc_16(q0 + 2048);
        unpack8(vc, pc); unpack8(vm, pm); unpack8(vn, pn);
#pragma unroll
        for (int e = 0; e < 8; ++e) o[e] = sigm(pc[e] + m0[e] * (pm[e] - pc[e]) + m1[e] * (pn[e] - pc[e]));
        stc_16(pr + (size_t)row * 2048 + 1920 + l16 * 8, pack8(o));
    }
}
__device__ __forceinline__ void ph_rw_out(PP pp, int l, int r0) {
    PREF; l = uni(l); r0 = uni(r0); const u16* pr = (const u16*)p.arena; const u16* ob = (const u16*)(p.arena + (size_t)MT * 2048 * 2); const float* bon = (const float*)(p.arena + (size_t)MT * 2048 * 2 + (size_t)2 * MT * 512 * 2); const u16* gg = RW_GG(p);
    const int wid = tix >> 6, lane = tix & 63, c0 = lane * 8, h = lane >> 3;
    const float* mu = p.in[I_rw_mu] + (size_t)l * 2 * 1920;
    float m0[8], m1[8], lg[8], lb[8];
#pragma unroll
    for (int e = 0; e < 8; ++e) { m0[e] = mu[1024 + c0 + e]; m1[e] = mu[1920 + 1024 + c0 + e]; lg[e] = p.in[I_rw_ln_g][l * 512 + c0 + e]; lb[e] = p.in[I_rw_ln_b][l * 512 + c0 + e]; }
    for (int row = r0 + blockIdx.x * 8 + wid; row < MT; row += gridDim.x * 8) {
        int base, t, L; seq_of(row, base, t, L);
        const u16* q0 = pr + (size_t)row * 2048 + 1024 + c0;
        float pc[8], pm[8], pn[8], g[8], o[8];
        f32x4 a0, a1, b0, b1; ld8bf(ob + (size_t)row * 512 + c0, a0, a1); ld8bf(ob + ((size_t)MT + row) * 512 + c0, b0, b1);
        unpack8(ldc_16(q0), pc); unpack8(ldc_16(gg + (size_t)row * 512 + c0), g);
        if (t > 0) unpack8(ldc_16(q0 - 2048), pm); else { for (int e = 0; e < 8; ++e) pm[e] = 0.f; }
        if (t < L - 1) unpack8(ldc_16(q0 + 2048), pn); else { for (int e = 0; e < 8; ++e) pn[e] = 0.f; }
        const float bs = ldc_f32(bon + (size_t)row * 8 + h) + ldc_f32(bon + ((size_t)MT + row) * 8 + h);
        float sm = 0.f;
#pragma unroll
        for (int e = 0; e < 4; ++e) { o[e] = a0[e] + b0[e]; o[4 + e] = a1[e] + b1[e]; }
#pragma unroll
        for (int e = 0; e < 8; ++e) sm += o[e];
        const float mean = sum8lanes(sm) * (1.f / 64.f);
        float sv = 0.f;
#pragma unroll
        for (int e = 0; e < 8; ++e) { o[e] -= mean; sv += o[e] * o[e]; }
        const float rs = rsqrtf(sum8lanes(sv) * (1.f / 64.f) + 64e-5f);
        float y[8];
#pragma unroll
        for (int e = 0; e < 8; ++e) { const float v = pc[e] + m0[e] * (pm[e] - pc[e]) + m1[e] * (pn[e] - pc[e]); y[e] = (o[e] * rs * lg[e] + lb[e] + bs * v) * g[e]; }
        stc_16(p.y + ((size_t)MT + row) * 512 + c0, pack8(y));
    }
}

__device__ __forceinline__ void ph_s5_scan(PP pp, int l) {
    PREF; l = uni(l); const u16* ps = p.y + (size_t)3 * MT * 512; u16* ys = (u16*)(p.arena + (size_t)MT * 512 * 2);
    const int wid = tix >> 6, lane = tix & 63, c = lane & 15, q = lane >> 4;
    if (wid >= 4) return;
    float* X0 = (float*)(smem + wid * 24832);
    u16* Hs = (u16*)(smem + wid * 24832 + 20480);
    for (int sid = blockIdx.x + wid * gridDim.x; sid < 1024; sid += gridDim.x * 4) {
        const int b = sid >> 6, g = (sid >> 1) & 31, d = sid & 1;
        const float dt = expf(p.in[I_s5_log_dt][(l * 2 + d) * 32 + g]);
        const float* are_p = p.in[I_s5_a_re] + ((size_t)(l * 2 + d) * 32 + g) * 64; const float* aim_p = p.in[I_s5_a_im] + ((size_t)(l * 2 + d) * 32 + g) * 64;
        float abr, abi;
        { const float are = are_p[lane], aim = aim_p[lane]; const float mag = expf(are * dt), ang = aim * dt; abr = mag * cosf(ang); abi = mag * sinf(ang); }
        bf16x8 bfr[8];
#pragma unroll
        for (int tn = 0; tn < 4; ++tn) {
            const int n = tn * 16 + c;
            const float are = are_p[n], aim = aim_p[n]; const float mag = expf(are * dt), ang = aim * dt, ar = mag * cosf(ang), ai = mag * sinf(ang);
            const float nr = ar - 1.f, ni = ai, den = are * are + aim * aim, fre = (nr * are + ni * aim) / den, fim = (ni * are - nr * aim) / den;
            unsigned wr[4], wi[4];
#pragma unroll
            for (int j2 = 0; j2 < 4; ++j2) { float vr[2], vi[2];
#pragma unroll
                for (int e = 0; e < 2; ++e) { const int u = 8 * q + 2 * j2 + e; float br = 0.f, bi = 0.f;
                    if (q < 2) { br = p.in[I_s5_b_re][((size_t)(l * 32 + g) * 64 + n) * 16 + u]; bi = p.in[I_s5_b_im][((size_t)(l * 32 + g) * 64 + n) * 16 + u]; }
                    vr[e] = fre * br - fim * bi; vi[e] = fre * bi + fim * br; }
                wr[j2] = pk2(vr[0], vr[1]); wi[j2] = pk2(vi[0], vi[1]); }
            u32x4 t0 = (u32x4){wr[0], wr[1], wr[2], wr[3]}, t1 = (u32x4){wi[0], wi[1], wi[2], wi[3]};
            bfr[tn] = __builtin_bit_cast(bf16x8, t0); bfr[4 + tn] = __builtin_bit_cast(bf16x8, t1);
        }
        bf16x8 cfr[4];
#pragma unroll
        for (int ks = 0; ks < 4; ++ks) { unsigned w[4];
#pragma unroll
            for (int j2 = 0; j2 < 4; ++j2) { float v[2];
#pragma unroll
                for (int e = 0; e < 2; ++e) { const int n = ks * 16 + 4 * q + j2;
                    v[e] = e == 0 ? p.in[I_s5_c_re][((size_t)(l * 32 + g) * 16 + c) * 64 + n] : -p.in[I_s5_c_im][((size_t)(l * 32 + g) * 16 + c) * 64 + n]; }
                w[j2] = pk2(v[0], v[1]); }
            u32x4 t = (u32x4){w[0], w[1], w[2], w[3]}; cfr[ks] = __builtin_bit_cast(bf16x8, t); }
        float hr = 0.f, hi = 0.f;
#define S5_ROW(fc, i) ((fc) < 16 ? (b * 256 + (d ? 255 - (16 * (fc) + (i)) : 16 * (fc) + (i))) : (RC + b * 2048 + (d ? 2047 - (16 * ((fc) - 16) + (i)) : 16 * ((fc) - 16) + (i))))
        u32x4 ua = (u32x4){0u, 0u, 0u, 0u};
        if (q < 2) ua = ldc_16(ps + (size_t)S5_ROW(0, c) * 512 + g * 16 + q * 8);
#define S5_DRIVE(Xb, afr_) do { _Pragma("unroll") for (int tl = 0; tl < 8; ++tl) { f32x4 xa = (f32x4){0.f, 0.f, 0.f, 0.f}; mfma_safe(xa, afr_, bfr[tl]); \
            *(f32x4*)((Xb) + (tl * 16 + c) * 20 + 4 * q) = xa; } } while (0)
        { const bf16x8 afr0 = __builtin_bit_cast(bf16x8, ua); LDSWAIT(); S5_DRIVE(X0, afr0); }
        if (q < 2) ua = ldc_16(ps + (size_t)S5_ROW(1, c) * 512 + g * 16 + q * 8);
        for (int fc = 0; fc < 144; ++fc) {
            float* Xc = X0 + (fc & 1) * 2560; float* Xn = X0 + ((fc & 1) ^ 1) * 2560;
            float xr[16], xi[16];
#pragma unroll
            for (int t4 = 0; t4 < 4; ++t4) { const f32x4 vr = *(const f32x4*)(Xc + lane * 20 + 4 * t4), vi = *(const f32x4*)(Xc + (64 + lane) * 20 + 4 * t4);
#pragma unroll
                for (int e = 0; e < 4; ++e) { xr[4 * t4 + e] = vr[e]; xi[4 * t4 + e] = vi[e]; } }
            if (fc + 1 < 144) { const bf16x8 afr = __builtin_bit_cast(bf16x8, ua);
                if (q < 2 && fc + 2 < 144) ua = ldc_16(ps + (size_t)S5_ROW(fc + 2, c) * 512 + g * 16 + q * 8);
                S5_DRIVE(Xn, afr); }
#pragma unroll
            for (int tk = 0; tk < 16; ++tk) {
                const float nhr = abr * hr - abi * hi + xr[tk], nhi = abr * hi + abi * hr + xi[tk]; hr = nhr; hi = nhi;
                *(unsigned*)(Hs + tk * 136 + 2 * lane) = pk2(hr, hi);
            }
            LDSWAIT();
            f32x4 ya = (f32x4){0.f, 0.f, 0.f, 0.f};
#pragma unroll
            for (int ks = 0; ks < 4; ++ks) { const bf16x8 hf = *(const bf16x8*)(Hs + c * 136 + ks * 32 + q * 8); mfma_safe(ya, cfr[ks], hf); }
            stc_8(ys + ((size_t)d * MT + S5_ROW(fc, c)) * 512 + g * 16 + 4 * q, pk4bf(ya));
        }
#undef S5_DRIVE
#undef S5_ROW
    }
}
__device__ __forceinline__ void ph_s5_act(PP pp, int l, int r0) {
    PREF; l = uni(l); r0 = uni(r0); const u16* ps = p.y + (size_t)3 * MT * 512; const u16* ys = (const u16*)(p.arena + (size_t)MT * 512 * 2); u16* ya = (u16*)(p.arena + (size_t)MT * 512 * 2 + (size_t)2 * MT * 512 * 4);
    const int wid = tix >> 6, lane = tix & 63, c0 = lane * 8;
    float dsk[8];
#pragma unroll
    for (int e = 0; e < 8; ++e) dsk[e] = p.in[I_s5_d][l * 512 + c0 + e];
    for (int row = r0 + blockIdx.x * 8 + wid; row < MT; row += gridDim.x * 8) {
        f32x4 a0, a1, b0, b1; ld8bf(ys + (size_t)row * 512 + c0, a0, a1); ld8bf(ys + ((size_t)MT + row) * 512 + c0, b0, b1);
        float u[8], o[8]; unpack8(ldc_16(ps + (size_t)row * 512 + c0), u);
#pragma unroll
        for (int e = 0; e < 8; ++e) { const float x = (e < 4 ? a0[e & 3] + b0[e & 3] : a1[e & 3] + b1[e & 3]) + dsk[e] * u[e]; o[e] = 0.5f * x * (1.f + ftanh(0.7978845608028654f * (x + 0.044715f * x * x * x))); }
        stc_16(ya + (size_t)row * 512 + c0, pack8(o));
    }
}

typedef __amdgpu_buffer_rsrc_t brsrc_t;
__device__ __forceinline__ brsrc_t mk_rsrc(const void* base, unsigned bytes) { return __builtin_amdgcn_make_buffer_rsrc((void*)base, (short)0, (int)bytes, 0x00020000); }
__device__ __forceinline__ u32x4 ld16_sc1(brsrc_t r, unsigned off) { return __builtin_bit_cast(u32x4, __builtin_amdgcn_raw_buffer_load_b128(r, (int)off, 0, SC1_AUX)); }
__device__ __forceinline__ unsigned ld4_sc1(brsrc_t r, unsigned off) { return __builtin_amdgcn_raw_buffer_load_b32(r, (int)off, 0, SC1_AUX); }
__device__ __forceinline__ void ph_gla_scan(PP pp, int l) {
    PREF; l = uni(l); const u16* pg = (const u16*)p.arena; u16* og = (u16*)(p.arena + (size_t)MT * 1792 * 2);
    const int tid = tix, wid = tid >> 6, lane = tid & 63, c = lane & 15, q = lane >> 4;
    const brsrc_t pgr = mk_rsrc(pg, (unsigned)((size_t)MT * 1792 * 2));
    u16* QT = (u16*)smem; u16* KT = QT + 4608; u16* QH = KT + 4608; u16* KHt = QH + 4608; u16* Vt = KHt + 4608; u16* Pm = Vt + 4608; u16* St = Pm + 4608;
    float* CUM = (float*)(St + 4608); float* TOT = CUM + 4096; float* GB = TOT + 512; float* DEC = GB + 64;
    u16* GUt = (u16*)(DEC + 64); u16* GDp = GUt + 64 * 40;
    const int tok = tid >> 3, c8 = (tid & 7) * 8;
    for (int item = blockIdx.x; item < 256; item += gridDim.x) {
        const int b = item >> 4, h = (item >> 2) & 3, d = (item >> 1) & 1, eh = item & 1;
        __syncthreads();
        for (int i = tid; i < 64 * 40; i += NT) { const int chn = i / 40, m = i - chn * 40; GUt[i] = m < 16 ? f2bf(p.in[I_gla_gate_up][((size_t)(l * 2 + d) * 16 + m) * 256 + h * 64 + chn]) : (u16)0; GDp[i] = (u16)0; GDp[64 * 40 + i] = (u16)0; }
        if (tid < 64) GB[tid] = p.in[I_gla_gate_b][(l * 2 + d) * 256 + h * 64 + tid];
        f32x4 sacc[2];
        sacc[0] = (f32x4){0.f, 0.f, 0.f, 0.f}; sacc[1] = sacc[0];
#define GLA_ROW(s) ((s) < 256 ? (b * 256 + (d ? 255 - (s) : (s))) : (RC + b * 2048 + ((((d ? 2047 - ((s) - 256) : ((s) - 256)) & 31) * 64) + ((d ? 2047 - ((s) - 256) : ((s) - 256)) >> 5))))
        u32x4 rq, rk, rv; unsigned rg;
        { const unsigned ro = (unsigned)GLA_ROW(tok) * 3584u; rq = ld16_sc1(pgr, ro + (h * 64 + c8) * 2); rk = ld16_sc1(pgr, ro + (256 + h * 64 + c8) * 2);
          rv = ld16_sc1(pgr, ro + (512 + h * 128 + eh * 64 + c8) * 2); rg = ld4_sc1(pgr, ro + (1536 + d * 16 + (tid & 7) * 2) * 2); }
        for (int ch = 0; ch < 36; ++ch) {
            const u32x4 cq = rq, ck = rk, cv = rv; const unsigned cg = rg;
            u16* GDc = GDp + (ch & 1) * (64 * 40);
            *(unsigned*)(GDc + tok * 40 + (tid & 7) * 2) = cg;
            __syncthreads();
            if (ch + 1 < 36) { const unsigned ro = (unsigned)GLA_ROW((ch + 1) * 64 + tok) * 3584u; rq = ld16_sc1(pgr, ro + (h * 64 + c8) * 2); rk = ld16_sc1(pgr, ro + (256 + h * 64 + c8) * 2);
                rv = ld16_sc1(pgr, ro + (512 + h * 128 + eh * 64 + c8) * 2); rg = ld4_sc1(pgr, ro + (1536 + d * 16 + (tid & 7) * 2) * 2); }
#pragma unroll
            for (int s2 = 0; s2 < 2; ++s2) { const int id = wid * 2 + s2, tt = id >> 2, ct = id & 3;
                f32x4 g4 = (f32x4){0.f, 0.f, 0.f, 0.f};
                { const bf16x8 a = *(const bf16x8*)(GDc + (tt * 16 + c) * 40 + q * 8), bb = *(const bf16x8*)(GUt + (ct * 16 + c) * 40 + q * 8); mfma_safe(g4, a, bb); }
                const float gb = GB[ct * 16 + c]; float pf[4];
#pragma unroll
                for (int j = 0; j < 4; ++j) { const float x = g4[j] + gb; pf[j] = (fminf(x, 0.f) - __builtin_amdgcn_logf(1.f + fexp(-fabsf(x))) * 0.6931471805599453f) * (1.f / 16.f); }
                pf[1] += pf[0]; pf[2] += pf[1]; pf[3] += pf[2];
                float sgrp = pf[3];
                { const float u1 = __int_as_float(__builtin_amdgcn_ds_bpermute((lane - 16) * 4, __float_as_int(sgrp))); if (q >= 1) sgrp += u1; }
                { const float u2 = __int_as_float(__builtin_amdgcn_ds_bpermute((lane - 32) * 4, __float_as_int(sgrp))); if (q >= 2) sgrp += u2; }
                const float excl = sgrp - pf[3];
#pragma unroll
                for (int j = 0; j < 4; ++j) CUM[(tt * 16 + 4 * q + j) * 64 + ct * 16 + c] = pf[j] + excl;
                if (q == 3) TOT[tt * 64 + ct * 16 + c] = sgrp; }
            __syncthreads();
            {
                float cm[8], rf[8], la[8];
                { const int tt = tok >> 4;
#pragma unroll
                  for (int hh = 0; hh < 2; ++hh) { const f32x4 mv = *(const f32x4*)(CUM + tok * 64 + c8 + 4 * hh), fv = *(const f32x4*)(CUM + 31 * 64 + c8 + 4 * hh), lv = *(const f32x4*)(CUM + 63 * 64 + c8 + 4 * hh);
                      const f32x4 t0 = *(const f32x4*)(TOT + c8 + 4 * hh), t1 = *(const f32x4*)(TOT + 64 + c8 + 4 * hh), t2 = *(const f32x4*)(TOT + 128 + c8 + 4 * hh);
#pragma unroll
                      for (int e = 0; e < 4; ++e) { cm[4 * hh + e] = mv[e] + (tt >= 1 ? t0[e] : 0.f) + (tt >= 2 ? t1[e] : 0.f) + (tt >= 3 ? t2[e] : 0.f); rf[4 * hh + e] = fv[e] + t0[e]; la[4 * hh + e] = lv[e] + (t0[e] + t1[e]) + t2[e]; } }
                  if (tok == 63) {
#pragma unroll
                      for (int e = 0; e < 8; ++e) DEC[c8 + e] = fexp(la[e]); } }
                const unsigned qw[4] = {cq.x, cq.y, cq.z, cq.w}, kw[4] = {ck.x, ck.y, ck.z, ck.w}, vw[4] = {cv.x, cv.y, cv.z, cv.w};
                float qt[8], kt[8], qh[8], kh[8];
#pragma unroll
                for (int e = 0; e < 8; ++e) {
                    const float qv = (e & 1 ? __uint_as_float(qw[e >> 1] & 0xffff0000u) : __uint_as_float(qw[e >> 1] << 16)) * 0.125f;
                    const float kv = (e & 1 ? __uint_as_float(kw[e >> 1] & 0xffff0000u) : __uint_as_float(kw[e >> 1] << 16));
                    const float e1 = fexp(cm[e] - rf[e]), r1 = fexp(rf[e] - cm[e]);
                    qt[e] = qv * e1; kt[e] = kv * r1; qh[e] = qt[e] * fexp(rf[e]); kh[e] = kt[e] * fexp(la[e] - rf[e]);
                }
                u32x4 w;
                w.x = pk2(qt[0], qt[1]); w.y = pk2(qt[2], qt[3]); w.z = pk2(qt[4], qt[5]); w.w = pk2(qt[6], qt[7]); *(u32x4*)(QT + tok * 72 + c8) = w;
                w.x = pk2(kt[0], kt[1]); w.y = pk2(kt[2], kt[3]); w.z = pk2(kt[4], kt[5]); w.w = pk2(kt[6], kt[7]); *(u32x4*)(KT + tok * 72 + c8) = w;
                w.x = pk2(qh[0], qh[1]); w.y = pk2(qh[2], qh[3]); w.z = pk2(qh[4], qh[5]); w.w = pk2(qh[6], qh[7]); *(u32x4*)(QH + tok * 72 + c8) = w;
#pragma unroll
                for (int e = 0; e < 8; ++e) { KHt[(c8 + e) * 72 + tok] = f2bf(kh[e]); Vt[(c8 + e) * 72 + tok] = (u16)(e & 1 ? (vw[e >> 1] >> 16) : (vw[e >> 1] & 0xffffu)); }
#pragma unroll
                for (int s2 = 0; s2 < 2; ++s2) { const int id = wid * 2 + s2, dkt = id >> 2, et = id & 3;
                    u32x2 sw; sw.x = pk2(sacc[s2][0], sacc[s2][1]); sw.y = pk2(sacc[s2][2], sacc[s2][3]); *(u32x2*)(St + (et * 16 + c) * 72 + dkt * 16 + 4 * q) = sw; }
            }
            __syncthreads();
#pragma unroll
            for (int s2 = 0; s2 < 2; ++s2) { const int id = wid * 2 + s2, it = id >> 2, jt = id & 3;
                f32x4 pa = (f32x4){0.f, 0.f, 0.f, 0.f};
                if (jt <= it) {
#pragma unroll
                    for (int ks = 0; ks < 2; ++ks) { const bf16x8 a = *(const bf16x8*)(QT + (it * 16 + c) * 72 + ks * 32 + q * 8), bb = *(const bf16x8*)(KT + (jt * 16 + c) * 72 + ks * 32 + q * 8); mfma_safe(pa, a, bb); } }
#pragma unroll
                for (int jj = 0; jj < 4; ++jj) { const int i = it * 16 + 4 * q + jj, j = jt * 16 + c; Pm[i * 72 + j] = f2bf(i >= j ? pa[jj] : 0.f); } }
            __syncthreads();
#pragma unroll
            for (int s2 = 0; s2 < 2; ++s2) { const int id = wid * 2 + s2, it = id >> 2, et = id & 3;
                f32x4 oa = (f32x4){0.f, 0.f, 0.f, 0.f};
#pragma unroll
                for (int ks = 0; ks < 2; ++ks) { const bf16x8 a = *(const bf16x8*)(Vt + (et * 16 + c) * 72 + ks * 32 + q * 8), bb = *(const bf16x8*)(Pm + (it * 16 + c) * 72 + ks * 32 + q * 8); mfma_safe(oa, a, bb); }
#pragma unroll
                for (int ks = 0; ks < 2; ++ks) { const bf16x8 a = *(const bf16x8*)(St + (et * 16 + c) * 72 + ks * 32 + q * 8), bb = *(const bf16x8*)(QH + (it * 16 + c) * 72 + ks * 32 + q * 8); mfma_safe(oa, a, bb); }
                stc_8(og + ((size_t)d * MT + GLA_ROW(ch * 64 + it * 16 + c)) * 512 + h * 128 + eh * 64 + et * 16 + 4 * q, pk4bf(oa));
                const int dkt = it;
#pragma unroll
                for (int jj = 0; jj < 4; ++jj) sacc[s2][jj] *= DEC[dkt * 16 + 4 * q + jj];
#pragma unroll
                for (int ks = 0; ks < 2; ++ks) { const bf16x8 a = *(const bf16x8*)(KHt + (dkt * 16 + c) * 72 + ks * 32 + q * 8), bb = *(const bf16x8*)(Vt + (et * 16 + c) * 72 + ks * 32 + q * 8); mfma_safe(sacc[s2], a, bb); }
            }
        }
#undef GLA_ROW
    }
}
__device__ __forceinline__ void ph_gla_out(PP pp, int l, int r0) {
    PREF; l = uni(l); r0 = uni(r0); const u16* pg = (const u16*)p.arena; const u16* og = (const u16*)(p.arena + (size_t)MT * 1792 * 2);
    const int wid = tix >> 6, lane = tix & 63, c0 = lane * 8;
    float ng[8];
#pragma unroll
    for (int e = 0; e < 8; ++e) ng[e] = p.in[I_gla_norm_g][l * 128 + ((c0 + e) & 127)];
    for (int row = r0 + blockIdx.x * 8 + wid; row < MT; row += gridDim.x * 8) {
        f32x4 a0, a1, b0, b1; ld8bf(og + (size_t)row * 512 + c0, a0, a1); ld8bf(og + ((size_t)MT + row) * 512 + c0, b0, b1);
        float g[8], o[8], y[8]; unpack8(ldc_16(pg + (size_t)row * 1792 + 1024 + c0), g);
        float ss = 0.f;
#pragma unroll
        for (int e = 0; e < 4; ++e) { o[e] = a0[e] + b0[e]; o[4 + e] = a1[e] + b1[e]; }
#pragma unroll
        for (int e = 0; e < 8; ++e) ss += o[e] * o[e];
        const float rs = rsqrtf(rowsum16(ss) * (1.f / 128.f) + 1e-6f);
#pragma unroll
        for (int e = 0; e < 8; ++e) y[e] = o[e] * rs * ng[e] * g[e] * sigm(g[e]);
        stc_16(p.y + ((size_t)3 * MT + row) * 512 + c0, pack8(y));
    }
}


__device__ __forceinline__ void ph_moe_slot(PP pp) {
    PREF;
    const int G = (int)gridDim.x, wid = tix >> 6, lane = tix & 63;
    int* tab = (int*)smem; int* sh = tab + 8 * G;
    __syncthreads();
    for (int i = tix; i < 8 * G; i += NT) tab[i] = (int)ldc_u32(p.moe_i + 1024 + i);
    __syncthreads();
    if (tix < 8) { int tot = 0, mine = 0; for (int b = 0; b < G; ++b) { const int c = tab[b * 8 + tix]; if (b < (int)blockIdx.x) mine += c; tot += c; } sh[17 + tix] = tot; sh[tix] = mine; }
    __syncthreads();
    if (tix == 0) { int ps = 0, nt = 0;
#pragma unroll 1
        for (int e = 0; e < 8; ++e) { sh[8 + e] = ps; const int tl = (sh[17 + e] + 255) / 256;
            if (blockIdx.x == 0) { int ev = e; asm volatile("" : "+v"(ev));
#pragma unroll 1
                for (int j = 0; j < tl; ++j) stc_u32(p.moe_i + 32 + nt + j, (unsigned)ev); }
            nt += tl; ps += tl * 256; }
        sh[16] = ps; if (blockIdx.x == 0) stc_u32(p.moe_i + 25, (unsigned)nt); }
    __syncthreads();
    for (int row = RC + blockIdx.x * 8 + wid; row < MT; row += G * 8) {
        const int tok = row - RC;
        const int e0 = (int)ldc_u32(p.top_i + tok * 2), e1 = (int)ldc_u32(p.top_i + tok * 2 + 1), k0 = (int)ldc_u32(p.row_tok + tok * 2), k1 = (int)ldc_u32(p.row_tok + tok * 2 + 1);
        const int d0 = sh[8 + e0] + sh[e0] + k0, d1 = sh[8 + e1] + sh[e1] + k1;
        if (lane == 0) { stc_u32(p.dest_of + tok * 2, (unsigned)d0); stc_u32(p.dest_of + tok * 2 + 1, (unsigned)d1); }
        const u32x4 a = ldc_16((const char*)p.hn + (size_t)row * 1024 + lane * 16);
        stc_16((char*)p.xb8 + (size_t)d0 * 1024 + lane * 16, a); stc_16((char*)p.xb8 + (size_t)d1 * 1024 + lane * 16, a);
    }
}
__device__ __forceinline__ void ph_final(PP pp) {
    PREF;
    const int wid = tix >> 6, lane = tix & 63;
    const float* g = p.in[I_final_norm_g];
    for (int tok = blockIdx.x * 8 + wid; tok < 32768; tok += gridDim.x * 8) {
        const float* gt = p.mod + (size_t)(17 + (tok >> 11)) * 6144 + 5120;
        const int d0 = (int)ldc_u32(p.dest_of + tok * 2), d1 = (int)ldc_u32(p.dest_of + tok * 2 + 1); const float g0 = ldc_f32(p.top_g + tok * 2), g1 = ldc_f32(p.top_g + tok * 2 + 1);
        float* hp = p.out + (size_t)tok * 1024;
        f32x4 v[4]; float ss = 0.f;
#pragma unroll
        for (int i = 0; i < 4; ++i) { const int k = i * 256 + lane * 4;
            const u32x2 a = ldc_8(p.yb + (size_t)d0 * 1024 + k), b = ldc_8(p.yb + (size_t)d1 * 1024 + k);
            const f32x4 hh = ldc_f4(hp + k), gg = *(const f32x4*)(gt + k);
            float ya[4] = {__uint_as_float(a.x << 16), __uint_as_float(a.x & 0xffff0000u), __uint_as_float(a.y << 16), __uint_as_float(a.y & 0xffff0000u)};
            float yc[4] = {__uint_as_float(b.x << 16), __uint_as_float(b.x & 0xffff0000u), __uint_as_float(b.y << 16), __uint_as_float(b.y & 0xffff0000u)};
#pragma unroll
            for (int j = 0; j < 4; ++j) { v[i][j] = hh[j] + gg[j] * (g0 * ya[j] + g1 * yc[j]); ss += v[i][j] * v[i][j]; } }
        ss = wsum(ss); const float rs = rsqrtf(ss * (1.f / 1024.f) + 1e-6f);
#pragma unroll
        for (int i = 0; i < 4; ++i) { const int k = i * 256 + lane * 4; const f32x4 gg = *(const f32x4*)(g + k); f32x4 o;
#pragma unroll
            for (int j = 0; j < 4; ++j) o[j] = v[i][j] * rs * gg[j];
            stc_f4(hp + k, o); }
    }
}


__device__ __forceinline__ GPb mkg(const u16* A, long lda, const u16* Bt, long ldb, int K, int tm0, int ntm, int ntn) { GPb g; g.A = A; g.lda = lda; g.Bt = Bt; g.ldb = ldb; g.Kd = K; g.tm0 = tm0; g.ntm = ntm; g.ntn = ntn; return g; }
#define BIGG (1 << 30)
__device__ __forceinline__ void ph_gemm_in(PP pp, int l, int part) {
    PREF; l = uni(l); part = uni(part);
    const int last = (l == 1);
    const u16* wt = p.wt_in + (size_t)l * 9984 * 1024;
    Dense8<PrStore> g;
    if (part == 0) { (GPb&)g = mkg(p.hn, 1024, wt, 1024, 1024, last ? 16 : 0, last ? 128 : 144, 6); g.ldo = 1536; g.act = 0; }
    else if (part == 1) { (GPb&)g = mkg(p.hn, 1024, wt + (size_t)1536 * 1024, 1024, 1024, 0, 144, 8); g.ldo = 2048; g.act = 0; }
    else if (part == 2) { (GPb&)g = mkg(p.hn, 1024, wt + (size_t)3584 * 1024, 1024, 1024, 0, 144, 2); g.ldo = 512; g.act = 0; }
    else if (part == 3) { (GPb&)g = mkg(p.hn, 1024, wt + (size_t)4096 * 1024, 1024, 1024, 0, 144, 7); g.ldo = 1792; g.act = 0; }
    else { (GPb&)g = mkg(p.hn, 1024, wt + (size_t)5888 * 1024, 1024, 1024, last ? 16 : 0, last ? 128 : 144, 16); g.ldo = 4096; g.act = 1; }
    g.O = part == 2 ? p.y + (size_t)3 * MT * 512 : (u16*)p.arena;
    if (FP8IN_LAST && last && part < 4) {
        const int roff = part == 0 ? 0 : part == 1 ? 1536 : part == 2 ? 3584 : 4096;
        Dense8F<PrStore> g8; (GPb&)g8 = (GPb&)g; g8.A = (const u16*)HN8(p); g8.Bt = (const u16*)((const char*)p.wt_in8 + (size_t)roff * 1024); g8.O = g.O; g8.ldo = g.ldo; g8.act = 0; g8.sa_ = 127; g8.sb_ = 122;
        GEMM8F(g8);
    } else GEMM8(g);
}
__device__ __forceinline__ void ph_hn8(PP pp, int r0) {
    PREF; r0 = uni(r0);
    const int wid = tix >> 6, lane = tix & 63;
    for (int row = r0 + blockIdx.x * 8 + wid; row < MT; row += gridDim.x * 8) {
        float a[8], b[8]; unpack8(ldc_16(p.hn + (size_t)row * 1024 + lane * 16), a); unpack8(ldc_16(p.hn + (size_t)row * 1024 + lane * 16 + 8), b);
        u32x4 w; w.x = pk4_fp8(a[0], a[1], a[2], a[3]); w.y = pk4_fp8(a[4], a[5], a[6], a[7]); w.z = pk4_fp8(b[0], b[1], b[2], b[3]); w.w = pk4_fp8(b[4], b[5], b[6], b[7]);
        stc_16(HN8(p) + (size_t)row * 1024 + lane * 16, w);
    }
}
__device__ __forceinline__ void ph_gemm_gates(PP pp, int l) {
    PREF; l = uni(l); const int last = (l == 1);
    Dense8F<PrStore> g; (GPb&)g = mkg((const u16*)HN8(p), 1024, (const u16*)((const char*)p.wt_gate8 + (size_t)l * 4096 * 1024), 1024, 1024, last ? 16 : 0, last ? 128 : 144, 16); g.ldo = 4096; g.act = 1; g.O = (u16*)p.arena; g.sa_ = 127; g.sb_ = 122;
    GEMM8F(g);
}
__device__ __forceinline__ void ph_gemm_in12(PP pp, int l) {
    PREF; l = uni(l);
    In12 g; g.A = p.hn; g.Wt = p.wt_in + (size_t)l * 9984 * 1024; g.Orw = (u16*)p.arena; g.Os5 = p.y + (size_t)3 * MT * 512;
    GEMM8(g);
}
__device__ __forceinline__ void ph_gemm_rwg(PP pp, int l) {
    PREF; l = uni(l); const int last = (l == 1);
    Dense8<PrStore> g; (GPb&)g = mkg((const u16*)p.arena + 1792, 2048, p.wt_g + (size_t)l * 512 * 256, 256, 256, last ? 16 : 0, last ? 128 : 144, 2); g.O = RW_GG(p); g.ldo = 512; g.act = 0;
    GEMM8(g);
}
__device__ __forceinline__ void ph_gemm_glu(PP pp, int l) {
    PREF; l = uni(l); const int last = (l == 1);
    u16* ya = (u16*)(p.arena + (size_t)MT * 512 * 2 + (size_t)2 * MT * 512 * 4);
    Dense8<PrGlu> q; (GPb&)q = mkg(ya, 512, p.wt_glu + (size_t)l * 512 * 512, 512, 512, last ? 16 : 0, last ? 128 : 144, 2); q.ya = ya; q.gb = p.in[I_s5_glu_b] + l * 512; q.O = p.y + (size_t)2 * MT * 512;
    GEMM8(q);
}
__device__ __forceinline__ void ph_gemm_branch4(PP pp, int l) {
    PREF; l = uni(l); const int last = (l == 1);
    Branch8 q; q.y = p.y; q.wt = p.wt_br + (size_t)l * 4 * 1024 * 512; q.G = (const u16*)p.arena; q.acc = p.hn; q.tm0 = last ? 16 : 0; q.ntm = last ? 128 : 144;
    GEMM8(q);
}
__device__ __forceinline__ void ph_gemm_resid(PP pp, int l, int which, float scale) {
    PREF; l = uni(l); which = uni(which); const int last = (l == 1), first = (l == 0);
    Dense8<PrResid> r;
    if (which == 0) { (GPb&)r = mkg(p.hn, 1024, p.wt_out + (size_t)l * 1024 * 1024, 1024, 1024, last ? 16 : 0, last ? 128 : 144, 4);
        r.oc = first ? p.in[I_ctx] : p.hctx; r.ol = first ? p.in[I_x] : p.out; r.goff = 2048; }
    else { (GPb&)r = mkg((const u16*)p.arena, 2816, p.wt_f2, 2816, 2816, 0, 144, 4); r.oc = p.hctx; r.ol = p.out; r.goff = 5120; }
    r.nc = p.hctx; r.nl = p.out; r.mod = p.mod + (size_t)l * 17 * 6144; r.scale = scale;
    GEMM8(r);
}
__device__ __forceinline__ void ph_gemm_ffn_up(PP pp) {
    PREF;
    Dense8<PrSwiglu> s; (GPb&)s = mkg(p.hn, 1024, p.wt_f13, 1024, 1024, 0, 144, 22); s.G = (u16*)p.arena; s.ldg = 2816;
    GEMM8(s);
}
__device__ __forceinline__ void ph_gemm_moe_up(PP pp, int ch) {
    PREF; ch = uni(ch);
    MoeUp8F u; u.xb8 = (const char*)p.xb8; u.mi = p.moe_i; u.W8 = (const char*)p.wt_m13; u.G8 = (char*)p.gch; u.t0 = ch * 128; u.nt = ch ? 136 : 128;
    GEMM8F(u);
}
__device__ __forceinline__ void ph_gemm_moe_down(PP pp, int ch) {
    PREF; ch = uni(ch);
    MoeDown8F dn; dn.G8 = (const char*)p.gch; dn.mi = p.moe_i; dn.W8 = (const char*)p.wt_m2; dn.yb = p.yb; dn.t0 = ch * 128; dn.nt = ch ? 136 : 128;
    GEMM8F(dn);
}
__device__ __forceinline__ void ph_prep(PP pp) {
    PREF;
    for (int l = 0; l < 2; ++l) {
        const float* wi = p.in[I_w_in] + (size_t)l * 1024 * 9632; u16* wt = p.wt_in + (size_t)l * 9984 * 1024;
        do_transpose(wi + 0, 1024, 1536, 9632, wt, BIGG, 0, 0, smem);
        do_transpose(wi + 1536, 1024, 1920, 9632, wt, BIGG, 0, 1536, smem);
        do_transpose(wi + 3456, 1024, 512, 9632, wt, BIGG, 0, 3584, smem);
        do_transpose(wi + 3968, 1024, 1568, 9632, wt, BIGG, 0, 4096, smem);
        do_transpose(wi + 5536, 1024, 4096, 9632, (u16*)((char*)p.wt_gate8 + (size_t)l * 4096 * 1024), BIGG, 0, 0, smem, 1);
        if (FP8IN_LAST && l == 1) { do_transpose(wi + 0, 1024, 1536, 9632, p.wt_in8, BIGG, 0, 0, smem, 1); do_transpose(wi + 1536, 1024, 1920, 9632, p.wt_in8, BIGG, 0, 1536, smem, 1);
                      do_transpose(wi + 3456, 1024, 512, 9632, p.wt_in8, BIGG, 0, 3584, smem, 1); do_transpose(wi + 3968, 1024, 1568, 9632, p.wt_in8, BIGG, 0, 4096, smem, 1); }
        for (int m = 0; m < 4; ++m) do_transpose(p.in[I_w_branch] + (size_t)(l * 4 + m) * 512 * 1024, 512, 1024, 1024, p.wt_br + (size_t)(l * 4 + m) * 1024 * 512, BIGG, 0, 0, smem);
        do_transpose(p.in[I_w_out] + (size_t)l * 1024 * 1024, 1024, 1024, 1024, p.wt_out + (size_t)l * 1024 * 1024, BIGG, 0, 0, smem);
        do_transpose(p.in[I_s5_glu_w] + (size_t)l * 512 * 512, 512, 512, 512, p.wt_glu + (size_t)l * 512 * 512, BIGG, 0, 0, smem);
        for (int i = blockIdx.x * NT + tix; i < 352 * 128; i += gridDim.x * NT) { const int rr = i >> 7, c16 = i & 127; const int row = rr < 128 ? 1536 + 1920 + rr : 4096 + 1568 + (rr - 128);
            *(u32x4*)(wt + (size_t)row * 1024 + c16 * 8) = (u32x4){0u, 0u, 0u, 0u}; }
        for (int i = blockIdx.x * NT + tix; i < 512 * 16; i += gridDim.x * NT) { const int n = i >> 4, c16 = i & 15; *(u32x4*)(p.wt_g + ((size_t)l * 512 + n) * 256 + c16 * 8) = (u32x4){0u, 0u, 0u, 0u}; }
        for (int i = blockIdx.x * NT + tix; i < 128 * 512; i += gridDim.x * NT) { const int n = i >> 7, k = i & 127; p.wt_g[((size_t)l * 512 + n) * 256 + 128 + k] = f2bf(p.in[I_rw_g_up][((size_t)l * 128 + k) * 512 + n]); }
    }
    do_transpose(p.in[I_ffn_w1], 1024, 2816, 2816, p.wt_f13, 128, 256, 0, smem);
    do_transpose(p.in[I_ffn_w3], 1024, 2816, 2816, p.wt_f13, 128, 256, 128, smem);
    do_transpose(p.in[I_ffn_w2], 2816, 1024, 1024, p.wt_f2, BIGG, 0, 0, smem);
}
__device__ __forceinline__ void ph_prep_moe(PP pp) {
    PREF;
    for (int e = 0; e < 8; ++e) {
        do_transpose(p.in[I_moe_w1] + (size_t)e * 1024 * 3584, 1024, 3584, 3584, (u16*)((char*)p.wt_m13 + (size_t)e * 7168 * 1024), 128, 256, 0, smem, 1);
        do_transpose(p.in[I_moe_w3] + (size_t)e * 1024 * 3584, 1024, 3584, 3584, (u16*)((char*)p.wt_m13 + (size_t)e * 7168 * 1024), 128, 256, 128, smem, 1);
        do_transpose(p.in[I_moe_w2] + (size_t)e * 3584 * 1024, 3584, 1024, 1024, (u16*)((char*)p.wt_m2 + (size_t)e * 1024 * 3584), BIGG, 0, 0, smem, 1);
    }
}


__device__ __forceinline__ void l2_scrub(PP pp, int parity) {
    PREF; parity = uni(parity);
    const u32x4* src = (const u32x4*)(parity ? p.in[I_moe_w3] : p.in[I_moe_w1]) + (size_t)blockIdx.x * 16384;
    u32x4 a = (u32x4){0u, 0u, 0u, 0u};
#pragma unroll 8
    for (int i = tix; i < 16384; i += NT) { const u32x4 v = src[i]; a.x ^= v.x; a.y ^= v.y; a.z ^= v.z; a.w ^= v.w; }
    asm volatile("" :: "v"(a.x), "v"(a.y), "v"(a.z), "v"(a.w));
}

__global__ void __launch_bounds__(NT, 2) k_fwd(P p_) {
    extern __shared__ __attribute__((aligned(16))) char smem_raw[];
    PP pp = (PP)__builtin_amdgcn_kernarg_segment_ptr();
    if (threadIdx.x == 0) *(uint4*)smem_raw = make_uint4(0u, 0u, 0u, 0u);
    __syncthreads();
    XcdBarrier bar = xcd_barrier_post(pp->bar, (volatile LAS unsigned*)smem_raw);
    int scr = 0;
#define GSYNC() do { (void)scr; for (int _b = 0; _b < (((REPMASK) >> 9) & 1) + 1; ++_b) xcd_barrier(bar); } while (0)
#ifndef REPN
#define REPN 1
#endif
#define RP(bit) for (int _r = 0; _r < (((REPMASK) >> (bit)) & 1) * REPN + 1; ++_r)
    RP(0) { ph_mod(pp); ph_filt(pp); ph_prep(pp); }
    GSYNC();
    for (int l = 0; l < 2; ++l) {
        const int first = (l == 0), last = (l == 1);
        const int r0L = last ? RC : 0;
        RP(5) { ph_norm(pp, l, 0, 0, MT, first, 0, 0); GSYNC(); }
        RP(1) { ph_gemm_in(pp, l, 0); GSYNC(); }
        RP(2) { ph_hy_pre(pp, l); GSYNC(); }
        RP(2) { ph_hy_conv(pp, l); GSYNC(); }
        ph_hy_post(pp, l, 0);
        RP(1) { ph_gemm_in12(pp, l); GSYNC(); }
        RP(3) { rw_sg_rows(pp, l, r0L); ph_rw_scan(pp, l); GSYNC(); }
        RP(1) { ph_gemm_rwg(pp, l); GSYNC(); }
        RP(10) { ph_rw_out(pp, l, r0L); GSYNC(); }
        RP(4) { ph_s5_scan(pp, l); GSYNC(); }
        RP(5) { ph_s5_act(pp, l, r0L); GSYNC(); }
        RP(10) ph_gemm_glu(pp, l);
        RP(1) { ph_gemm_in(pp, l, 3); GSYNC(); }
        RP(6) { ph_gla_scan(pp, l); GSYNC(); }
        RP(5) { ph_gla_out(pp, l, r0L); GSYNC(); }
        RP(1) { ph_gemm_gates(pp, l); GSYNC(); }
        ph_gemm_branch4(pp, l); GSYNC();
        if ((REPMASK >> 11) & 1) { ph_gemm_resid(pp, l, 0, 0.f); GSYNC(); }
        ph_gemm_resid(pp, l, 0, 1.f); GSYNC();
        if (!last) {
            RP(5) { ph_norm(pp, l, 1, 0, MT, 0, 0, 0); GSYNC(); }
            RP(7) { ph_gemm_ffn_up(pp); GSYNC(); }
            ph_gemm_resid(pp, l, 1, 1.f); GSYNC();
        } else {
            RP(8) { ph_prep_moe(pp); }
            RP(11) { ph_norm(pp, l, 1, RC, MT, 0, 1, 1); GSYNC(); }
            RP(11) { ph_moe_slot(pp); GSYNC(); }
            for (int ch = 0; ch < 2; ++ch) {
                RP(7) { ph_gemm_moe_up(pp, ch); GSYNC(); }
                RP(7) { ph_gemm_moe_down(pp, ch); GSYNC(); }
            }
            ph_final(pp);
        }
    }
}

static inline size_t al256(size_t x) { return (x + 255) & ~(size_t)255; }

extern "C" void kernel_launch(void* const* d_in, const int* in_sizes, int n_in, void* d_out, int out_size, void* d_ws, size_t ws_size, hipStream_t stream) {
    P p; memset(&p, 0, sizeof(p));
    for (int i = 0; i < N_IN; ++i) p.in[i] = (const float*)d_in[i];
    p.out = (float*)d_out;
    char* ws = (char*)d_ws; size_t o = 0;
    auto take = [&](size_t bytes) { char* r = ws + o; o = al256(o + bytes); return r; };
    p.bar = (unsigned*)take(16384);
    p.moe_i = (int*)take(32768);
    p.row_tok = (int*)take((size_t)67584 * 4);
    p.mod = (float*)take((size_t)2 * 17 * 6144 * 4);
    p.rvl = (u16*)take((size_t)2 * 512 * 4096 * 2);
    p.rvc = (u16*)take((size_t)2 * 512 * 512 * 2);
    p.dest_of = (int*)take((size_t)65536 * 4);
    p.top_i = (int*)take((size_t)65536 * 4);
    p.top_g = (float*)take((size_t)65536 * 4);
    p.wt_in = (u16*)take((size_t)2 * 9984 * 1024 * 2);
    p.wt_br = (u16*)take((size_t)2 * 4 * 1024 * 512 * 2);
    p.wt_out = (u16*)take((size_t)2 * 1024 * 1024 * 2);
    p.wt_f13 = (u16*)take((size_t)5632 * 1024 * 2);
    p.wt_f2 = (u16*)take((size_t)1024 * 2816 * 2);
    p.wt_glu = (u16*)take((size_t)2 * 512 * 512 * 2);
    p.wt_g = (u16*)take((size_t)2 * 512 * 256 * 2);
    p.wt_gate8 = (u16*)take((size_t)2 * 4096 * 1024);
    p.wt_in8 = (u16*)take((size_t)5888 * 1024);
    p.hctx = (float*)take((size_t)RC * 1024 * 4);
    const size_t off_hn = o;
    p.hn = (u16*)take((size_t)MT * 1024 * 2);
    p.y = (u16*)take((size_t)4 * MT * 512 * 2);
    p.arena = ws + o;
    const size_t arena_need = (size_t)MT * 2048 * 2 + (size_t)2 * MT * 512 * 4 + (size_t)2 * MT * 8 * 4 + 4096 + (size_t)MT * 512 * 2;
    size_t mo = off_hn;
    p.gch = (u16*)(ws + mo); mo = al256(mo + (size_t)136 * 256 * 3584);
    p.wt_m13 = (u16*)(ws + mo); mo = al256(mo + (size_t)8 * 7168 * 1024);
    p.wt_m2 = (u16*)(ws + mo); mo = al256(mo + (size_t)8 * 1024 * 3584);
    p.yb = (u16*)(ws + mo); mo = al256(mo + (size_t)67584 * 1024 * 2);
    p.xb8 = (u16*)(ws + mo); mo = al256(mo + (size_t)67584 * 1024);
    if (o + arena_need > ws_size || mo > ws_size) return;

    static int grid = 0;
    if (!grid) {
        int dev = 0, cus = 0, per_cu = 0;
        hipGetDevice(&dev);
        hipDeviceGetAttribute(&cus, hipDeviceAttributeMultiprocessorCount, dev);
        hipFuncSetAttribute((const void*)k_fwd, hipFuncAttributeMaxDynamicSharedMemorySize, LDS_BYTES);
        hipOccupancyMaxActiveBlocksPerMultiprocessor(&per_cu, k_fwd, NT, LDS_BYTES);
        grid = per_cu >= 1 ? cus : 0;
    }
    if (!grid) return;
    hipMemsetAsync(p.bar, 0, 16384, stream);
    if (FP8IN_LAST) hipMemsetAsync(p.wt_in8, 0, (size_t)5888 * 1024, stream);
    k_fwd<<<grid, NT, LDS_BYTES, stream>>>(p);
}
```

```cpp
#define REPMASK 0
#define FP8IN_LAST 0
#define RWREP 0
#include <hip/hip_runtime.h>
#include <stdint.h>
#include <string.h>

typedef unsigned short u16;
typedef short bf16x8 __attribute__((ext_vector_type(8)));
typedef float f32x4 __attribute__((ext_vector_type(4)));
typedef unsigned u32x4 __attribute__((ext_vector_type(4)));
typedef unsigned u32x2 __attribute__((ext_vector_type(2)));

#define NT 512
#define MT 36864
#define RC 4096
#define LDS_BYTES 155648
#define SM_OFF 128

enum { I_x, I_c, I_ctx, I_c_ctx, I_ada_w, I_ada_b, I_norm_mix_g, I_norm_ffn_g, I_w_in, I_hy_conv_w, I_hy_conv_b, I_hy_f_w1, I_hy_f_b1, I_hy_f_w2, I_hy_f_b2,
       I_hy_f_w3, I_hy_f_b3, I_hy_bias, I_rw_mu, I_rw_w0, I_rw_w_up, I_rw_a0, I_rw_a_up, I_rw_g_up, I_rw_k_k, I_rw_k_a, I_rw_r_k, I_rw_ln_g, I_rw_ln_b,
       I_s5_a_re, I_s5_a_im, I_s5_log_dt, I_s5_b_re, I_s5_b_im, I_s5_c_re, I_s5_c_im, I_s5_d, I_s5_glu_w, I_s5_glu_b, I_gla_gate_up, I_gla_gate_b, I_gla_norm_g,
       I_w_branch, I_w_out, I_ffn_w1, I_ffn_w3, I_ffn_w2, I_moe_router_w, I_moe_router_b, I_moe_w1, I_moe_w3, I_moe_w2, I_final_norm_g, N_IN };

struct P {
    const float* in[N_IN];
    float* out;
    unsigned* bar;
    float* mod;
    u16* rvl;
    u16* rvc;
    int* moe_i;
    int* row_tok;
    int* dest_of;
    int* top_i;
    float* top_g;
    u16* wt_in;
    u16* wt_br;
    u16* wt_out;
    u16* wt_f13;
    u16* wt_f2;
    u16* wt_glu;
    u16* wt_g;
    float* hctx;
    u16* hn;
    u16* y;
    char* arena;
    u16* wt_m13;
    u16* wt_m2;
    u16* yb;
    u16* xb8;
    u16* wt_gate8;
    u16* wt_in8;
    u16* gch;
};

typedef const __attribute__((address_space(4))) P* PP;
#define PREF asm volatile("" : "+s"(pp)); const __attribute__((address_space(4))) P& p = *pp; extern __shared__ __attribute__((aligned(16))) char smem_raw[]; char* smem = smem_raw + SM_OFF; (void)smem; const int tix = ltid(); (void)tix
__device__ __forceinline__ int ltid() { int t = threadIdx.x; asm volatile("" : "+v"(t)); return t; }
__device__ __forceinline__ int uni(int v) { return __builtin_amdgcn_readfirstlane(v); }
__device__ __forceinline__ float bf2f(u16 b) { return __uint_as_float(((unsigned)b) << 16); }

#define RLXA __ATOMIC_RELAXED, __HIP_MEMORY_SCOPE_AGENT
#ifndef COH
#define COH 0
#endif
#if COH
__device__ __forceinline__ unsigned ldc_u32(const void* q) { return __hip_atomic_load((unsigned*)q, RLXA); }
__device__ __forceinline__ unsigned long long ldc_u64(const void* q) { return __hip_atomic_load((unsigned long long*)q, RLXA); }
__device__ __forceinline__ float ldc_f32(const void* q) { return __uint_as_float(ldc_u32(q)); }
__device__ __forceinline__ u32x2 ldc_8(const void* q) { const unsigned long long v = ldc_u64(q); u32x2 r; r.x = (unsigned)v; r.y = (unsigned)(v >> 32); return r; }
__device__ __forceinline__ u32x4 ldc_16(const void* q) { const unsigned long long a = ldc_u64(q), b = ldc_u64((const char*)q + 8); u32x4 r; r.x = (unsigned)a; r.y = (unsigned)(a >> 32); r.z = (unsigned)b; r.w = (unsigned)(b >> 32); return r; }
__device__ __forceinline__ f32x4 ldc_f4(const void* q) { const u32x4 v = ldc_16(q); return (f32x4){__uint_as_float(v.x), __uint_as_float(v.y), __uint_as_float(v.z), __uint_as_float(v.w)}; }
__device__ __forceinline__ void stc_u32(void* q, unsigned v) { __hip_atomic_store((unsigned*)q, v, RLXA); }
__device__ __forceinline__ void stc_f32(void* q, float v) { __hip_atomic_store((unsigned*)q, __float_as_uint(v), RLXA); }
__device__ __forceinline__ void stc_8(void* q, u32x2 v) { __hip_atomic_store((unsigned long long*)q, ((unsigned long long)v.y << 32) | v.x, RLXA); }
__device__ __forceinline__ void stc_16(void* q, u32x4 v) { __hip_atomic_store((unsigned long long*)q, ((unsigned long long)v.y << 32) | v.x, RLXA); __hip_atomic_store((unsigned long long*)q + 1, ((unsigned long long)v.w << 32) | v.z, RLXA); }
__device__ __forceinline__ void stc_u16(void* q, u16 v) { __hip_atomic_store((unsigned short*)q, v, RLXA); }
__device__ __forceinline__ void stc_f4(void* q, f32x4 v) { stc_16(q, (u32x4){__float_as_uint(v[0]), __float_as_uint(v[1]), __float_as_uint(v[2]), __float_as_uint(v[3])}); }
__device__ __forceinline__ float ldc_bf(const u16* q) { const unsigned w = ldc_u32((const void*)((size_t)q & ~(size_t)3)); return ((size_t)q & 2) ? __uint_as_float(w & 0xffff0000u) : __uint_as_float(w << 16); }
#define SC1_AUX 16
#else
__device__ __forceinline__ unsigned ldc_u32(const void* q) { return *(const unsigned*)q; }
__device__ __forceinline__ float ldc_f32(const void* q) { return *(const float*)q; }
__device__ __forceinline__ u32x2 ldc_8(const void* q) { return *(const u32x2*)q; }
__device__ __forceinline__ u32x4 ldc_16(const void* q) { return *(const u32x4*)q; }
__device__ __forceinline__ f32x4 ldc_f4(const void* q) { return *(const f32x4*)q; }
__device__ __forceinline__ void stc_u32(void* q, unsigned v) { *(unsigned*)q = v; }
__device__ __forceinline__ void stc_f32(void* q, float v) { *(float*)q = v; }
__device__ __forceinline__ void stc_8(void* q, u32x2 v) { *(u32x2*)q = v; }
__device__ __forceinline__ void stc_16(void* q, u32x4 v) { *(u32x4*)q = v; }
__device__ __forceinline__ void stc_u16(void* q, u16 v) { *(u16*)q = v; }
__device__ __forceinline__ void stc_f4(void* q, f32x4 v) { *(f32x4*)q = v; }
__device__ __forceinline__ float ldc_bf(const u16* q) { return __uint_as_float(((unsigned)*q) << 16); }
#define SC1_AUX 0
#endif
typedef __bf16 bf16x2_t __attribute__((ext_vector_type(2)));
typedef float f32x2_t __attribute__((ext_vector_type(2)));
__device__ __forceinline__ unsigned pk2(float lo, float hi) { const f32x2_t v = {lo, hi}; return __builtin_bit_cast(unsigned, __builtin_convertvector(v, bf16x2_t)); }
__device__ __forceinline__ u16 f2bf(float f) { return (u16)(pk2(f, 0.f) & 0xffffu); }
__device__ __forceinline__ float fexp(float x) { return __builtin_amdgcn_exp2f(x * 1.4426950408889634f); }
__device__ __forceinline__ float frcp(float x) { return __builtin_amdgcn_rcpf(x); }
__device__ __forceinline__ float sigm(float x) { return frcp(1.f + fexp(-x)); }
__device__ __forceinline__ float ftanh(float x) { return 1.f - 2.f * frcp(1.f + fexp(2.f * x)); }
template <int CTRL> __device__ __forceinline__ float dppf(float v) { return __int_as_float(__builtin_amdgcn_update_dpp(0, __float_as_int(v), CTRL, 0xF, 0xF, true)); }
__device__ __forceinline__ float rowsum16(float v) { v += dppf<0xB1>(v); v += dppf<0x4E>(v); v += dppf<0x141>(v); v += dppf<0x140>(v); return v; }
__device__ __forceinline__ float rdl(float v, int l) { return __int_as_float(__builtin_amdgcn_readlane(__float_as_int(v), l)); }
__device__ __forceinline__ float wsum(float v) { v = rowsum16(v); return (rdl(v, 0) + rdl(v, 16)) + (rdl(v, 32) + rdl(v, 48)); }

__device__ __forceinline__ void unpack8(const u32x4 w, float (&o)[8]) { o[0] = __uint_as_float(w.x << 16); o[1] = __uint_as_float(w.x & 0xffff0000u); o[2] = __uint_as_float(w.y << 16); o[3] = __uint_as_float(w.y & 0xffff0000u);
    o[4] = __uint_as_float(w.z << 16); o[5] = __uint_as_float(w.z & 0xffff0000u); o[6] = __uint_as_float(w.w << 16); o[7] = __uint_as_float(w.w & 0xffff0000u); }
__device__ __forceinline__ u32x4 pack8(const float (&o)[8]) { u32x4 w; w.x = pk2(o[0], o[1]); w.y = pk2(o[2], o[3]); w.z = pk2(o[4], o[5]); w.w = pk2(o[6], o[7]); return w; }
__device__ __forceinline__ unsigned pk4_fp8(float a, float b, float c, float d) {
    a = fminf(fmaxf(a, -448.f), 448.f); b = fminf(fmaxf(b, -448.f), 448.f); c = fminf(fmaxf(c, -448.f), 448.f); d = fminf(fmaxf(d, -448.f), 448.f);
    const unsigned w = __builtin_amdgcn_cvt_pk_fp8_f32(a, b, 0, false); return __builtin_amdgcn_cvt_pk_fp8_f32(c, d, w, true); }
__device__ __forceinline__ u32x2 pk4bf(const f32x4 v) { u32x2 w; w.x = pk2(v[0], v[1]); w.y = pk2(v[2], v[3]); return w; }
__device__ __forceinline__ void ld8bf(const u16* q, f32x4& lo, f32x4& hi) { float t[8]; unpack8(ldc_16(q), t); lo = (f32x4){t[0], t[1], t[2], t[3]}; hi = (f32x4){t[4], t[5], t[6], t[7]}; }
__device__ __forceinline__ float sum8lanes(float v) { v += dppf<0xB1>(v); v += dppf<0x4E>(v); v += dppf<0x141>(v); return v; }
__device__ __forceinline__ int mrow_of(int row) { return row < RC ? 16 : ((row - RC) >> 11); }
#define LDSWAIT() asm volatile("s_waitcnt lgkmcnt(0)" ::: "memory")

#define XB_TMO      128
#define XB_XCNT(j)  (256  + 64 * (j))
#define XB_XSUB(j)  (1280 + 64 * (j))
#define XB_XGEN(j)  (2304 + 64 * (j))
#define XB_TOP      3328
#define XB_TOPGEN   3392
#define XCD_BAR_WORDS 3456
#define XB_SPIN_CAP (1u << 18)
#define LAS __attribute__((address_space(3)))

__device__ __forceinline__ unsigned xb_ld(unsigned* p)              { return __hip_atomic_load(p, __ATOMIC_RELAXED, __HIP_MEMORY_SCOPE_AGENT); }
__device__ __forceinline__ unsigned xb_add(unsigned* p, unsigned v) { return __hip_atomic_fetch_add(p, v, __ATOMIC_RELAXED, __HIP_MEMORY_SCOPE_AGENT); }
__device__ __forceinline__ unsigned xb_xcc_id() { return (unsigned)__builtin_amdgcn_s_getreg((3 << 11) | 20) & 0xFu; }
#define XB_SPIN(cond, bar) do { unsigned _sp = 0; while (cond) { __builtin_amdgcn_s_sleep(1); \
    if ((++_sp & 255u) == 0u) { if (xb_ld(&(bar)[XB_TMO])) break; if (_sp > XB_SPIN_CAP) { atomicAdd(&(bar)[XB_TMO], 1u); break; } } } } while (0)

struct XcdBarrier {
    unsigned* bar; unsigned x;
    volatile LAS unsigned* st;
};

__device__ __forceinline__ XcdBarrier xcd_barrier_post(unsigned* bar, volatile LAS unsigned* st) {
    XcdBarrier b; b.bar = bar; b.x = xb_xcc_id(); b.st = st;
    if (threadIdx.x == 0) (void)xb_add(&bar[XB_XCNT(b.x)], 1u);
    return b;
}
__device__ __forceinline__ void xcd_barrier_complete(unsigned* bar, unsigned x, unsigned& nloc, unsigned& nx) {
    const unsigned G = gridDim.x * gridDim.y * gridDim.z;
    unsigned sum, cnt, mine, sp = 0u;
    for (;;) {
        sum = 0u; cnt = 0u; mine = 0u;
#pragma unroll
        for (unsigned j = 0; j < 16; ++j) { const unsigned c = xb_ld(&bar[XB_XCNT(j)]); sum += c; cnt += (c > 0u) ? 1u : 0u; mine = (j == x) ? c : mine; }
        if (sum == G) break;
        __builtin_amdgcn_s_sleep(1);
        if ((++sp & 255u) == 0u) { if (xb_ld(&bar[XB_TMO])) break; if (sp > XB_SPIN_CAP) { atomicAdd(&bar[XB_TMO], 1u); break; } }
    }
    nloc = mine > 0u ? mine : 1u; nx = cnt > 0u ? cnt : 1u;
}

__device__ __forceinline__ void xcd_barrier(const XcdBarrier& b) {
    asm volatile("s_waitcnt vmcnt(0)" ::: "memory");
    __syncthreads();
    if (threadIdx.x == 0) {
        unsigned* bar = b.bar; unsigned bx = b.x; asm volatile("" : "+s"(bar), "+s"(bx));
        __builtin_amdgcn_s_waitcnt(0);
        unsigned nloc = b.st[0], nx = b.st[1];
        if (nloc == 0u) { xcd_barrier_complete(bar, bx, nloc, nx); b.st[0] = nloc; b.st[1] = nx; }
        const unsigned old = xb_add(&bar[XB_XSUB(bx)], 1u);
        const unsigned gen = old / nloc;
        if (old + 1u == (gen + 1u) * nloc) {
            __builtin_amdgcn_fence(__ATOMIC_RELEASE, "agent");
            asm volatile("s_waitcnt vmcnt(0)" ::: "memory");
            const unsigned og = xb_add(&bar[XB_TOP], 1u);
            const unsigned tg = og / nx;
            if (og + 1u == (tg + 1u) * nx) xb_add(&bar[XB_TOPGEN], 1u);
            else XB_SPIN(xb_ld(&bar[XB_TOPGEN]) == tg, bar);
            __builtin_amdgcn_fence(__ATOMIC_ACQUIRE, "agent");
            xb_add(&bar[XB_XGEN(bx)], 1u);
            asm volatile("s_waitcnt vmcnt(0)" ::: "memory");
        } else {
            XB_SPIN(xb_ld(&bar[XB_XGEN(bx)]) == gen, bar);
            __builtin_amdgcn_fence(__ATOMIC_ACQUIRE, "agent");
            asm volatile("s_waitcnt vmcnt(0)" ::: "memory");
        }
    }
    __syncthreads();
}

__device__ __forceinline__ void do_transpose(const float* src, int K, int N, long ldsrc, u16* dst, int G, int GS, int off, char* smem, int f8 = 0) {
    const int tix = ltid();
    float (*t)[65] = (float (*)[65])smem;
    const int tk = K / 64, tn = (N + 63) / 64;
    const int sn = tix >> 3, sk = (tix & 7) * 8;
    for (int u = blockIdx.x; u < tk * tn; u += gridDim.x) {
        const int k0 = (u % tk) * 64, n0 = (u / tk) * 64;
        __syncthreads();
#pragma unroll
        for (int q2 = 0; q2 < 2; ++q2) { const int q = tix + q2 * NT, i = q >> 4, c4 = (q & 15) * 4, n = n0 + c4;
            f32x4 v = (f32x4){0.f, 0.f, 0.f, 0.f};
            if (n < N) v = *(const f32x4*)(src + (long)(k0 + i) * ldsrc + n);
            t[i][c4] = v[0]; t[i][c4 + 1] = v[1]; t[i][c4 + 2] = v[2]; t[i][c4 + 3] = v[3]; }
        __syncthreads();
        { const int n = n0 + sn;
          if (n < N) { float o[8];
#pragma unroll
              for (int e = 0; e < 8; ++e) o[e] = t[sk + e][sn];
              const long dr = (long)(n / G) * GS + (n % G) + off;
              if (f8) { u32x2 w8; w8.x = pk4_fp8(o[0] * 32.f, o[1] * 32.f, o[2] * 32.f, o[3] * 32.f); w8.y = pk4_fp8(o[4] * 32.f, o[5] * 32.f, o[6] * 32.f, o[7] * 32.f); *(u32x2*)((char*)dst + dr * K + k0 + sk) = w8; }
              else *(u32x4*)(dst + dr * K + k0 + sk) = pack8(o); } }
    }
}

__device__ __forceinline__ void ph_mod(PP pp) {
    PREF;
    float* s = (float*)smem; float* red = s + 17 * 1024;
    const int G = (int)gridDim.x, bsh = (int)((blockIdx.x + 64u) % gridDim.x);
    if (bsh >= 192) return;
    for (int i = tix; i < 17 * 1024; i += NT) { const int r = i >> 10, k = i & 1023; const float v = r < 16 ? p.in[I_c][r * 1024 + k] : p.in[I_c_ctx][k]; s[i] = v / (1.f + expf(-v)); }
    __syncthreads();
    const int j = tix & 63, kq = tix >> 6;
    for (int u = bsh; u < 192; u += G) {
        const int l = u / 96, jc = (u % 96) * 64;
        float acc[17];
#pragma unroll
        for (int r = 0; r < 17; ++r) acc[r] = 0.f;
        const float* w = p.in[I_ada_w] + ((size_t)l * 1024 + kq * 128) * 6144 + jc + j;
#pragma unroll 8
        for (int k = 0; k < 128; ++k) { const float wv = w[(size_t)k * 6144];
#pragma unroll
            for (int r = 0; r < 17; ++r) acc[r] += s[r * 1024 + kq * 128 + k] * wv; }
        __syncthreads();
#pragma unroll
        for (int r = 0; r < 17; ++r) red[(kq * 17 + r) * 64 + j] = acc[r];
        __syncthreads();
        for (int o = tix; o < 17 * 64; o += NT) { const int r = o >> 6, jj = o & 63; float a = p.in[I_ada_b][l * 6144 + jc + jj];
#pragma unroll
            for (int q = 0; q < 8; ++q) a += red[(q * 17 + r) * 64 + jj];
            p.mod[(size_t)(l * 17 + r) * 6144 + jc + jj] = a; }
    }
}

__device__ __forceinline__ void ph_filt(PP pp) {
    PREF;
    float* z = (float*)smem; float* h1 = z + 65 * 36; float* h2 = h1 + 65 * 64; u16* tile = (u16*)(h2 + 65 * 64);
    const int tid = tix, wid = tid >> 6, lane = tid & 63;
    const int G = (int)gridDim.x;
    for (int u = (int)((blockIdx.x + 128u) % gridDim.x); u < 288; u += G) {
        const int l = u / 144, r = (u % 144) >> 2, cq = u & 3;
        const int L = r < 4 ? 256 : 2048, k = r < 4 ? r : r - 4;
        __syncthreads();
        for (int idx = tid; idx < 65 * 17; idx += NT) { const int pj = idx / 17, i = idx - pj * 17; const int pos = 64 * k + pj;
            if (i == 16) z[pj * 36] = (float)pos / (float)(L - 1);
            else { const float fr = 1e-4f + (float)i * ((15.f - 1e-4f) / 15.f); const float ang = (6.283185307179586f / (float)L) * (float)pos * fr; z[pj * 36 + 1 + i] = cosf(ang); z[pj * 36 + 17 + i] = -sinf(ang); } }
        __syncthreads();
        for (int idx = tid; idx < 65 * 64; idx += NT) { const int pj = idx >> 6, uu = idx & 63; float a = p.in[I_hy_f_b1][l * 64 + uu];
            for (int i = 0; i < 33; ++i) a += z[pj * 36 + i] * p.in[I_hy_f_w1][(l * 33 + i) * 64 + uu];
            h1[idx] = sinf(a); }
        __syncthreads();
        for (int idx = tid; idx < 65 * 64; idx += NT) { const int pj = idx >> 6, uu = idx & 63; float a = p.in[I_hy_f_b2][l * 64 + uu];
            for (int i = 0; i < 64; ++i) a += h1[pj * 64 + i] * p.in[I_hy_f_w2][(l * 64 + i) * 64 + uu];
            h2[idx] = sinf(a); }
        __syncthreads();
        {
            const int c = tid & 255, ph = tid >> 8, cg = (c < 128 ? 0 : 512) + cq * 128 + (c & 127);
            float wc[64];
#pragma unroll
            for (int i = 0; i < 64; ++i) wc[i] = p.in[I_hy_f_w3][(l * 64 + i) * 1024 + cg];
            const float b3 = p.in[I_hy_f_b3][l * 1024 + cg];
            const float ra = 3.0701134573f, rb = 15.3505672867f;
            const float rate = ra + (float)(cg & 511) * ((rb - ra) / 511.f);
            const float bias0 = cg < 512 ? p.in[I_hy_bias][l * 512 + cg] : 0.f;
            for (int pj = ph * 33; pj < (ph ? 65 : 33); ++pj) {
                const int pos = 64 * k + pj; const float t = (float)pos / (float)(L - 1);
                float a = b3;
#pragma unroll
                for (int i4 = 0; i4 < 16; ++i4) { const f32x4 hv = *(const f32x4*)(h2 + pj * 64 + i4 * 4); a += hv[0] * wc[i4 * 4] + hv[1] * wc[i4 * 4 + 1] + hv[2] * wc[i4 * 4 + 2] + hv[3] * wc[i4 * 4 + 3]; }
                float val = a * expf(-t * rate);
                if (pos == 0) val += bias0;
                if (pos >= L) val = 0.f;
                tile[c * 66 + pj] = f2bf(val);
            }
        }
        __syncthreads();
        u16* rv = L == 2048 ? p.rvl + (size_t)l * 512 * 4096 : p.rvc + (size_t)l * 512 * 512;
        for (int cl = wid; cl < 128; cl += 8) {
            u16* row = rv + (size_t)(cq * 128 + cl) * (2 * L);
            row[L - 64 * k - 64 + lane] = tile[cl * 66 + 64 - lane];
            row[L + 64 * k + lane] = (k == 0 && lane == 0) ? tile[cl * 66] : tile[(128 + cl) * 66 + lane];
        }
    }
}

#define HN8(p) ((char*)(p).arena + (size_t)MT * 4096 * 2)
__device__ __forceinline__ void ph_norm(PP pp, int l, int which, int r0, int r1, int first, int router, int f8) {
    PREF; l = uni(l); which = uni(which); r0 = uni(r0); r1 = uni(r1); first = uni(first); router = uni(router); f8 = uni(f8);
    const int wid = tix >> 6, lane = tix & 63;
    const float* g = p.in[which ? I_norm_ffn_g : I_norm_mix_g] + l * 1024;
    const int shoff = which ? 3072 : 0, scoff = which ? 4096 : 1024;
    LAS int* lc = (LAS int*)smem;
    float* rwT = (float*)smem + 64;
    if (router) { __syncthreads(); if (tix < 8) lc[tix] = 0;
        for (int i = tix; i < 8192; i += NT) rwT[(i & 7) * 1024 + (i >> 3)] = p.in[I_moe_router_w][i];
        __syncthreads(); }
    for (int row = r0 + blockIdx.x * 8 + wid; row < r1; row += gridDim.x * 8) {
        const float* src = row < RC ? ((first ? p.in[I_ctx] : p.hctx) + (size_t)row * 1024) : ((first ? p.in[I_x] : p.out) + (size_t)(row - RC) * 1024);
        const float* md = p.mod + (size_t)(l * 17 + mrow_of(row)) * 6144;
        f32x4 v[4]; float ss = 0.f;
#pragma unroll
        for (int i = 0; i < 4; ++i) { v[i] = ldc_f4(src + i * 256 + lane * 4); ss += v[i][0] * v[i][0] + v[i][1] * v[i][1] + v[i][2] * v[i][2] + v[i][3] * v[i][3]; }
        ss = wsum(ss);
        const float rs = rsqrtf(ss * (1.f / 1024.f) + 1e-6f);
        float lg[8];
#pragma unroll
        for (int e = 0; e < 8; ++e) lg[e] = 0.f;
        f32x4 gg4[4], sc4[4], sh4[4];
#pragma unroll
        for (int i = 0; i < 4; ++i) { const int k = i * 256 + lane * 4; gg4[i] = *(const f32x4*)(g + k); sc4[i] = *(const f32x4*)(md + scoff + k); sh4[i] = *(const f32x4*)(md + shoff + k); }
#pragma unroll
        for (int i = 0; i < 4; ++i) {
            const int k = i * 256 + lane * 4;
            const f32x4 gg = gg4[i], sc = sc4[i], sh = sh4[i];
            f32x4 o;
#pragma unroll
            for (int j = 0; j < 4; ++j) o[j] = v[i][j] * rs * gg[j] * (1.f + sc[j]) + sh[j];
            if (f8) stc_u32((char*)p.hn + (size_t)row * 1024 + k, pk4_fp8(o[0], o[1], o[2], o[3]));
            else { u32x2 w; w.x = pk2(o[0], o[1]); w.y = pk2(o[2], o[3]); stc_8(p.hn + (size_t)row * 1024 + k, w);
                   if (!which) stc_u32(HN8(p) + (size_t)row * 1024 + k, pk4_fp8(o[0], o[1], o[2], o[3])); }
            if (router) {
#pragma unroll
                for (int e = 0; e < 8; ++e) { const f32x4 wv = *(const f32x4*)(rwT + e * 1024 + k); lg[e] += (o[0] * wv[0] + o[1] * wv[1]) + (o[2] * wv[2] + o[3] * wv[3]); }
            }
        }
        if (router) {
#pragma unroll
            for (int e = 0; e < 8; ++e) lg[e] = wsum(lg[e]) + p.in[I_moe_router_b][e];
            if (lane == 0) {
                int i0 = 0; float v0 = lg[0];
#pragma unroll
                for (int e = 1; e < 8; ++e) if (lg[e] > v0) { v0 = lg[e]; i0 = e; }
                int i1 = -1; float v1 = -3.4e38f;
#pragma unroll
                for (int e = 0; e < 8; ++e) if (e != i0 && lg[e] > v1) { v1 = lg[e]; i1 = e; }
                const float e1 = expf(v1 - v0), g0 = 1.f / (1.f + e1), g1 = e1 / (1.f + e1);
                const int tok = row - RC;
                stc_u32(p.top_i + tok * 2, (unsigned)i0); stc_u32(p.top_i + tok * 2 + 1, (unsigned)i1); stc_f32(p.top_g + tok * 2, g0); stc_f32(p.top_g + tok * 2 + 1, g1);
                const int k0 = __hip_atomic_fetch_add(lc + i0, 1, __ATOMIC_RELAXED, __HIP_MEMORY_SCOPE_WORKGROUP), k1 = __hip_atomic_fetch_add(lc + i1, 1, __ATOMIC_RELAXED, __HIP_MEMORY_SCOPE_WORKGROUP);
                stc_u32(p.row_tok + tok * 2, (unsigned)k0); stc_u32(p.row_tok + tok * 2 + 1, (unsigned)k1);
            }
        }
    }
    if (router) { __syncthreads(); if (tix < 8) stc_u32(p.moe_i + 1024 + blockIdx.x * 8 + tix, (unsigned)lc[tix]); }
}

typedef f32x4 Acc[2][2][4][2];
__device__ __forceinline__ int perm32(int rho) { const int n = rho >> 4, i = rho & 15; return 8 * (i >> 2) + 4 * n + (i & 3); }

template <class Pr>
__device__ __forceinline__ void gemm_v1(const Pr& pr, char* smem) {
    const int tid = ltid(), wid = tid >> 6, lane = tid & 63, wr = wid >> 2, wc = wid & 3, fr = lane & 15, fq = lane >> 4;
    u16* sA = (u16*)smem; u16* sB = sA + 256 * 40;
    const int nu = pr.num_units();
    const int kp = (tid & 3) * 8;
    for (int u = blockIdx.x; u < nu; u += gridDim.x) {
        int pm, pn; if (!pr.unit(u, pm, pn)) continue;
        const u16* arow[2]; const u16* brow[2];
#pragma unroll
        for (int i = 0; i < 2; ++i) { const int row = (tid + i * 512) >> 2; arow[i] = pr.a_row(pm, row); brow[i] = pr.b_row(pm, pn, (row & ~31) + perm32(row & 31)); }
        Acc acc;
#pragma unroll
        for (int a = 0; a < 2; ++a)
#pragma unroll
            for (int b = 0; b < 2; ++b)
#pragma unroll
                for (int m = 0; m < 4; ++m)
#pragma unroll
                    for (int n = 0; n < 2; ++n) acc[a][b][m][n] = (f32x4){0.f, 0.f, 0.f, 0.f};
        const int K = pr.K();
        for (int k0 = 0; k0 < K; k0 += 32) {
            u32x4 ra[2], rb[2];
#pragma unroll
            for (int i = 0; i < 2; ++i) { ra[i] = arow[i] ? *(const u32x4*)(arow[i] + k0 + kp) : (u32x4){0u, 0u, 0u, 0u}; rb[i] = *(const u32x4*)(brow[i] + k0 + kp); }
            __syncthreads();
#pragma unroll
            for (int i = 0; i < 2; ++i) { const int row = (tid + i * 512) >> 2; *(u32x4*)(sA + row * 40 + kp) = ra[i]; *(u32x4*)(sB + row * 40 + kp) = rb[i]; }
            __syncthreads();
            bf16x8 af[2][4], bf[2][2];
#pragma unroll
            for (int a = 0; a < 2; ++a)
#pragma unroll
                for (int m = 0; m < 4; ++m) af[a][m] = *(const bf16x8*)(sA + (a * 128 + wr * 64 + m * 16 + fr) * 40 + fq * 8);
#pragma unroll
            for (int b = 0; b < 2; ++b)
#pragma unroll
                for (int n = 0; n < 2; ++n) bf[b][n] = *(const bf16x8*)(sB + (b * 128 + wc * 32 + n * 16 + fr) * 40 + fq * 8);
#pragma unroll
            for (int a = 0; a < 2; ++a)
#pragma unroll
                for (int b = 0; b < 2; ++b)
#pragma unroll
                    for (int m = 0; m < 4; ++m)
#pragma unroll
                        for (int n = 0; n < 2; ++n) acc[a][b][m][n] = __builtin_amdgcn_mfma_f32_16x16x32_bf16(bf[b][n], af[a][m], acc[a][b][m][n], 0, 0, 0);
        }
        pr.epi(acc, pm, pn, wr, wc, fr, fq);
    }
}

struct GPb {
    const u16* A; long lda; const u16* Bt; long ldb; int Kd; int tm0, ntm, ntn;
    __device__ int num_units() const { return ntm * ntn; }
    __device__ bool unit(int u, int& pm, int& pn) const { pm = tm0 + u / ntn; pn = u % ntn; return true; }
    __device__ const u16* a_row(int pm, int r) const { return A + (size_t)(pm * 256 + r) * lda; }
    __device__ const u16* b_row(int pm, int pn, int r) const { return Bt + (size_t)(pn * 256 + r) * ldb; }
    __device__ int K() const { return Kd; }
};
struct PrStore : GPb { u16* O; long ldo; int act; int pad_;
    __device__ void epi(Acc& acc, int pm, int pn, int wr, int wc, int fr, int fq) const {
#pragma unroll
        for (int a = 0; a < 2; ++a)
#pragma unroll
            for (int m = 0; m < 4; ++m) { const size_t row = (size_t)pm * 256 + a * 128 + wr * 64 + m * 16 + fr;
#pragma unroll
                for (int b = 0; b < 2; ++b) { const int col = pn * 256 + b * 128 + wc * 32 + fq * 8; f32x4 v0 = acc[a][b][m][0], v1 = acc[a][b][m][1];
                    if (act == 1) {
#pragma unroll
                        for (int j = 0; j < 4; ++j) { v0[j] = sigm(v0[j]); v1[j] = sigm(v1[j]); } }
                    u32x4 w; w.x = pk2(v0[0], v0[1]); w.y = pk2(v0[2], v0[3]); w.z = pk2(v1[0], v1[1]); w.w = pk2(v1[2], v1[3]);
                    stc_16(O + row * ldo + col, w); } }
    }
};
struct PrBranch : GPb { const u16* g; float* ACC; u16* accb; int mi; float scale;
    __device__ void epi(Acc& acc, int pm, int pn, int wr, int wc, int fr, int fq) const {
#pragma unroll
        for (int a = 0; a < 2; ++a)
#pragma unroll
            for (int m = 0; m < 4; ++m) { const size_t row = (size_t)pm * 256 + a * 128 + wr * 64 + m * 16 + fr;
#pragma unroll
                for (int b = 0; b < 2; ++b) { const int col = pn * 256 + b * 128 + wc * 32 + fq * 8;
                    const u32x4 gw = ldc_16(g + row * 1024 + col);
                    float gv[8]; gv[0] = __uint_as_float(gw.x << 16); gv[1] = __uint_as_float(gw.x & 0xffff0000u); gv[2] = __uint_as_float(gw.y << 16); gv[3] = __uint_as_float(gw.y & 0xffff0000u);
                    gv[4] = __uint_as_float(gw.z << 16); gv[5] = __uint_as_float(gw.z & 0xffff0000u); gv[6] = __uint_as_float(gw.w << 16); gv[7] = __uint_as_float(gw.w & 0xffff0000u);
                    float* ap = ACC + row * 1024 + col;
                    f32x4 o0, o1;
                    if (mi == 0) { o0 = (f32x4){0.f, 0.f, 0.f, 0.f}; o1 = o0; } else { o0 = ldc_f4(ap); o1 = ldc_f4(ap + 4); }
#pragma unroll
                    for (int j = 0; j < 4; ++j) { o0[j] += scale * gv[j] * acc[a][b][m][0][j]; o1[j] += scale * gv[4 + j] * acc[a][b][m][1][j]; }
                    if (mi == 3) { u32x4 w; w.x = pk2(o0[0], o0[1]); w.y = pk2(o0[2], o0[3]); w.z = pk2(o1[0], o1[1]); w.w = pk2(o1[2], o1[3]); stc_16(accb + row * 1024 + col, w); }
                    else { stc_f4(ap, o0); stc_f4(ap + 4, o1); } } }
    }
};
struct PrResid : GPb { const float* oc; const float* ol; float* nc; float* nl; const float* mod; int goff; float scale;
    __device__ void epi(Acc& acc, int pm, int pn, int wr, int wc, int fr, int fq) const {
        const float* gt = mod + (size_t)mrow_of(pm * 256) * 6144 + goff;
#pragma unroll
        for (int a = 0; a < 2; ++a)
#pragma unroll
            for (int m = 0; m < 4; ++m) { const int row = pm * 256 + a * 128 + wr * 64 + m * 16 + fr;
                const float* op = row < RC ? oc + (size_t)row * 1024 : ol + (size_t)(row - RC) * 1024;
                float* np = row < RC ? nc + (size_t)row * 1024 : nl + (size_t)(row - RC) * 1024;
#pragma unroll
                for (int b = 0; b < 2; ++b) { const int col = pn * 256 + b * 128 + wc * 32 + fq * 8;
#pragma unroll
                    for (int n = 0; n < 2; ++n) { const f32x4 o = ldc_f4(op + col + 4 * n), gg = *(const f32x4*)(gt + col + 4 * n); f32x4 r;
#pragma unroll
                        for (int j = 0; j < 4; ++j) r[j] = o[j] + scale * gg[j] * acc[a][b][m][n][j];
                        stc_f4(np + col + 4 * n, r); } } }
    }
};
struct PrSwiglu : GPb { u16* G; long ldg;
    __device__ void epi(Acc& acc, int pm, int pn, int wr, int wc, int fr, int fq) const {
#pragma unroll
        for (int a = 0; a < 2; ++a)
#pragma unroll
            for (int m = 0; m < 4; ++m) { const size_t row = (size_t)pm * 256 + a * 128 + wr * 64 + m * 16 + fr; const int col = pn * 128 + wc * 32 + fq * 8;
                float o[8];
#pragma unroll
                for (int n = 0; n < 2; ++n)
#pragma unroll
                    for (int j = 0; j < 4; ++j) { const float x = acc[a][0][m][n][j]; o[n * 4 + j] = x * sigm(x) * acc[a][1][m][n][j]; }
                stc_16(G + row * ldg + col, pack8(o)); }
    }
};
struct PrGlu : GPb { const u16* ya; const float* gb; u16* O;
    __device__ void epi(Acc& acc, int pm, int pn, int wr, int wc, int fr, int fq) const {
#pragma unroll
        for (int a = 0; a < 2; ++a)
#pragma unroll
            for (int m = 0; m < 4; ++m) { const size_t row = (size_t)pm * 256 + a * 128 + wr * 64 + m * 16 + fr;
#pragma unroll
                for (int b = 0; b < 2; ++b) { const int col = pn * 256 + b * 128 + wc * 32 + fq * 8;
                    const u32x4 yw = ldc_16(ya + row * 512 + col);
                    float yv[8]; yv[0] = __uint_as_float(yw.x << 16); yv[1] = __uint_as_float(yw.x & 0xffff0000u); yv[2] = __uint_as_float(yw.y << 16); yv[3] = __uint_as_float(yw.y & 0xffff0000u);
                    yv[4] = __uint_as_float(yw.z << 16); yv[5] = __uint_as_float(yw.z & 0xffff0000u); yv[6] = __uint_as_float(yw.w << 16); yv[7] = __uint_as_float(yw.w & 0xffff0000u);
                    float o[8];
#pragma unroll
                    for (int n = 0; n < 2; ++n)
#pragma unroll
                        for (int j = 0; j < 4; ++j) o[n * 4 + j] = yv[n * 4 + j] * sigm(acc[a][b][m][n][j] + gb[col + n * 4 + j]);
                    u32x4 w; w.x = pk2(o[0], o[1]); w.y = pk2(o[2], o[3]); w.z = pk2(o[4], o[5]); w.w = pk2(o[6], o[7]);
                    stc_16(O + row * 512 + col, w); } }
    }
};
struct PrMoeUp { const u16* h2; const int* row_tok; const int* mi; const u16* W; u16* G; int t0, nt;
    __device__ int num_units() const { return nt * 28; }
    __device__ bool unit(int u, int& pm, int& pn) const { pm = t0 + u / 28; pn = u % 28; return pm < mi[25]; }
    __device__ const u16* a_row(int pm, int r) const { const int t = row_tok[pm * 256 + r]; return t >= 0 ? h2 + (size_t)(RC + t) * 1024 : (const u16*)0; }
    __device__ const u16* b_row(int pm, int pn, int r) const { return W + ((size_t)mi[32 + pm] * 7168 + pn * 256 + r) * 1024; }
    __device__ int K() const { return 1024; }
    __device__ void epi(Acc& acc, int pm, int pn, int wr, int wc, int fr, int fq) const {
#pragma unroll
        for (int a = 0; a < 2; ++a)
#pragma unroll
            for (int m = 0; m < 4; ++m) { const size_t row = (size_t)(pm - t0) * 256 + a * 128 + wr * 64 + m * 16 + fr; const int col = pn * 128 + wc * 32 + fq * 8;
                float o[8];
#pragma unroll
                for (int n = 0; n < 2; ++n)
#pragma unroll
                    for (int j = 0; j < 4; ++j) { const float x = acc[a][0][m][n][j]; o[n * 4 + j] = x * sigm(x) * acc[a][1][m][n][j]; }
                u32x4 w; w.x = pk2(o[0], o[1]); w.y = pk2(o[2], o[3]); w.z = pk2(o[4], o[5]); w.w = pk2(o[6], o[7]);
                stc_16(G + row * 3584 + col, w); }
    }
};
struct PrMoeDown { const u16* G; const int* mi; const u16* W; u16* yb; int t0, nt;
    __device__ int num_units() const { return nt * 4; }
    __device__ bool unit(int u, int& pm, int& pn) const { pm = t0 + u / 4; pn = u % 4; return pm < mi[25]; }
    __device__ const u16* a_row(int pm, int r) const { return G + (size_t)((pm - t0) * 256 + r) * 3584; }
    __device__ const u16* b_row(int pm, int pn, int r) const { return W + ((size_t)mi[32 + pm] * 1024 + pn * 256 + r) * 3584; }
    __device__ int K() const { return 3584; }
    __device__ void epi(Acc& acc, int pm, int pn, int wr, int wc, int fr, int fq) const {
#pragma unroll
        for (int a = 0; a < 2; ++a)
#pragma unroll
            for (int m = 0; m < 4; ++m) { const size_t row = (size_t)pm * 256 + a * 128 + wr * 64 + m * 16 + fr;
#pragma unroll
                for (int b = 0; b < 2; ++b) { const int col = pn * 256 + b * 128 + wc * 32 + fq * 8; const f32x4 v0 = acc[a][b][m][0], v1 = acc[a][b][m][1];
                    u32x4 w; w.x = pk2(v0[0], v0[1]); w.y = pk2(v0[2], v0[3]); w.z = pk2(v1[0], v1[1]); w.w = pk2(v1[2], v1[3]);
                    stc_16(yb + row * 1024 + col, w); } }
    }
};


#define LAS3 __attribute__((address_space(3)))
#ifndef G8_AUXA
#define G8_AUXA 0
#endif
namespace g8 {
constexpr int BK = 64, HALF = 128, HTB = HALF * BK * 2, STAGE_BYTES = 8 * HTB;
__device__ __forceinline__ int lds_byte(int r, int c) { const int st = (r >> 4) * 2 + (c >> 5), rr = r & 15, cc = c & 31, ob = rr * 64 + cc * 2; return st * 1024 + (ob ^ (((ob >> 9) & 1) << 5)); }
__device__ __forceinline__ void stage_rc(int b, int& R, int& C) { const int st = b / 1024, sb = b % 1024, swz = sb ^ (((sb >> 9) & 1) << 5); R = (st >> 1) * 16 + swz / 64; C = (st & 1) * 32 + (swz % 64) / 2; }
struct U8 { const char* a; const char* b; int kb, kbb; int nt; int pm, pn, kind; };
__device__ __forceinline__ bool order8(int L, int nM, int nN, int& pm, int& pn) {
    const int nwg = nM * nN; if (L >= nwg) return false;
    int wgid = L; { const int q = nwg / 8, r = nwg % 8, xcd = wgid % 8, off = wgid / 8; wgid = (xcd < r ? xcd * (q + 1) : r * (q + 1) + (xcd - r) * q) + off; }
    const int nig = 8 * nN, gid = wgid / nig, fm = gid * 8, gsz = (nM - fm) < 8 ? (nM - fm) : 8;
    pm = fm + ((wgid % nig) % gsz); pn = (wgid % nig) / gsz; return true;
}
template <class Pr>
__device__ __forceinline__ void gemm8(LAS3 unsigned char* lds, const Pr& pr) {
    const int tid = ltid(), wid = __builtin_amdgcn_readfirstlane(tid >> 6), lane = tid & 63, wr = wid >> 2, wc = wid & 3, fr = lane & 15, fq = lane >> 4;
    unsigned RA[2], RB[2], C2[2];
#pragma unroll
    for (int i = 0; i < 2; ++i) { int R, C; stage_rc(tid * 16 + i * 8192, R, C); RA[i] = (unsigned)R; RB[i] = (unsigned)((R & ~31) + perm32(R & 31)); C2[i] = (unsigned)C * 2u; }
    const size_t kstep = (size_t)(BK * 2);
    const unsigned ldsw = (unsigned)wid * 1024u;
    const int aoff = lds_byte(wr * 64 + fr, fq * 8), boff = lds_byte(wc * 32 + fr, fq * 8);
#define G8_SA(b, h) (((b) * 2 + (h)) * HTB)
#define G8_SB(b, h) ((4 + (b) * 2 + (h)) * HTB)
#define G8_STAGE(bufoff, gbase, RR, kb) do { _Pragma("unroll") for (int _i = 0; _i < 2; ++_i) { \
        if ((const void*)RR == (const void*)RA) __builtin_amdgcn_global_load_lds((const unsigned*)((const char*)(gbase) + (RR[_i] * (unsigned)(kb) + C2[_i])), (LAS3 unsigned*)(lds + (bufoff) + ldsw + _i * 8192), 16, 0, G8_AUXA); \
        else __builtin_amdgcn_global_load_lds((const unsigned*)((const char*)(gbase) + (RR[_i] * (unsigned)(kb) + C2[_i])), (LAS3 unsigned*)(lds + (bufoff) + ldsw + _i * 8192), 16, 0, 0); } } while (0)
#define G8_LDA(dst, b, h) do { _Pragma("unroll") for (int m = 0; m < 4; ++m) _Pragma("unroll") for (int k = 0; k < 2; ++k) dst[m][k] = *(const LAS3 bf16x8*)(lds + G8_SA(b, h) + aoff + m * 2048 + k * 1024); } while (0)
#define G8_LDB(dst, b, h) do { _Pragma("unroll") for (int n = 0; n < 2; ++n) _Pragma("unroll") for (int k = 0; k < 2; ++k) dst[n][k] = *(const LAS3 bf16x8*)(lds + G8_SB(b, h) + boff + n * 2048 + k * 1024); } while (0)
#define G8_MMA(ai, bj, At, Bt) do { __builtin_amdgcn_s_setprio(1); _Pragma("unroll") for (int m = 0; m < 4; ++m) _Pragma("unroll") for (int n = 0; n < 2; ++n) _Pragma("unroll") for (int k = 0; k < 2; ++k) \
        acc[ai][bj][m][n] = __builtin_amdgcn_mfma_f32_16x16x32_bf16(Bt[n][k], At[m][k], acc[ai][bj][m][n], 0, 0, 0); __builtin_amdgcn_s_setprio(0); } while (0)
#define G8_WAIT_V(n) asm volatile("s_waitcnt vmcnt(" #n ")" ::: "memory")
#define G8_WAIT_L(n) asm volatile("s_waitcnt lgkmcnt(" #n ")" ::: "memory")
#define G8_BAR __builtin_amdgcn_s_barrier()
#define G8_SCHED __builtin_amdgcn_sched_barrier(0)
    U8 cur, nxt; int ui = 0;
    if (!pr.unit8(0, cur)) return;
    nxt = cur;
    f32x4 acc[2][2][4][2];
#pragma unroll
    for (int a = 0; a < 2; ++a)
#pragma unroll
        for (int b = 0; b < 2; ++b)
#pragma unroll
            for (int m = 0; m < 4; ++m)
#pragma unroll
                for (int n = 0; n < 2; ++n) acc[a][b][m][n] = (f32x4){0.f, 0.f, 0.f, 0.f};
    bf16x8 At[4][2], B0[2][2], B1[2][2];
    const char* cA = cur.a; const char* cB = cur.b; int ckb = cur.kb, ckbb = cur.kbb; size_t chs = (size_t)HALF * ckb, chsb = (size_t)HALF * ckbb;
    G8_STAGE(G8_SB(0, 0), cB, RB, ckbb); G8_STAGE(G8_SB(0, 1), cB + chsb, RB, ckbb); G8_STAGE(G8_SA(0, 0), cA, RA, ckb); G8_STAGE(G8_SA(0, 1), cA + chs, RA, ckb);
    if (wr == 1) G8_BAR;
    G8_WAIT_V(2); G8_BAR;
    G8_STAGE(G8_SB(1, 0), cB + kstep, RB, ckbb); G8_STAGE(G8_SA(1, 0), cA + kstep, RA, ckb); G8_STAGE(G8_SB(1, 1), cB + chsb + kstep, RB, ckbb);
    G8_WAIT_V(6); G8_BAR;
    for (;;) {
        const bool has_next = pr.unit8(ui + 1, nxt);
        const char* nA = has_next ? nxt.a : cA; const char* nB = has_next ? nxt.b : cB; const int nkb = has_next ? nxt.kb : ckb, nkbb = has_next ? nxt.kbb : ckbb;
        const int nt = cur.nt;
        for (int t = 0; t < nt; t += 2) {
            const bool last = (t == nt - 2);
            const char* a1 = cA + (size_t)(t + 1) * kstep;
            const char* a2 = last ? nA : cA + (size_t)(t + 2) * kstep; const char* b2 = last ? nB : cB + (size_t)(t + 2) * kstep;
            const int kb2 = last ? nkb : ckb, kbb2 = last ? nkbb : ckbb; const size_t hs2 = (size_t)HALF * kb2, hsb2 = (size_t)HALF * kbb2;
            const char* a3 = a2 + kstep; const char* b3 = b2 + kstep;
            G8_LDB(B0, 0, 0); G8_LDB(B1, 0, 1); G8_SCHED; G8_LDA(At, 0, 0); G8_STAGE(G8_SA(1, 1), a1 + chs, RA, ckb);
            G8_WAIT_V(8); G8_WAIT_L(0); G8_BAR; G8_MMA(0, 0, At, B0); G8_MMA(0, 1, At, B1); G8_BAR; G8_SCHED;
            G8_LDA(At, 0, 1); G8_STAGE(G8_SB(0, 0), b2, RB, kbb2); G8_STAGE(G8_SB(0, 1), b2 + hsb2, RB, kbb2); G8_STAGE(G8_SA(0, 0), a2, RA, kb2);
            G8_WAIT_V(8); G8_WAIT_L(0); G8_BAR; G8_MMA(1, 0, At, B0); G8_MMA(1, 1, At, B1); G8_BAR; G8_SCHED;
            G8_LDB(B0, 1, 0); G8_LDB(B1, 1, 1); G8_SCHED; G8_LDA(At, 1, 0); G8_STAGE(G8_SA(0, 1), a2 + hs2, RA, kb2);
            G8_WAIT_V(8); G8_WAIT_L(0); G8_BAR; G8_MMA(0, 0, At, B0); G8_MMA(0, 1, At, B1); G8_BAR; G8_SCHED;
            G8_LDA(At, 1, 1); G8_STAGE(G8_SB(1, 0), b3, RB, kbb2); G8_STAGE(G8_SB(1, 1), b3 + hsb2, RB, kbb2); G8_STAGE(G8_SA(1, 0), a3, RA, kb2);
            G8_WAIT_V(8); G8_WAIT_L(0); G8_BAR; G8_MMA(1, 0, At, B0); G8_MMA(1, 1, At, B1); G8_BAR; G8_SCHED;
        }
        if (wr == 0) G8_BAR;
        const bool clr = pr.epi8(acc, cur, wr, wc, fr, fq);
        if (!has_next) break;
        if (clr) {
#pragma unroll
            for (int a = 0; a < 2; ++a)
#pragma unroll
                for (int b = 0; b < 2; ++b)
#pragma unroll
                    for (int m = 0; m < 4; ++m)
#pragma unroll
                        for (int n = 0; n < 2; ++n) acc[a][b][m][n] = (f32x4){0.f, 0.f, 0.f, 0.f};
        }
        cur = nxt; cA = nA; cB = nB; ckb = nkb; ckbb = nkbb; chs = (size_t)HALF * ckb; chsb = (size_t)HALF * ckbb; ++ui;
        if (wr == 1) G8_BAR;
    }
    G8_WAIT_V(0);
    G8_BAR;
#undef G8_SA
#undef G8_SB
#undef G8_STAGE
#undef G8_LDA
#undef G8_LDB
#undef G8_MMA
#undef G8_WAIT_V
#undef G8_WAIT_L
#undef G8_BAR
#undef G8_SCHED
}
typedef int i32x8 __attribute__((ext_vector_type(8)));
typedef short s16x16a __attribute__((ext_vector_type(16), aligned(16)));
template <class Pr>
__device__ __forceinline__ void gemm8f(LAS3 unsigned char* lds, const Pr& pr) {
    const int tid = ltid(), wid = __builtin_amdgcn_readfirstlane(tid >> 6), lane = tid & 63, wr = wid >> 2, wc = wid & 3, fr = lane & 15, fq = lane >> 4;
    unsigned RA[2], RB[2], C2[2];
#pragma unroll
    for (int i = 0; i < 2; ++i) { int R, C; stage_rc(tid * 16 + i * 8192, R, C); RA[i] = (unsigned)R; RB[i] = (unsigned)((R & ~31) + perm32(R & 31)); C2[i] = (unsigned)C * 2u; }
    const size_t kstep = (size_t)(BK * 2);
    const unsigned ldsw = (unsigned)wid * 1024u;
    const int aoff = lds_byte(wr * 64 + fr, fq * 16), boff = lds_byte(wc * 32 + fr, fq * 16);
    const int sca = pr.scale_a(), scb = pr.scale_b();
#define G8_SA(b, h) (((b) * 2 + (h)) * HTB)
#define G8_SB(b, h) ((4 + (b) * 2 + (h)) * HTB)
#define G8_STAGE(bufoff, gbase, RR, kb) do { _Pragma("unroll") for (int _i = 0; _i < 2; ++_i) { \
        if ((const void*)RR == (const void*)RA) __builtin_amdgcn_global_load_lds((const unsigned*)((const char*)(gbase) + (RR[_i] * (unsigned)(kb) + C2[_i])), (LAS3 unsigned*)(lds + (bufoff) + ldsw + _i * 8192), 16, 0, G8_AUXA); \
        else __builtin_amdgcn_global_load_lds((const unsigned*)((const char*)(gbase) + (RR[_i] * (unsigned)(kb) + C2[_i])), (LAS3 unsigned*)(lds + (bufoff) + ldsw + _i * 8192), 16, 0, 0); } } while (0)
#define G8_LDA(dst, b, h) do { _Pragma("unroll") for (int m = 0; m < 4; ++m) { const bf16x8 lo_ = *(const LAS3 bf16x8*)(lds + G8_SA(b, h) + aoff + m * 2048), hi_ = *(const LAS3 bf16x8*)(lds + G8_SA(b, h) + aoff + m * 2048 + 16); dst[m] = __builtin_bit_cast(i32x8, __builtin_shufflevector(lo_, hi_, 0, 1, 2, 3, 4, 5, 6, 7, 8, 9, 10, 11, 12, 13, 14, 15)); } } while (0)
#define G8_LDB(dst, b, h) do { _Pragma("unroll") for (int n = 0; n < 2; ++n) { const bf16x8 lo_ = *(const LAS3 bf16x8*)(lds + G8_SB(b, h) + boff + n * 2048), hi_ = *(const LAS3 bf16x8*)(lds + G8_SB(b, h) + boff + n * 2048 + 16); dst[n] = __builtin_bit_cast(i32x8, __builtin_shufflevector(lo_, hi_, 0, 1, 2, 3, 4, 5, 6, 7, 8, 9, 10, 11, 12, 13, 14, 15)); } } while (0)
#define G8_MMA(ai, bj, At, Bt) do { __builtin_amdgcn_s_setprio(1); asm volatile("s_nop 1"); _Pragma("unroll") for (int m = 0; m < 4; ++m) _Pragma("unroll") for (int n = 0; n < 2; ++n) \
        asm volatile("v_mfma_scale_f32_16x16x128_f8f6f4 %0, %1, %2, %0, %3, %4 op_sel_hi:[0,0,0]" : "+v"(acc[ai][bj][m][n]) : "v"(Bt[n]), "v"(At[m]), "v"(scb), "v"(sca)); __builtin_amdgcn_s_setprio(0); } while (0)
#define G8_WAIT_V(n) asm volatile("s_waitcnt vmcnt(" #n ")" ::: "memory")
#define G8_WAIT_L(n) asm volatile("s_waitcnt lgkmcnt(" #n ")" ::: "memory")
#define G8_BAR __builtin_amdgcn_s_barrier()
#define G8_SCHED __builtin_amdgcn_sched_barrier(0)
    U8 cur, nxt; int ui = 0;
    if (!pr.unit8(0, cur)) return;
    nxt = cur;
    f32x4 acc[2][2][4][2];
#pragma unroll
    for (int a = 0; a < 2; ++a)
#pragma unroll
        for (int b = 0; b < 2; ++b)
#pragma unroll
            for (int m = 0; m < 4; ++m)
#pragma unroll
                for (int n = 0; n < 2; ++n) acc[a][b][m][n] = (f32x4){0.f, 0.f, 0.f, 0.f};
    i32x8 At[4], B0[2], B1[2];
    const char* cA = cur.a; const char* cB = cur.b; int ckb = cur.kb, ckbb = cur.kbb; size_t chs = (size_t)HALF * ckb, chsb = (size_t)HALF * ckbb;
    G8_STAGE(G8_SB(0, 0), cB, RB, ckbb); G8_STAGE(G8_SB(0, 1), cB + chsb, RB, ckbb); G8_STAGE(G8_SA(0, 0), cA, RA, ckb); G8_STAGE(G8_SA(0, 1), cA + chs, RA, ckb);
    if (wr == 1) G8_BAR;
    G8_WAIT_V(2); G8_BAR;
    G8_STAGE(G8_SB(1, 0), cB + kstep, RB, ckbb); G8_STAGE(G8_SA(1, 0), cA + kstep, RA, ckb); G8_STAGE(G8_SB(1, 1), cB + chsb + kstep, RB, ckbb);
    G8_WAIT_V(6); G8_BAR;
    for (;;) {
        const bool has_next = pr.unit8(ui + 1, nxt);
        const char* nA = has_next ? nxt.a : cA; const char* nB = has_next ? nxt.b : cB; const int nkb = has_next ? nxt.kb : ckb, nkbb = has_next ? nxt.kbb : ckbb;
        const int nt = cur.nt;
        for (int t = 0; t < nt; t += 2) {
            const bool last = (t == nt - 2);
            const char* a1 = cA + (size_t)(t + 1) * kstep;
            const char* a2 = last ? nA : cA + (size_t)(t + 2) * kstep; const char* b2 = last ? nB : cB + (size_t)(t + 2) * kstep;
            const int kb2 = last ? nkb : ckb, kbb2 = last ? nkbb : ckbb; const size_t hs2 = (size_t)HALF * kb2, hsb2 = (size_t)HALF * kbb2;
            const char* a3 = a2 + kstep; const char* b3 = b2 + kstep;
            G8_LDB(B0, 0, 0); G8_LDB(B1, 0, 1); G8_SCHED; G8_LDA(At, 0, 0); G8_STAGE(G8_SA(1, 1), a1 + chs, RA, ckb);
            G8_WAIT_V(8); G8_WAIT_L(0); G8_BAR; G8_MMA(0, 0, At, B0); G8_MMA(0, 1, At, B1); G8_BAR; G8_SCHED;
            G8_LDA(At, 0, 1); G8_STAGE(G8_SB(0, 0), b2, RB, kbb2); G8_STAGE(G8_SB(0, 1), b2 + hsb2, RB, kbb2); G8_STAGE(G8_SA(0, 0), a2, RA, kb2);
            G8_WAIT_V(8); G8_WAIT_L(0); G8_BAR; G8_MMA(1, 0, At, B0); G8_MMA(1, 1, At, B1); G8_BAR; G8_SCHED;
            G8_LDB(B0, 1, 0); G8_LDB(B1, 1, 1); G8_SCHED; G8_LDA(At, 1, 0); G8_STAGE(G8_SA(0, 1), a2 + hs2, RA, kb2);
            G8_WAIT_V(8); G8_WAIT_L(0); G8_BAR; G8_MMA(0, 0, At, B0); G8_MMA(0, 1, At, B1); G8_BAR; G8_SCHED;
            G8_LDA(At, 1, 1); G8_STAGE(G8_SB(1, 0), b3, RB, kbb2); G8_STAGE(G8_SB(1, 1), b3 + hsb2, RB, kbb2); G8_STAGE(G8_SA(1, 0), a3, RA, kb2);
            G8_WAIT_V(8); G8_WAIT_L(0); G8_BAR; G8_MMA(1, 0, At, B0); G8_MMA(1, 1, At, B1); G8_BAR; G8_SCHED;
        }
        asm volatile("s_nop 7\n\ts_nop 7\n\ts_nop 7" : "+v"(acc[1][0][0][0]), "+v"(acc[1][0][0][1]), "+v"(acc[1][0][1][0]), "+v"(acc[1][0][1][1]), "+v"(acc[1][0][2][0]), "+v"(acc[1][0][2][1]), "+v"(acc[1][0][3][0]), "+v"(acc[1][0][3][1]), "+v"(acc[1][1][0][0]), "+v"(acc[1][1][0][1]), "+v"(acc[1][1][1][0]), "+v"(acc[1][1][1][1]), "+v"(acc[1][1][2][0]), "+v"(acc[1][1][2][1]), "+v"(acc[1][1][3][0]), "+v"(acc[1][1][3][1]) :: "memory");
        if (wr == 0) G8_BAR;
        const bool clr = pr.epi8(acc, cur, wr, wc, fr, fq);
        if (!has_next) break;
        if (clr) {
#pragma unroll
            for (int a = 0; a < 2; ++a)
#pragma unroll
                for (int b = 0; b < 2; ++b)
#pragma unroll
                    for (int m = 0; m < 4; ++m)
#pragma unroll
                        for (int n = 0; n < 2; ++n) acc[a][b][m][n] = (f32x4){0.f, 0.f, 0.f, 0.f};
        }
        cur = nxt; cA = nA; cB = nB; ckb = nkb; ckbb = nkbb; chs = (size_t)HALF * ckb; chsb = (size_t)HALF * ckbb; ++ui;
        if (wr == 1) G8_BAR;
    }
    G8_WAIT_V(0);
    G8_BAR;
#undef G8_SA
#undef G8_SB
#undef G8_STAGE
#undef G8_LDA
#undef G8_LDB
#undef G8_MMA
#undef G8_WAIT_V
#undef G8_WAIT_L
#undef G8_BAR
#undef G8_SCHED
}
}

template <class Base> struct Dense8 : Base {
    __device__ bool unit8(int i, g8::U8& u) const { int pm, pn; if (!g8::order8(i * (int)gridDim.x + (int)blockIdx.x, this->ntm, this->ntn, pm, pn)) return false; pm += this->tm0;
        u.pm = pm; u.pn = pn; u.kind = 0; u.kb = (int)this->lda * 2; u.kbb = (int)this->ldb * 2; u.nt = this->Kd / 64; u.a = (const char*)(this->A + (size_t)pm * 256 * this->lda); u.b = (const char*)(this->Bt + (size_t)pn * 256 * this->ldb); return true; }
    __device__ bool epi8(Acc& acc, const g8::U8& u, int wr, int wc, int fr, int fq) const { this->epi(acc, u.pm, u.pn, wr, wc, fr, fq); return true; }
};
template <class Base> struct Dense8F : Base {
    int sa_, sb_;
    __device__ int scale_a() const { return sa_; }
    __device__ int scale_b() const { return sb_; }
    __device__ bool unit8(int i, g8::U8& u) const { int pm, pn; if (!g8::order8(i * (int)gridDim.x + (int)blockIdx.x, this->ntm, this->ntn, pm, pn)) return false; pm += this->tm0;
        u.pm = pm; u.pn = pn; u.kind = 0; u.kb = (int)this->lda; u.kbb = (int)this->ldb; u.nt = this->Kd / 128; u.a = (const char*)this->A + (size_t)pm * 256 * this->lda; u.b = (const char*)this->Bt + (size_t)pn * 256 * this->ldb; return true; }
    __device__ bool epi8(Acc& acc, const g8::U8& u, int wr, int wc, int fr, int fq) const { this->epi(acc, u.pm, u.pn, wr, wc, fr, fq); return true; }
};
struct In12 { const u16* A; const u16* Wt; u16* Orw; u16* Os5;
    __device__ bool unit8(int i, g8::U8& u) const { int pm, pn; if (!g8::order8(i * (int)gridDim.x + (int)blockIdx.x, 144, 10, pm, pn)) return false;
        u.pm = pm; u.pn = pn; u.kind = 0; u.kb = 2048; u.kbb = 2048; u.nt = 16; u.a = (const char*)(A + (size_t)pm * 256 * 1024);
        u.b = (const char*)(Wt + (size_t)((pn < 8 ? 1536 + pn * 256 : 3584 + (pn - 8) * 256)) * 1024); return true; }
    __device__ bool epi8(Acc& acc, const g8::U8& u, int wr, int wc, int fr, int fq) const {
        u16* O = u.pn < 8 ? Orw : Os5; const long ldo = u.pn < 8 ? 2048 : 512; const int cb = (u.pn < 8 ? u.pn : u.pn - 8) * 256;
#pragma unroll
        for (int a = 0; a < 2; ++a)
#pragma unroll
            for (int m = 0; m < 4; ++m) { const size_t row = (size_t)u.pm * 256 + a * 128 + wr * 64 + m * 16 + fr;
#pragma unroll
                for (int b = 0; b < 2; ++b) { const int col = cb + b * 128 + wc * 32 + fq * 8; const f32x4 v0 = acc[a][b][m][0], v1 = acc[a][b][m][1];
                    u32x4 w; w.x = pk2(v0[0], v0[1]); w.y = pk2(v0[2], v0[3]); w.z = pk2(v1[0], v1[1]); w.w = pk2(v1[2], v1[3]);
                    stc_16(O + row * ldo + col, w); } }
        return true; }
};
struct MoeUp8 : PrMoeUp { const u16* xb;
    __device__ bool unit8(int i, g8::U8& u) const { int nM = uni((int)ldc_u32(mi + 25)) - t0; nM = nM < 0 ? 0 : (nM > nt ? nt : nM); int pm, pn; if (!g8::order8(i * (int)gridDim.x + (int)blockIdx.x, nM, 28, pm, pn)) return false; pm += t0;
        u.pm = pm; u.pn = pn; u.kind = 0; u.kb = 2048; u.kbb = 2048; u.nt = 16; u.a = (const char*)(xb + (size_t)pm * 256 * 1024); u.b = (const char*)(W + ((size_t)uni((int)ldc_u32(mi + 32 + pm)) * 7168 + pn * 256) * 1024); return true; }
    __device__ bool epi8(Acc& acc, const g8::U8& u, int wr, int wc, int fr, int fq) const { this->epi(acc, u.pm, u.pn, wr, wc, fr, fq); return true; }
};
struct MoeDown8 : PrMoeDown {
    __device__ bool unit8(int i, g8::U8& u) const { int nM = uni((int)ldc_u32(mi + 25)) - t0; nM = nM < 0 ? 0 : (nM > nt ? nt : nM); int pm, pn; if (!g8::order8(i * (int)gridDim.x + (int)blockIdx.x, nM, 4, pm, pn)) return false; pm += t0;
        u.pm = pm; u.pn = pn; u.kind = 0; u.kb = 7168; u.kbb = 7168; u.nt = 56; u.a = (const char*)(G + (size_t)(pm - t0) * 256 * 3584); u.b = (const char*)(W + ((size_t)uni((int)ldc_u32(mi + 32 + pm)) * 1024 + pn * 256) * 3584); return true; }
    __device__ bool epi8(Acc& acc, const g8::U8& u, int wr, int wc, int fr, int fq) const { this->epi(acc, u.pm, u.pn, wr, wc, fr, fq); return true; }
};
struct Branch8 { const u16* y; const u16* wt; const u16* G; u16* acc; int tm0, ntm;
    __device__ bool unit8(int i, g8::U8& u) const { const int ti = i >> 2, m = i & 3; int pm, pn; if (!g8::order8(ti * (int)gridDim.x + (int)blockIdx.x, ntm, 4, pm, pn)) return false; pm += tm0;
        u.pm = pm; u.pn = pn; u.kind = m; u.kb = 1024; u.kbb = 1024; u.nt = 8; u.a = (const char*)(y + ((size_t)m * MT + (size_t)pm * 256) * 512); u.b = (const char*)(wt + ((size_t)m * 1024 + pn * 256) * 512); return true; }
    __device__ bool epi8(Acc& acc_, const g8::U8& u, int wr, int wc, int fr, int fq) const {
        const int m = u.kind;
#pragma unroll
        for (int a = 0; a < 2; ++a)
#pragma unroll
            for (int mm = 0; mm < 4; ++mm) { const size_t row = (size_t)u.pm * 256 + a * 128 + wr * 64 + mm * 16 + fr;
#pragma unroll
                for (int b = 0; b < 2; ++b) { const int col = u.pn * 256 + b * 128 + wc * 32 + fq * 8;
                    float gv[8], o[8]; unpack8(ldc_16(G + row * 4096 + m * 1024 + col), gv);
                    u16* ap = acc + row * 1024 + col;
                    if (m == 0) {
#pragma unroll
                        for (int j = 0; j < 8; ++j) o[j] = 0.f; }
                    else unpack8(*(const u32x4*)ap, o);
#pragma unroll
                    for (int j = 0; j < 4; ++j) { o[j] += gv[j] * acc_[a][b][mm][0][j]; o[4 + j] += gv[4 + j] * acc_[a][b][mm][1][j]; }
                    const u32x4 w = pack8(o);
                    if (m == 3) stc_16(ap, w); else *(u32x4*)ap = w; } }
        return true; }
};
struct MoeUp8F { const char* xb8; const int* mi; const char* W8; char* G8; int t0, nt;
    __device__ int scale_a() const { return 127; }
    __device__ int scale_b() const { return 122; }
    __device__ bool unit8(int i, g8::U8& u) const { int nM = uni((int)ldc_u32(mi + 25)) - t0; nM = nM < 0 ? 0 : (nM > nt ? nt : nM); int pm, pn; if (!g8::order8(i * (int)gridDim.x + (int)blockIdx.x, nM, 28, pm, pn)) return false; pm += t0;
        u.pm = pm; u.pn = pn; u.kind = 0; u.kb = 1024; u.kbb = 1024; u.nt = 8; u.a = xb8 + (size_t)pm * 256 * 1024; u.b = W8 + ((size_t)uni((int)ldc_u32(mi + 32 + pm)) * 7168 + pn * 256) * 1024; return true; }
    __device__ bool epi8(Acc& acc, const g8::U8& u, int wr, int wc, int fr, int fq) const {
#pragma unroll
        for (int a = 0; a < 2; ++a)
#pragma unroll
            for (int m = 0; m < 4; ++m) { const size_t row = (size_t)(u.pm - t0) * 256 + a * 128 + wr * 64 + m * 16 + fr; const int col = u.pn * 128 + wc * 32 + fq * 8;
                float o[8];
#pragma unroll
                for (int n = 0; n < 2; ++n)
#pragma unroll
                    for (int j = 0; j < 4; ++j) { const float x = acc[a][0][m][n][j]; o[n * 4 + j] = 4.f * x * sigm(x) * acc[a][1][m][n][j]; }
                u32x2 w; w.x = pk4_fp8(o[0], o[1], o[2], o[3]); w.y = pk4_fp8(o[4], o[5], o[6], o[7]);
                stc_8(G8 + row * 3584 + col, w); }
        return true; }
};
struct MoeDown8F { const char* G8; const int* mi; const char* W8; u16* yb; int t0, nt;
    __device__ int scale_a() const { return 125; }
    __device__ int scale_b() const { return 122; }
    __device__ bool unit8(int i, g8::U8& u) const { int nM = uni((int)ldc_u32(mi + 25)) - t0; nM = nM < 0 ? 0 : (nM > nt ? nt : nM); int pm, pn; if (!g8::order8(i * (int)gridDim.x + (int)blockIdx.x, nM, 4, pm, pn)) return false; pm += t0;
        u.pm = pm; u.pn = pn; u.kind = 0; u.kb = 3584; u.kbb = 3584; u.nt = 28; u.a = G8 + (size_t)(pm - t0) * 256 * 3584; u.b = W8 + ((size_t)uni((int)ldc_u32(mi + 32 + pm)) * 1024 + pn * 256) * 3584; return true; }
    __device__ bool epi8(Acc& acc, const g8::U8& u, int wr, int wc, int fr, int fq) const {
#pragma unroll
        for (int a = 0; a < 2; ++a)
#pragma unroll
            for (int m = 0; m < 4; ++m) { const size_t row = (size_t)u.pm * 256 + a * 128 + wr * 64 + m * 16 + fr;
#pragma unroll
                for (int b = 0; b < 2; ++b) { const int col = u.pn * 256 + b * 128 + wc * 32 + fq * 8; const f32x4 v0 = acc[a][b][m][0], v1 = acc[a][b][m][1];
                    u32x4 w; w.x = pk2(v0[0], v0[1]); w.y = pk2(v0[2], v0[3]); w.z = pk2(v1[0], v1[1]); w.w = pk2(v1[2], v1[3]);
                    stc_16(yb + row * 1024 + col, w); } }
        return true; }
};
#define GEMM8(pr) g8::gemm8((LAS3 unsigned char*)smem, pr)
#define GEMM8F(pr) g8::gemm8f((LAS3 unsigned char*)smem, pr)

__device__ __forceinline__ void seq_of(int row, int& base, int& t, int& L) {
    if (row < RC) { t = row & 255; L = 256; } else { t = (row - RC) & 2047; L = 2048; }
    base = row - t;
}
__device__ __forceinline__ void mfma_safe(f32x4& acc, const bf16x8 a, const bf16x8 b) {
    acc = __builtin_amdgcn_mfma_f32_16x16x32_bf16(a, b, acc, 0, 0, 0);
    asm volatile("" :: "v"(acc), "v"(a), "v"(b));
}
__device__ __forceinline__ void mfma_ip(f32x4& acc, const bf16x8 a, const bf16x8 b) { asm volatile("v_mfma_f32_16x16x32_bf16 %0, %1, %2, %0" : "+v"(acc) : "v"(a), "v"(b)); }
__device__ __forceinline__ void mfma_settle() { asm volatile("s_nop 7\n\ts_nop 7\n\ts_nop 3" ::: "memory"); }
#define HY_UTL(p) ((u16*)((p).arena + (size_t)MT * 1536 * 2))
#define HY_UTC(p) (HY_UTL(p) + (size_t)512 * 16 * 2048)
#define HY_YTL(p) (HY_UTC(p) + (size_t)512 * 16 * 256)
#define HY_YTC(p) (HY_YTL(p) + (size_t)512 * 16 * 2048)
__device__ __forceinline__ void ph_hy_pre(PP pp, int l) {
    PREF; l = uni(l); const u16* ph = (const u16*)p.arena;
    u16* T = (u16*)smem;
    const int w = tix >> 6, lane = tix & 63, tg = lane >> 3, cg = lane & 7, c0 = w * 64 + cg * 8, s0 = tg * 8;
    const float* cw = p.in[I_hy_conv_w] + l * 3 * 1536; const float* cb = p.in[I_hy_conv_b] + l * 1536;
    for (int tt = (l ? 64 : 0) + blockIdx.x; tt < 576; tt += gridDim.x) {
        const int row0 = tt * 64; int b, t0, L; u16* utb;
        if (row0 < RC) { b = row0 >> 8; t0 = row0 & 255; L = 256; utb = HY_UTC(p) + (size_t)b * 256 + t0; }
        else { b = (row0 - RC) >> 11; t0 = (row0 - RC) & 2047; L = 2048; utb = HY_UTL(p) + (size_t)b * 2048 + t0; }
        float uu[8][8];
#pragma unroll
        for (int j = 0; j < 3; ++j) {
            float w0[8], w1[8], w2[8], bb[8];
#pragma unroll
            for (int e4 = 0; e4 < 2; ++e4) { const f32x4 a0 = *(const f32x4*)(cw + j * 512 + c0 + e4 * 4), a1 = *(const f32x4*)(cw + 1536 + j * 512 + c0 + e4 * 4), a2 = *(const f32x4*)(cw + 3072 + j * 512 + c0 + e4 * 4), a3 = *(const f32x4*)(cb + j * 512 + c0 + e4 * 4);
#pragma unroll
                for (int e = 0; e < 4; ++e) { w0[e4 * 4 + e] = a0[e]; w1[e4 * 4 + e] = a1[e]; w2[e4 * 4 + e] = a2[e]; bb[e4 * 4 + e] = a3[e]; } }
            u32x4 raw[10];
#pragma unroll
            for (int r = 0; r < 10; ++r) { const int t = t0 + s0 - 1 + r; raw[r] = (u32x4){0u, 0u, 0u, 0u};
                if (t >= 0 && t < L) raw[r] = ldc_16(ph + (size_t)(row0 + s0 - 1 + r) * 1536 + j * 512 + c0); }
            float xr[10][8];
#pragma unroll
            for (int r = 0; r < 10; ++r) unpack8(raw[r], xr[r]);
#pragma unroll
            for (int i = 0; i < 8; ++i) {
                float r8[8];
#pragma unroll
                for (int e = 0; e < 8; ++e) r8[e] = xr[i][e] * w0[e] + xr[i + 1][e] * w1[e] + xr[i + 2][e] * w2[e] + bb[e];
                if (j == 0) stc_16(p.y + ((size_t)row0 + s0 + i) * 512 + c0, pack8(r8));
                else if (j == 1) {
#pragma unroll
                    for (int e = 0; e < 8; ++e) uu[i][e] = r8[e]; }
                else {
#pragma unroll
                    for (int e = 0; e < 8; ++e) uu[i][e] = r8[e] * uu[i][e]; }
            }
        }
        __syncthreads();
#pragma unroll
        for (int e = 0; e < 8; ++e) { u32x4 wv; wv.x = pk2(uu[0][e], uu[1][e]); wv.y = pk2(uu[2][e], uu[3][e]); wv.z = pk2(uu[4][e], uu[5][e]); wv.w = pk2(uu[6][e], uu[7][e]); *(u32x4*)(T + (c0 + e) * 72 + s0) = wv; }
        __syncthreads();
        { const int c = tix;
#pragma unroll
          for (int k8 = 0; k8 < 8; ++k8) stc_16(utb + (size_t)c * 16 * L + k8 * 8, *(const u32x4*)(T + c * 72 + k8 * 8)); }
    }
}
template <int L>
__device__ __forceinline__ void hy_conv_items(const u16* rvg, const u16* utg, u16* ytg, char* smem, const int tix) {
    constexpr int TPW = L / 128, CPN = 2 * L + 16, OFS = L + 8, RS = L + 8, NKS = L / 32, UNR = TPW / 2;
    u16* cp = (u16*)smem; u16* us = cp + 8 * CPN;
    const int wid = tix >> 6, lane = tix & 63, r = lane & 15, q = lane >> 4;
    const int a = (8 - (r & 7)) & 7;
    const int tb = a * CPN + 8 * q - r - a + OFS;
    const int ubs = r * RS + 8 * q;
    const int t_w = wid * (TPW * 16);
    for (int c = blockIdx.x; c < 512; c += gridDim.x) {
        __syncthreads();
        for (int idx = tix; idx < 8 * CPN; idx += NT) { const int a_ = idx / CPN, xi = idx - a_ * CPN; const int g = xi - OFS + a_ + L; cp[idx] = (g >= 0 && g < 2 * L) ? rvg[(size_t)c * (2 * L) + g] : (u16)0; }
        for (int pc = tix; pc < 16 * (L / 8); pc += NT) { const int b = pc / (L / 8), k8 = pc - b * (L / 8); *(u32x4*)(us + b * RS + k8 * 8) = ldc_16(utg + ((size_t)c * 16 + b) * L + k8 * 8); }
        __syncthreads();
        f32x4 acc[TPW]; bf16x8 W[TPW];
#pragma unroll
        for (int i = 0; i < TPW; ++i) { acc[i] = (f32x4){0.f, 0.f, 0.f, 0.f}; W[i] = *(const bf16x8*)(cp + tb - (t_w + 16 * i)); }
        for (int ks0 = 0; ks0 < NKS; ks0 += UNR) {
#pragma unroll
            for (int u = 0; u < UNR; ++u) {
                const int ks = ks0 + u;
                const bf16x8 U = *(const bf16x8*)(us + ubs + 32 * ks);
#pragma unroll
                for (int i = TPW - 2; i < TPW; ++i) mfma_safe(acc[i], W[(i - 2 * u + 2 * TPW) % TPW], U);
#pragma unroll
                for (int i = 0; i < 2; ++i) W[(i - 2 * (u + 1) + 2 * TPW) % TPW] = *(const bf16x8*)(cp + tb + 32 * (ks + 1) - (t_w + 16 * i));
#pragma unroll
                for (int i = 0; i < TPW - 2; ++i) mfma_safe(acc[i], W[(i - 2 * u + 2 * TPW) % TPW], U);
            }
        }
#pragma unroll
        for (int i = 0; i < TPW; ++i) { u32x2 w; w.x = pk2(acc[i][0], acc[i][1]); w.y = pk2(acc[i][2], acc[i][3]); stc_8(ytg + ((size_t)c * 16 + r) * L + t_w + 16 * i + 4 * q, w); }
    }
}
__device__ __forceinline__ void ph_hy_conv(PP pp, int l) {
    PREF; l = uni(l);
    hy_conv_items<2048>(p.rvl + (size_t)l * 512 * 4096, HY_UTL(p), HY_YTL(p), smem, tix);
    if (l == 0) hy_conv_items<256>(p.rvc + (size_t)l * 512 * 512, HY_UTC(p), HY_YTC(p), smem, tix);
}
__device__ __forceinline__ void ph_hy_post(PP pp, int l, int shadow) {
    PREF; l = uni(l); (void)shadow;
    u16* T = (u16*)smem;
    const int w = tix >> 6, lane = tix & 63, tg = lane >> 3, cg = lane & 7, c0 = w * 64 + cg * 8, s0 = tg * 8;
    for (int tt = (l ? 64 : 0) + blockIdx.x; tt < 576; tt += gridDim.x) {
        const int row0 = tt * 64; const u16* yt;
        if (row0 < RC) yt = HY_YTC(p) + ((size_t)tix * 16 + (row0 >> 8)) * 256 + (row0 & 255);
        else yt = HY_YTL(p) + ((size_t)tix * 16 + ((row0 - RC) >> 11)) * 2048 + ((row0 - RC) & 2047);
        u32x4 v[8], xr[8];
#pragma unroll
        for (int k = 0; k < 8; ++k) v[k] = ldc_16(yt + 8 * k);
#pragma unroll
        for (int i = 0; i < 8; ++i) xr[i] = ldc_16(p.y + ((size_t)row0 + s0 + i) * 512 + c0);
        __syncthreads();
#pragma unroll
        for (int k = 0; k < 8; ++k) *(u32x4*)(T + tix * 72 + 8 * k) = v[k];
        __syncthreads();
#pragma unroll
        for (int i = 0; i < 8; ++i) { float x0[8], o[8]; unpack8(xr[i], x0);
#pragma unroll
            for (int e = 0; e < 8; ++e) o[e] = x0[e] * bf2f(T[(c0 + e) * 72 + s0 + i]);
            stc_16(p.y + ((size_t)row0 + s0 + i) * 512 + c0, pack8(o)); }
    }
}

__device__ __forceinline__ void ph_rw_scan(PP pp, int l) {
    PREF; l = uni(l); const u16* pr = (const u16*)p.arena; u16* ob = (u16*)(p.arena + (size_t)MT * 2048 * 2); float* bon = (float*)(p.arena + (size_t)MT * 2048 * 2 + (size_t)2 * MT * 512 * 2);
    const int tid = tix, wid = tid >> 6, lane = tid & 63;
    u16* WUt = (u16*)smem;
    u16* AUt = WUt + 64 * 72;
    u16* RAW = AUt + 64 * 72;
    u16* TWb = RAW + 34 * 320;
    u16* ADb = TWb + 32 * 72;
    float* Ks = (float*)(ADb + 32 * 72);
    float* KKv = Ks + 2048; float* Rv = KKv + 2048; float* Vv = Rv + 2048; float* Wv = Vv + 2048; float* Bv = Wv + 2048; float* KDv = Bv + 2048;
    float* bonp = KDv + 2048;
    float* Oc = bonp + 128;
    u16* KT = RAW; u16* BT = KT + 32 * 72; u16* KD = BT + 32 * 72; u16* RT = KD + 32 * 72; u16* AB = RT + 32 * 72; u16* CC = AB + 2 * 16 * 40; u16* Tm = CC + 2 * 16 * 40;
    float* Amat = (float*)(Tm + 2 * 16 * 40);
    float* CUMS = Ks;
    u16* MtT = (u16*)KKv;
    u16* BKt = (u16*)(Oc + 2048);
    u16* UVt = BKt + 2 * 64 * 40;
    u16* Sb = UVt + 2 * 64 * 40;
    float* MUs = (float*)(Sb + 64 * 72);
    float* KKs = MUs + 640;
    float* PC = KKs + 64;
    const int pt = tid >> 4, pc4 = (tid & 15) * 4;
    const int r4 = lane >> 4, kq = lane & 15, v0 = wid * 8 + r4 * 2;
    const int tt = wid >> 2, ct = wid & 3, ech = ct * 16 + (lane & 15), eq = lane >> 4;
    for (int sid = blockIdx.x; sid < 256; sid += gridDim.x) {
        const int b = sid >> 4, h = (sid >> 1) & 7, d = sid & 1;
        __syncthreads();
        for (int i = tid; i < 4096; i += NT) { const int m = i >> 6, ch = i & 63;
            WUt[ch * 72 + m] = f2bf(p.in[I_rw_w_up][((size_t)(l * 2 + d) * 64 + m) * 512 + h * 64 + ch]);
            AUt[ch * 72 + m] = f2bf(p.in[I_rw_a_up][((size_t)(l * 2 + d) * 64 + m) * 512 + h * 64 + ch]); }
        const int cbase[5] = {h * 64, 512 + h * 64, 1024 + h * 64, 1536 + d * 64, 1664 + d * 64};
        for (int i = tid; i < 704; i += NT) { const int ch = i & 63, j = (i >> 6) % 5, wh = i / 320;
            MUs[i] = i < 640 ? p.in[I_rw_mu][(size_t)(l * 2 + wh) * 1920 + cbase[j] + ch] : p.in[I_rw_k_k][l * 512 + h * 64 + ch]; }
        const float e_w0 = p.in[I_rw_w0][(l * 2 + d) * 512 + h * 64 + ech], e_a0 = p.in[I_rw_a0][(l * 2 + d) * 512 + h * 64 + ech], e_ka = p.in[I_rw_k_a][l * 512 + h * 64 + ech], e_rk = p.in[I_rw_r_k][l * 512 + h * 64 + ech];
        f32x4 SS[4];
#pragma unroll
        for (int i = 0; i < 4; ++i) SS[i] = (f32x4){0.f, 0.f, 0.f, 0.f};
        for (int i = tid; i < 2 * 64 * 40 + 64 * 72; i += NT) UVt[i] = (u16)0;
        int prev_row0 = -1;
#define RW_GEOM(fc, L_, base_, tlo_) const int L_ = (fc) < 8 ? 256 : 2048, base_ = (fc) < 8 ? b * 256 : RC + b * 2048, tlo_ = d ? L_ - 32 * (((fc) < 8 ? (fc) : (fc) - 8) + 1) : 32 * ((fc) < 8 ? (fc) : (fc) - 8)
#define RW_FETCH(fc) do { RW_GEOM(fc, Lf, basef, tlof); _Pragma("unroll") for (int i3 = 0; i3 < 3; ++i3) { const int i = tid + i3 * NT; const int rr = i / 40, c8 = i - rr * 40; const int t = tlof - 1 + rr; const int j = c8 >> 3; \
            u32x4 v = (u32x4){0u, 0u, 0u, 0u}; if (i < 34 * 40 && t >= 0 && t < Lf) v = ldc_16(pr + ((size_t)basef + t) * 2048 + cbase[j] + (c8 & 7) * 8); rawreg[i3] = v; } } while (0)
        u32x4 rawreg[3];
        RW_FETCH(0);
        for (int fc = 0; fc < 72; ++fc) {
            {
                RW_GEOM(fc, L, base, t_lo); (void)L;
                __syncthreads();
                if (prev_row0 >= 0) { const f32x4 o = *(const f32x4*)(Oc + pt * 64 + pc4); stc_8(ob + ((size_t)d * MT + prev_row0 + pt) * 512 + h * 64 + pc4, pk4bf(o)); }
#pragma unroll
                for (int i3 = 0; i3 < 3; ++i3) { const int i = tid + i3 * NT; const int rr = i / 40, c8 = i - rr * 40; if (i < 34 * 40) *(u32x4*)(RAW + rr * 320 + c8 * 8) = rawreg[i3]; }
                __syncthreads();
                for (int rwr_ = 0; rwr_ < 1 + ((RWREP >> 0) & 1); ++rwr_) { if (rwr_) __syncthreads();
                {
                    float x[5][4];
#pragma unroll
                    for (int j = 0; j < 5; ++j) { const u32x2 a = *(const u32x2*)(RAW + pt * 320 + j * 64 + pc4), c = *(const u32x2*)(RAW + (pt + 1) * 320 + j * 64 + pc4), n = *(const u32x2*)(RAW + (pt + 2) * 320 + j * 64 + pc4);
                        const float pm[4] = {__uint_as_float(a.x << 16), __uint_as_float(a.x & 0xffff0000u), __uint_as_float(a.y << 16), __uint_as_float(a.y & 0xffff0000u)};
                        const float pc[4] = {__uint_as_float(c.x << 16), __uint_as_float(c.x & 0xffff0000u), __uint_as_float(c.y << 16), __uint_as_float(c.y & 0xffff0000u)};
                        const float pn[4] = {__uint_as_float(n.x << 16), __uint_as_float(n.x & 0xffff0000u), __uint_as_float(n.y << 16), __uint_as_float(n.y & 0xffff0000u)};
                        const f32x4 m0 = *(const f32x4*)(MUs + j * 64 + pc4), m1 = *(const f32x4*)(MUs + 320 + j * 64 + pc4);
#pragma unroll
                        for (int e = 0; e < 4; ++e) x[j][e] = pc[e] + m0[e] * (pm[e] - pc[e]) + m1[e] * (pn[e] - pc[e]); }
                    float kr[4], ss = 0.f;
                    const f32x4 kk_k = *(const f32x4*)(KKs + pc4);
#pragma unroll
                    for (int e = 0; e < 4; ++e) { kr[e] = x[1][e] * kk_k[e]; ss += kr[e] * kr[e]; }
                    ss = rowsum16(ss);
                    const float inv = frcp(fmaxf(__builtin_amdgcn_sqrtf(ss), 1e-12f));
                    *(f32x4*)(Rv + pt * 64 + pc4) = (f32x4){x[0][0], x[0][1], x[0][2], x[0][3]};
                    *(f32x4*)(Ks + pt * 64 + pc4) = (f32x4){x[1][0], x[1][1], x[1][2], x[1][3]};
                    *(f32x4*)(Vv + pt * 64 + pc4) = (f32x4){x[2][0], x[2][1], x[2][2], x[2][3]};
                    *(f32x4*)(KKv + pt * 64 + pc4) = (f32x4){kr[0] * inv, kr[1] * inv, kr[2] * inv, kr[3] * inv};
                    u32x2 tw, ad; tw.x = pk2(ftanh(x[3][0]), ftanh(x[3][1])); tw.y = pk2(ftanh(x[3][2]), ftanh(x[3][3])); ad.x = pk2(x[4][0], x[4][1]); ad.y = pk2(x[4][2], x[4][3]);
                    *(u32x2*)(TWb + pt * 72 + pc4) = tw; *(u32x2*)(ADb + pt * 72 + pc4) = ad;
                }
                }
                __syncthreads();
                for (int rwr_ = 0; rwr_ < 1 + ((RWREP >> 1) & 1); ++rwr_) { if (rwr_) __syncthreads();
                {
                    f32x4 dw = (f32x4){0.f, 0.f, 0.f, 0.f}, da = dw;
#pragma unroll
                    for (int ks = 0; ks < 2; ++ks) {
                        const bf16x8 aw = *(const bf16x8*)(TWb + (tt * 16 + (lane & 15)) * 72 + ks * 32 + eq * 8), aa = *(const bf16x8*)(ADb + (tt * 16 + (lane & 15)) * 72 + ks * 32 + eq * 8);
                        const bf16x8 bw = *(const bf16x8*)(WUt + ech * 72 + ks * 32 + eq * 8), ba = *(const bf16x8*)(AUt + ech * 72 + ks * 32 + eq * 8);
                        mfma_safe(dw, aw, bw); mfma_safe(da, aa, ba);
                    }
                    float lw[4], kap[4], bet[4], kdv[4], rr[4], vvv[4];
#pragma unroll
                    for (int j = 0; j < 4; ++j) { const int tok = tt * 16 + eq * 4 + j;
                        const float wv = -0.606531f * sigm(e_w0 + dw[j]), av = sigm(e_a0 + da[j]);
                        const float ks_ = Ks[tok * 64 + ech], kkv = KKv[tok * 64 + ech], rs = Rv[tok * 64 + ech];
                        const float kd = ks_ * (1.f + (av - 1.f) * e_ka);
                        lw[j] = wv; kap[j] = kkv; bet[j] = kkv * av; kdv[j] = kd; rr[j] = rs; vvv[j] = Vv[tok * 64 + ech];
                        const float bs = rowsum16(rs * kd * e_rk);
                        if ((lane & 15) == 0) bonp[ct * 32 + tok] = bs; }
                    {
                        float pf[4];
                        if (!d) { pf[0] = lw[0]; pf[1] = pf[0] + lw[1]; pf[2] = pf[1] + lw[2]; pf[3] = pf[2] + lw[3]; }
                        else { pf[3] = lw[3]; pf[2] = pf[3] + lw[2]; pf[1] = pf[2] + lw[1]; pf[0] = pf[1] + lw[0]; }
                        const float gt = d ? pf[0] : pf[3];
                        float inc = gt;
                        { const float u1 = __int_as_float(__builtin_amdgcn_ds_bpermute((lane - 16) * 4, __float_as_int(inc))); if (eq >= 1) inc += u1; }
                        { const float u2 = __int_as_float(__builtin_amdgcn_ds_bpermute((lane - 32) * 4, __float_as_int(inc))); if (eq >= 2) inc += u2; }
                        const float tile_tot = __int_as_float(__builtin_amdgcn_ds_bpermute((48 + (lane & 15)) * 4, __float_as_int(inc)));
                        const float excl = d ? tile_tot - inc : inc - gt;
                        const int c = d ? 1 - tt : tt;
                        const int i0 = d ? 12 - 4 * eq : 4 * eq;
                        float bt4[4], kd4[4], vv4[4];
#pragma unroll
                        for (int j = 0; j < 4; ++j) { const float cum = pf[j] + excl, P = fexp(cum), Pm1 = fexp(cum - lw[j]), rP = fexp(-cum);
                            const int ii = d ? 3 - j : j, sp = c * 16 + i0 + ii;
                            KT[sp * 72 + ech] = f2bf(kap[j] * Pm1); BT[sp * 72 + ech] = f2bf(bet[j] * rP); KD[sp * 72 + ech] = f2bf(kdv[j] * rP); RT[sp * 72 + ech] = f2bf(rr[j] * P);
                            bt4[ii] = bet[j] * rP; kd4[ii] = kdv[j] * rP; vv4[ii] = vvv[j];
                            if (i0 + ii == 15) PC[c * 64 + ech] = P; }
                        u32x2 w2;
                        w2.x = pk2(bt4[0], bt4[1]); w2.y = pk2(bt4[2], bt4[3]); *(u32x2*)(BKt + (c * 64 + ech) * 40 + i0) = w2;
                        w2.x = pk2(kd4[0], kd4[1]); w2.y = pk2(kd4[2], kd4[3]); *(u32x2*)(BKt + (c * 64 + ech) * 40 + 16 + i0) = w2;
                        w2.x = pk2(vv4[0], vv4[1]); w2.y = pk2(vv4[2], vv4[3]); *(u32x2*)(UVt + (c * 64 + ech) * 40 + 16 + i0) = w2;
                    }
                }
                }
                __syncthreads();
                if (tid < 32) stc_f32(bon + ((size_t)d * MT + base + t_lo + tid) * 8 + h, (bonp[tid] + bonp[32 + tid]) + (bonp[64 + tid] + bonp[96 + tid]));
                if (fc + 1 < 72) RW_FETCH(fc + 1);
                int tid_o = tid; asm volatile("" : "+v"(tid_o));
                const int tid = tid_o, wid = __builtin_amdgcn_readfirstlane(tid_o >> 6), lane = tid_o & 63;
                for (int rwr_ = 0; rwr_ < 1 + ((RWREP >> 3) & 1); ++rwr_) { if (rwr_) __syncthreads();
                {
                    const int c = wid >> 2, which = wid & 3, c16 = lane & 15, q = lane >> 4;
                    const u16* X = (which < 2) ? KT : RT; const u16* Y = (which & 1) ? KD : BT;
                    f32x4 pa = (f32x4){0.f, 0.f, 0.f, 0.f};
#pragma unroll
                    for (int ks = 0; ks < 2; ++ks) { const bf16x8 a = *(const bf16x8*)(X + (c * 16 + c16) * 72 + ks * 32 + q * 8), bb = *(const bf16x8*)(Y + (c * 16 + c16) * 72 + ks * 32 + q * 8); mfma_safe(pa, a, bb); }
#pragma unroll
                    for (int j = 0; j < 4; ++j) { const int t = 4 * q + j, sx = c16; const bool keep = (which < 2) ? (sx < t) : (sx <= t); const float val = keep ? pa[j] : 0.f;
                        if (which == 0) { Amat[c * 256 + sx * 16 + t] = val; AB[(c * 16 + t) * 40 + sx] = (u16)0; }
                        else if (which == 1) AB[(c * 16 + t) * 40 + 16 + sx] = f2bf(val);
                        else if (which == 2) CC[(c * 16 + t) * 40 + sx] = f2bf(val);
                        else CC[(c * 16 + t) * 40 + 16 + sx] = f2bf(val); }
                    if (which == 0) {
                        LDSWAIT(); const int jcol = lane & 15; float part[16], an[16];
#pragma unroll
                        for (int t = 0; t < 16; ++t) part[t] = (t == jcol) ? 1.f : 0.f;
#pragma unroll
                        for (int t4 = 0; t4 < 4; ++t4) { const f32x4 av = *(const f32x4*)(Amat + c * 256 + t4 * 4); an[t4 * 4] = av[0]; an[t4 * 4 + 1] = av[1]; an[t4 * 4 + 2] = av[2]; an[t4 * 4 + 3] = av[3]; }
#pragma unroll
                        for (int sx = 0; sx < 16; ++sx) { const float xs = part[sx];
                            float acol[16];
#pragma unroll
                            for (int t = 0; t < 16; ++t) acol[t] = an[t];
                            if (sx + 1 < 16) {
#pragma unroll
                                for (int t4 = 0; t4 < 4; ++t4) { const f32x4 av = *(const f32x4*)(Amat + c * 256 + (sx + 1) * 16 + t4 * 4); an[t4 * 4] = av[0]; an[t4 * 4 + 1] = av[1]; an[t4 * 4 + 2] = av[2]; an[t4 * 4 + 3] = av[3]; } }
                            if (lane < 32) Tm[(c * 16 + sx) * 40 + lane] = lane < 16 ? f2bf(xs) : (u16)0;
#pragma unroll
                            for (int t = sx + 1; t < 16; ++t) part[t] -= acol[t] * xs; }
                    }
                }
                }
                __syncthreads();
                if (wid < 4) {
                    const int w = wid, c16 = lane & 15, q = lane >> 4;
#pragma unroll 1
                    for (int c = 0; c < 2; ++c) {
                        *(u32x2*)(MtT + (w * 16 + c16) * 40 + 16 + 4 * q) = (u32x2){0u, 0u};
                        f32x4 m = (f32x4){0.f, 0.f, 0.f, 0.f};
#pragma unroll
                        for (int ks = 0; ks < 2; ++ks) { const bf16x8 a = *(const bf16x8*)(KT + (c * 16 + c16) * 72 + ks * 32 + q * 8), bb = *(const bf16x8*)(Sb + (w * 16 + c16) * 72 + ks * 32 + q * 8); mfma_safe(m, a, bb); }
                        { const bf16x8 a = *(const bf16x8*)(AB + (c * 16 + c16) * 40 + q * 8), bb = *(const bf16x8*)(UVt + (c * 64 + w * 16 + c16) * 40 + q * 8); mfma_safe(m, a, bb); }
                        { u32x2 w2; w2.x = pk2(m[0], m[1]); w2.y = pk2(m[2], m[3]); *(u32x2*)(MtT + (w * 16 + c16) * 40 + 4 * q) = w2; }
                        LDSWAIT();
                        f32x4 u = (f32x4){0.f, 0.f, 0.f, 0.f};
                        { const bf16x8 a = *(const bf16x8*)(Tm + (c * 16 + c16) * 40 + q * 8), bb = *(const bf16x8*)(MtT + (w * 16 + c16) * 40 + q * 8); mfma_safe(u, a, bb); }
                        { u32x2 w2; w2.x = pk2(-u[0], -u[1]); w2.y = pk2(-u[2], -u[3]); *(u32x2*)(UVt + (c * 64 + w * 16 + c16) * 40 + 4 * q) = w2; }
                        LDSWAIT();
                        f32x4 o = (f32x4){0.f, 0.f, 0.f, 0.f};
#pragma unroll
                        for (int ks = 0; ks < 2; ++ks) { const bf16x8 a = *(const bf16x8*)(Sb + (w * 16 + c16) * 72 + ks * 32 + q * 8), bb = *(const bf16x8*)(RT + (c * 16 + c16) * 72 + ks * 32 + q * 8); mfma_safe(o, a, bb); }
                        { const bf16x8 a = *(const bf16x8*)(UVt + (c * 64 + w * 16 + c16) * 40 + q * 8), bb = *(const bf16x8*)(CC + (c * 16 + c16) * 40 + q * 8); mfma_safe(o, a, bb); }
                        { const int sp = c * 16 + c16, tk = d ? 31 - sp : sp; *(f32x4*)(Oc + tk * 64 + w * 16 + 4 * q) = o; }
#pragma unroll
                        for (int kt = 0; kt < 4; ++kt) {
                            const bf16x8 a = *(const bf16x8*)(BKt + (c * 64 + kt * 16 + c16) * 40 + q * 8), bb = *(const bf16x8*)(UVt + (c * 64 + w * 16 + c16) * 40 + q * 8);
                            mfma_safe(SS[kt], a, bb);
                            const f32x4 pc = *(const f32x4*)(PC + c * 64 + kt * 16 + 4 * q);
#pragma unroll
                            for (int j = 0; j < 4; ++j) SS[kt][j] *= pc[j];
                            u32x2 w2; w2.x = pk2(SS[kt][0], SS[kt][1]); w2.y = pk2(SS[kt][2], SS[kt][3]); *(u32x2*)(Sb + (w * 16 + c16) * 72 + kt * 16 + 4 * q) = w2;
                        }
                        LDSWAIT();
                    }
                }
                prev_row0 = base + t_lo;
            }
        }
#undef RW_FETCH
#undef RW_GEOM
        __syncthreads();
        { const f32x4 o = *(const f32x4*)(Oc + pt * 64 + pc4); stc_8(ob + ((size_t)d * MT + prev_row0 + pt) * 512 + h * 64 + pc4, pk4bf(o)); }
    }
}
#define RW_GG(p) ((u16*)((p).arena + (size_t)MT * 2048 * 2 + (size_t)2 * MT * 512 * 2 + (size_t)2 * MT * 8 * 4 + 4096))
__device__ __forceinline__ void rw_sg_rows(PP pp, int l, int r0) {
    PREF; l = uni(l); r0 = uni(r0); u16* pr = (u16*)p.arena;
    const int wid = tix >> 6, lane = tix & 63, l16 = lane & 15, sub = lane >> 4;
    const float* mu = p.in[I_rw_mu] + (size_t)l * 2 * 1920;
    float m0[8], m1[8];
#pragma unroll
    for (int e = 0; e < 8; ++e) { m0[e] = mu[1792 + l16 * 8 + e]; m1[e] = mu[1920 + 1792 + l16 * 8 + e]; }
    for (int row = r0 + ((int)blockIdx.x * 8 + wid) * 4 + sub; row < MT; row += (int)gridDim.x * 32) {
        int base, t, L; seq_of(row, base, t, L);
        const u16* q0 = pr + (size_t)row * 2048 + 1792 + l16 * 8;
        float pc[8], pm[8], pn[8], o[8];
        u32x4 vm = (u32x4){0u, 0u, 0u, 0u}, vn = vm; const u32x4 vc = ldc_16(q0);
        if (t > 0) vm = ldc_16(q0 - 2048);
        if (t < L - 1) vn = ldc_16(q0 + 2048);
        unpack8(vc, pc); unpack8(vm, pm); unpack8(vn, pn);
#pragma unroll
        for (int e = 0; e < 8; ++e) o[e] = sigm(pc[e] + m0[e] * (pm[e] - pc[e]) + m1[e] * (pn[e] - pc[e]));
        stc_16(pr + (size_t)row * 2048 + 1920 + l16 * 8, pack8(o));
    }
}
__device__ __forceinline__ void ph_rw_out(PP pp, int l, int r0) {
    PREF; l = uni(l); r0 = uni(r0); const u16* pr = (const u16*)p.arena; const u16* ob = (const u16*)(p.arena + (size_t)MT * 2048 * 2); const float* bon = (const float*)(p.arena + (size_t)MT * 2048 * 2 + (size_t)2 * MT * 512 * 2); const u16* gg = RW_GG(p);
    const int wid = tix >> 6, lane = tix & 63, c0 = lane * 8, h = lane >> 3;
    const float* mu = p.in[I_rw_mu] + (size_t)l * 2 * 1920;
    float m0[8], m1[8], lg[8], lb[8];
#pragma unroll
    for (int e = 0; e < 8; ++e) { m0[e] = mu[1024 + c0 + e]; m1[e] = mu[1920 + 1024 + c0 + e]; lg[e] = p.in[I_rw_ln_g][l * 512 + c0 + e]; lb[e] = p.in[I_rw_ln_b][l * 512 + c0 + e]; }
    for (int row = r0 + blockIdx.x * 8 + wid; row < MT; row += gridDim.x * 8) {
        int base, t, L; seq_of(row, base, t, L);
        const u16* q0 = pr + (size_t)row * 2048 + 1024 + c0;
        float pc[8], pm[8], pn[8], g[8], o[8];
        f32x4 a0, a1, b0, b1; ld8bf(ob + (size_t)row * 512 + c0, a0, a1); ld8bf(ob + ((size_t)MT + row) * 512 + c0, b0, b1);
        unpack8(ldc_16(q0), pc); unpack8(ldc_16(gg + (size_t)row * 512 + c0), g);
        if (t > 0) unpack8(ldc_16(q0 - 2048), pm); else { for (int e = 0; e < 8; ++e) pm[e] = 0.f; }
        if (t < L - 1) unpack8(ldc_16(q0 + 2048), pn); else { for (int e = 0; e < 8; ++e) pn[e] = 0.f; }
        const float bs = ldc_f32(bon + (size_t)row * 8 + h) + ldc_f32(bon + ((size_t)MT + row) * 8 + h);
        float sm = 0.f;
#pragma unroll
        for (int e = 0; e < 4; ++e) { o[e] = a0[e] + b0[e]; o[4 + e] = a1[e] + b1[e]; }
#pragma unroll
        for (int e = 0; e < 8; ++e) sm += o[e];
        const float mean = sum8lanes(sm) * (1.f / 64.f);
        float sv = 0.f;
#pragma unroll
        for (int e = 0; e < 8; ++e) { o[e] -= mean; sv += o[e] * o[e]; }
        const float rs = rsqrtf(sum8lanes(sv) * (1.f / 64.f) + 64e-5f);
        float y[8];
#pragma unroll
        for (int e = 0; e < 8; ++e) { const float v = pc[e] + m0[e] * (pm[e] - pc[e]) + m1[e] * (pn[e] - pc[e]); y[e] = (o[e] * rs * lg[e] + lb[e] + bs * v) * g[e]; }
        stc_16(p.y + ((size_t)MT + row) * 512 + c0, pack8(y));
    }
}

__device__ __forceinline__ void ph_s5_scan(PP pp, int l) {
    PREF; l = uni(l); const u16* ps = p.y + (size_t)3 * MT * 512; u16* ys = (u16*)(p.arena + (size_t)MT * 512 * 2);
    const int wid = tix >> 6, lane = tix & 63, c = lane & 15, q = lane >> 4;
    if (wid >= 4) return;
    float* X0 = (float*)(smem + wid * 24832);
    u16* Hs = (u16*)(smem + wid * 24832 + 20480);
    for (int sid = blockIdx.x + wid * gridDim.x; sid < 1024; sid += gridDim.x * 4) {
        const int b = sid >> 6, g = (sid >> 1) & 31, d = sid & 1;
        const float dt = expf(p.in[I_s5_log_dt][(l * 2 + d) * 32 + g]);
        const float* are_p = p.in[I_s5_a_re] + ((size_t)(l * 2 + d) * 32 + g) * 64; const float* aim_p = p.in[I_s5_a_im] + ((size_t)(l * 2 + d) * 32 + g) * 64;
        float abr, abi;
        { const float are = are_p[lane], aim = aim_p[lane]; const float mag = expf(are * dt), ang = aim * dt; abr = mag * cosf(ang); abi = mag * sinf(ang); }
        bf16x8 bfr[8];
#pragma unroll
        for (int tn = 0; tn < 4; ++tn) {
            const int n = tn * 16 + c;
            const float are = are_p[n], aim = aim_p[n]; const float mag = expf(are * dt), ang = aim * dt, ar = mag * cosf(ang), ai = mag * sinf(ang);
            const float nr = ar - 1.f, ni = ai, den = are * are + aim * aim, fre = (nr * are + ni * aim) / den, fim = (ni * are - nr * aim) / den;
            unsigned wr[4], wi[4];
#pragma unroll
            for (int j2 = 0; j2 < 4; ++j2) { float vr[2], vi[2];
#pragma unroll
                for (int e = 0; e < 2; ++e) { const int u = 8 * q + 2 * j2 + e; float br = 0.f, bi = 0.f;
                    if (q < 2) { br = p.in[I_s5_b_re][((size_t)(l * 32 + g) * 64 + n) * 16 + u]; bi = p.in[I_s5_b_im][((size_t)(l * 32 + g) * 64 + n) * 16 + u]; }
                    vr[e] = fre * br - fim * bi; vi[e] = fre * bi + fim * br; }
                wr[j2] = pk2(vr[0], vr[1]); wi[j2] = pk2(vi[0], vi[1]); }
            u32x4 t0 = (u32x4){wr[0], wr[1], wr[2], wr[3]}, t1 = (u32x4){wi[0], wi[1], wi[2], wi[3]};
            bfr[tn] = __builtin_bit_cast(bf16x8, t0); bfr[4 + tn] = __builtin_bit_cast(bf16x8, t1);
        }
        bf16x8 cfr[4];
#pragma unroll
        for (int ks = 0; ks < 4; ++ks) { unsigned w[4];
#pragma unroll
            for (int j2 = 0; j2 < 4; ++j2) { float v[2];
#pragma unroll
                for (int e = 0; e < 2; ++e) { const int n = ks * 16 + 4 * q + j2;
                    v[e] = e == 0 ? p.in[I_s5_c_re][((size_t)(l * 32 + g) * 16 + c) * 64 + n] : -p.in[I_s5_c_im][((size_t)(l * 32 + g) * 16 + c) * 64 + n]; }
                w[j2] = pk2(v[0], v[1]); }
            u32x4 t = (u32x4){w[0], w[1], w[2], w[3]}; cfr[ks] = __builtin_bit_cast(bf16x8, t); }
        float hr = 0.f, hi = 0.f;
#define S5_ROW(fc, i) ((fc) < 16 ? (b * 256 + (d ? 255 - (16 * (fc) + (i)) : 16 * (fc) + (i))) : (RC + b * 2048 + (d ? 2047 - (16 * ((fc) - 16) + (i)) : 16 * ((fc) - 16) + (i))))
        u32x4 ua = (u32x4){0u, 0u, 0u, 0u};
        if (q < 2) ua = ldc_16(ps + (size_t)S5_ROW(0, c) * 512 + g * 16 + q * 8);
#define S5_DRIVE(Xb, afr_) do { _Pragma("unroll") for (int tl = 0; tl < 8; ++tl) { f32x4 xa = (f32x4){0.f, 0.f, 0.f, 0.f}; mfma_safe(xa, afr_, bfr[tl]); \
            *(f32x4*)((Xb) + (tl * 16 + c) * 20 + 4 * q) = xa; } } while (0)
        { const bf16x8 afr0 = __builtin_bit_cast(bf16x8, ua); LDSWAIT(); S5_DRIVE(X0, afr0); }
        if (q < 2) ua = ldc_16(ps + (size_t)S5_ROW(1, c) * 512 + g * 16 + q * 8);
        for (int fc = 0; fc < 144; ++fc) {
            float* Xc = X0 + (fc & 1) * 2560; float* Xn = X0 + ((fc & 1) ^ 1) * 2560;
            float xr[16], xi[16];
#pragma unroll
            for (int t4 = 0; t4 < 4; ++t4) { const f32x4 vr = *(const f32x4*)(Xc + lane * 20 + 4 * t4), vi = *(const f32x4*)(Xc + (64 + lane) * 20 + 4 * t4);
#pragma unroll
                for (int e = 0; e < 4; ++e) { xr[4 * t4 + e] = vr[e]; xi[4 * t4 + e] = vi[e]; } }
            if (fc + 1 < 144) { const bf16x8 afr = __builtin_bit_cast(bf16x8, ua);
                if (q < 2 && fc + 2 < 144) ua = ldc_16(ps + (size_t)S5_ROW(fc + 2, c) * 512 + g * 16 + q * 8);
                S5_DRIVE(Xn, afr); }
#pragma unroll
            for (int tk = 0; tk < 16; ++tk) {
                const float nhr = abr * hr - abi * hi + xr[tk], nhi = abr * hi + abi * hr + xi[tk]; hr = nhr; hi = nhi;
                *(unsigned*)(Hs + tk * 136 + 2 * lane) = pk2(hr, hi);
            }
            LDSWAIT();
            f32x4 ya = (f32x4){0.f, 0.f, 0.f, 0.f};
#pragma unroll
            for (int ks = 0; ks < 4; ++ks) { const bf16x8 hf = *(const bf16x8*)(Hs + c * 136 + ks * 32 + q * 8); mfma_safe(ya, cfr[ks], hf); }
            stc_8(ys + ((size_t)d * MT + S5_ROW(fc, c)) * 512 + g * 16 + 4 * q, pk4bf(ya));
        }
#undef S5_DRIVE
#undef S5_ROW
    }
}
__device__ __forceinline__ void ph_s5_act(PP pp, int l, int r0) {
    PREF; l = uni(l); r0 = uni(r0); const u16* ps = p.y + (size_t)3 * MT * 512; const u16* ys = (const u16*)(p.arena + (size_t)MT * 512 * 2); u16* ya = (u16*)(p.arena + (size_t)MT * 512 * 2 + (size_t)2 * MT * 512 * 4);
    const int wid = tix >> 6, lane = tix & 63, c0 = lane * 8;
    float dsk[8];
#pragma unroll
    for (int e = 0; e < 8; ++e) dsk[e] = p.in[I_s5_d][l * 512 + c0 + e];
    for (int row = r0 + blockIdx.x * 8 + wid; row < MT; row += gridDim.x * 8) {
        f32x4 a0, a1, b0, b1; ld8bf(ys + (size_t)row * 512 + c0, a0, a1); ld8bf(ys + ((size_t)MT + row) * 512 + c0, b0, b1);
        float u[8], o[8]; unpack8(ldc_16(ps + (size_t)row * 512 + c0), u);
#pragma unroll
        for (int e = 0; e < 8; ++e) { const float x = (e < 4 ? a0[e & 3] + b0[e & 3] : a1[e & 3] + b1[e & 3]) + dsk[e] * u[e]; o[e] = 0.5f * x * (1.f + ftanh(0.7978845608028654f * (x + 0.044715f * x * x * x))); }
        stc_16(ya + (size_t)row * 512 + c0, pack8(o));
    }
}

typedef __amdgpu_buffer_rsrc_t brsrc_t;
__device__ __forceinline__ brsrc_t mk_rsrc(const void* base, unsigned bytes) { return __builtin_amdgcn_make_buffer_rsrc((void*)base, (short)0, (int)bytes, 0x00020000); }
__device__ __forceinline__ u32x4 ld16_sc1(brsrc_t r, unsigned off) { return __builtin_bit_cast(u32x4, __builtin_amdgcn_raw_buffer_load_b128(r, (int)off, 0, SC1_AUX)); }
__device__ __forceinline__ unsigned ld4_sc1(brsrc_t r, unsigned off) { return __builtin_amdgcn_raw_buffer_load_b32(r, (int)off, 0, SC1_AUX); }
__device__ __forceinline__ void ph_gla_scan(PP pp, int l) {
    PREF; l = uni(l); const u16* pg = (const u16*)p.arena; u16* og = (u16*)(p.arena + (size_t)MT * 1792 * 2);
    const int tid = tix, wid = tid >> 6, lane = tid & 63, c = lane & 15, q = lane >> 4;
    const brsrc_t pgr = mk_rsrc(pg, (unsigned)((size_t)MT * 1792 * 2));
    u16* QT = (u16*)smem; u16* KT = QT + 4608; u16* QH = KT + 4608; u16* KHt = QH + 4608; u16* Vt = KHt + 4608; u16* Pm = Vt + 4608; u16* St = Pm + 4608;
    float* CUM = (float*)(St + 4608); float* TOT = CUM + 4096; float* GB = TOT + 512; float* DEC = GB + 64;
    u16* GUt = (u16*)(DEC + 64); u16* GDp = GUt + 64 * 40;
    const int tok = tid >> 3, c8 = (tid & 7) * 8;
    for (int item = blockIdx.x; item < 256; item += gridDim.x) {
        const int b = item >> 4, h = (item >> 2) & 3, d = (item >> 1) & 1, eh = item & 1;
        __syncthreads();
        for (int i = tid; i < 64 * 40; i += NT) { const int chn = i / 40, m = i - chn * 40; GUt[i] = m < 16 ? f2bf(p.in[I_gla_gate_up][((size_t)(l * 2 + d) * 16 + m) * 256 + h * 64 + chn]) : (u16)0; GDp[i] = (u16)0; GDp[64 * 40 + i] = (u16)0; }
        if (tid < 64) GB[tid] = p.in[I_gla_gate_b][(l * 2 + d) * 256 + h * 64 + tid];
        f32x4 sacc[2];
        sacc[0] = (f32x4){0.f, 0.f, 0.f, 0.f}; sacc[1] = sacc[0];
#define GLA_ROW(s) ((s) < 256 ? (b * 256 + (d ? 255 - (s) : (s))) : (RC + b * 2048 + ((((d ? 2047 - ((s) - 256) : ((s) - 256)) & 31) * 64) + ((d ? 2047 - ((s) - 256) : ((s) - 256)) >> 5))))
        u32x4 rq, rk, rv; unsigned rg;
        { const unsigned ro = (unsigned)GLA_ROW(tok) * 3584u; rq = ld16_sc1(pgr, ro + (h * 64 + c8) * 2); rk = ld16_sc1(pgr, ro + (256 + h * 64 + c8) * 2);
          rv = ld16_sc1(pgr, ro + (512 + h * 128 + eh * 64 + c8) * 2); rg = ld4_sc1(pgr, ro + (1536 + d * 16 + (tid & 7) * 2) * 2); }
        for (int ch = 0; ch < 36; ++ch) {
            const u32x4 cq = rq, ck = rk, cv = rv; const unsigned cg = rg;
            u16* GDc = GDp + (ch & 1) * (64 * 40);
            *(unsigned*)(GDc + tok * 40 + (tid & 7) * 2) = cg;
            __syncthreads();
            if (ch + 1 < 36) { const unsigned ro = (unsigned)GLA_ROW((ch + 1) * 64 + tok) * 3584u; rq = ld16_sc1(pgr, ro + (h * 64 + c8) * 2); rk = ld16_sc1(pgr, ro + (256 + h * 64 + c8) * 2);
                rv = ld16_sc1(pgr, ro + (512 + h * 128 + eh * 64 + c8) * 2); rg = ld4_sc1(pgr, ro + (1536 + d * 16 + (tid & 7) * 2) * 2); }
#pragma unroll
            for (int s2 = 0; s2 < 2; ++s2) { const int id = wid * 2 + s2, tt = id >> 2, ct = id & 3;
                f32x4 g4 = (f32x4){0.f, 0.f, 0.f, 0.f};
                { const bf16x8 a = *(const bf16x8*)(GDc + (tt * 16 + c) * 40 + q * 8), bb = *(const bf16x8*)(GUt + (ct * 16 + c) * 40 + q * 8); mfma_safe(g4, a, bb); }
                const float gb = GB[ct * 16 + c]; float pf[4];
#pragma unroll
                for (int j = 0; j < 4; ++j) { const float x = g4[j] + gb; pf[j] = (fminf(x, 0.f) - __builtin_amdgcn_logf(1.f + fexp(-fabsf(x))) * 0.6931471805599453f) * (1.f / 16.f); }
                pf[1] += pf[0]; pf[2] += pf[1]; pf[3] += pf[2];
                float sgrp = pf[3];
                { const float u1 = __int_as_float(__builtin_amdgcn_ds_bpermute((lane - 16) * 4, __float_as_int(sgrp))); if (q >= 1) sgrp += u1; }
                { const float u2 = __int_as_float(__builtin_amdgcn_ds_bpermute((lane - 32) * 4, __float_as_int(sgrp))); if (q >= 2) sgrp += u2; }
                const float excl = sgrp - pf[3];
#pragma unroll
                for (int j = 0; j < 4; ++j) CUM[(tt * 16 + 4 * q + j) * 64 + ct * 16 + c] = pf[j] + excl;
                if (q == 3) TOT[tt * 64 + ct * 16 + c] = sgrp; }
            __syncthreads();
            {
                float cm[8], rf[8], la[8];
                { const int tt = tok >> 4;
#pragma unroll
                  for (int hh = 0; hh < 2; ++hh) { const f32x4 mv = *(const f32x4*)(CUM + tok * 64 + c8 + 4 * hh), fv = *(const f32x4*)(CUM + 31 * 64 + c8 + 4 * hh), lv = *(const f32x4*)(CUM + 63 * 64 + c8 + 4 * hh);
                      const f32x4 t0 = *(const f32x4*)(TOT + c8 + 4 * hh), t1 = *(const f32x4*)(TOT + 64 + c8 + 4 * hh), t2 = *(const f32x4*)(TOT + 128 + c8 + 4 * hh);
#pragma unroll
                      for (int e = 0; e < 4; ++e) { cm[4 * hh + e] = mv[e] + (tt >= 1 ? t0[e] : 0.f) + (tt >= 2 ? t1[e] : 0.f) + (tt >= 3 ? t2[e] : 0.f); rf[4 * hh + e] = fv[e] + t0[e]; la[4 * hh + e] = lv[e] + (t0[e] + t1[e]) + t2[e]; } }
                  if (tok == 63) {
#pragma unroll
                      for (int e = 0; e < 8; ++e) DEC[c8 + e] = fexp(la[e]); } }
                const unsigned qw[4] = {cq.x, cq.y, cq.z, cq.w}, kw[4] = {ck.x, ck.y, ck.z, ck.w}, vw[4] = {cv.x, cv.y, cv.z, cv.w};
                float qt[8], kt[8], qh[8], kh[8];
#pragma unroll
                for (int e = 0; e < 8; ++e) {
                    const float qv = (e & 1 ? __uint_as_float(qw[e >> 1] & 0xffff0000u) : __uint_as_float(qw[e >> 1] << 16)) * 0.125f;
                    const float kv = (e & 1 ? __uint_as_float(kw[e >> 1] & 0xffff0000u) : __uint_as_float(kw[e >> 1] << 16));
                    const float e1 = fexp(cm[e] - rf[e]), r1 = fexp(rf[e] - cm[e]);
                    qt[e] = qv * e1; kt[e] = kv * r1; qh[e] = qt[e] * fexp(rf[e]); kh[e] = kt[e] * fexp(la[e] - rf[e]);
                }
                u32x4 w;
                w.x = pk2(qt[0], qt[1]); w.y = pk2(qt[2], qt[3]); w.z = pk2(qt[4], qt[5]); w.w = pk2(qt[6], qt[7]); *(u32x4*)(QT + tok * 72 + c8) = w;
                w.x = pk2(kt[0], kt[1]); w.y = pk2(kt[2], kt[3]); w.z = pk2(kt[4], kt[5]); w.w = pk2(kt[6], kt[7]); *(u32x4*)(KT + tok * 72 + c8) = w;
                w.x = pk2(qh[0], qh[1]); w.y = pk2(qh[2], qh[3]); w.z = pk2(qh[4], qh[5]); w.w = pk2(qh[6], qh[7]); *(u32x4*)(QH + tok * 72 + c8) = w;
#pragma unroll
                for (int e = 0; e < 8; ++e) { KHt[(c8 + e) * 72 + tok] = f2bf(kh[e]); Vt[(c8 + e) * 72 + tok] = (u16)(e & 1 ? (vw[e >> 1] >> 16) : (vw[e >> 1] & 0xffffu)); }
#pragma unroll
                for (int s2 = 0; s2 < 2; ++s2) { const int id = wid * 2 + s2, dkt = id >> 2, et = id & 3;
                    u32x2 sw; sw.x = pk2(sacc[s2][0], sacc[s2][1]); sw.y = pk2(sacc[s2][2], sacc[s2][3]); *(u32x2*)(St + (et * 16 + c) * 72 + dkt * 16 + 4 * q) = sw; }
            }
            __syncthreads();
#pragma unroll
            for (int s2 = 0; s2 < 2; ++s2) { const int id = wid * 2 + s2, it = id >> 2, jt = id & 3;
                f32x4 pa = (f32x4){0.f, 0.f, 0.f, 0.f};
                if (jt <= it) {
#pragma unroll
                    for (int ks = 0; ks < 2; ++ks) { const bf16x8 a = *(const bf16x8*)(QT + (it * 16 + c) * 72 + ks * 32 + q * 8), bb = *(const bf16x8*)(KT + (jt * 16 + c) * 72 + ks * 32 + q * 8); mfma_safe(pa, a, bb); } }
#pragma unroll
                for (int jj = 0; jj < 4; ++jj) { const int i = it * 16 + 4 * q + jj, j = jt * 16 + c; Pm[i * 72 + j] = f2bf(i >= j ? pa[jj] : 0.f); } }
            __syncthreads();
#pragma unroll
            for (int s2 = 0; s2 < 2; ++s2) { const int id = wid * 2 + s2, it = id >> 2, et = id & 3;
                f32x4 oa = (f32x4){0.f, 0.f, 0.f, 0.f};
#pragma unroll
                for (int ks = 0; ks < 2; ++ks) { const bf16x8 a = *(const bf16x8*)(Vt + (et * 16 + c) * 72 + ks * 32 + q * 8), bb = *(const bf16x8*)(Pm + (it * 16 + c) * 72 + ks * 32 + q * 8); mfma_safe(oa, a, bb); }
#pragma unroll
                for (int ks = 0; ks < 2; ++ks) { const bf16x8 a = *(const bf16x8*)(St + (et * 16 + c) * 72 + ks * 32 + q * 8), bb = *(const bf16x8*)(QH + (it * 16 + c) * 72 + ks * 32 + q * 8); mfma_safe(oa, a, bb); }
                stc_8(og + ((size_t)d * MT + GLA_ROW(ch * 64 + it * 16 + c)) * 512 + h * 128 + eh * 64 + et * 16 + 4 * q, pk4bf(oa));
                const int dkt = it;
#pragma unroll
                for (int jj = 0; jj < 4; ++jj) sacc[s2][jj] *= DEC[dkt * 16 + 4 * q + jj];
#pragma unroll
                for (int ks = 0; ks < 2; ++ks) { const bf16x8 a = *(const bf16x8*)(KHt + (dkt * 16 + c) * 72 + ks * 32 + q * 8), bb = *(const bf16x8*)(Vt + (et * 16 + c) * 72 + ks * 32 + q * 8); mfma_safe(sacc[s2], a, bb); }
            }
        }
#undef GLA_ROW
    }
}
__device__ __forceinline__ void ph_gla_out(PP pp, int l, int r0) {
    PREF; l = uni(l); r0 = uni(r0); const u16* pg = (const u16*)p.arena; const u16* og = (const u16*)(p.arena + (size_t)MT * 1792 * 2);
    const int wid = tix >> 6, lane = tix & 63, c0 = lane * 8;
    float ng[8];
#pragma unroll
    for (int e = 0; e < 8; ++e) ng[e] = p.in[I_gla_norm_g][l * 128 + ((c0 + e) & 127)];
    for (int row = r0 + blockIdx.x * 8 + wid; row < MT; row += gridDim.x * 8) {
        f32x4 a0, a1, b0, b1; ld8bf(og + (size_t)row * 512 + c0, a0, a1); ld8bf(og + ((size_t)MT + row) * 512 + c0, b0, b1);
        float g[8], o[8], y[8]; unpack8(ldc_16(pg + (size_t)row * 1792 + 1024 + c0), g);
        float ss = 0.f;
#pragma unroll
        for (int e = 0; e < 4; ++e) { o[e] = a0[e] + b0[e]; o[4 + e] = a1[e] + b1[e]; }
#pragma unroll
        for (int e = 0; e < 8; ++e) ss += o[e] * o[e];
        const float rs = rsqrtf(rowsum16(ss) * (1.f / 128.f) + 1e-6f);
#pragma unroll
        for (int e = 0; e < 8; ++e) y[e] = o[e] * rs * ng[e] * g[e] * sigm(g[e]);
        stc_16(p.y + ((size_t)3 * MT + row) * 512 + c0, pack8(y));
    }
}


__device__ __forceinline__ void ph_moe_slot(PP pp) {
    PREF;
    const int G = (int)gridDim.x, wid = tix >> 6, lane = tix & 63;
    int* tab = (int*)smem; int* sh = tab + 8 * G;
    __syncthreads();
    for (int i = tix; i < 8 * G; i += NT) tab[i] = (int)ldc_u32(p.moe_i + 1024 + i);
    __syncthreads();
    if (tix < 8) { int tot = 0, mine = 0; for (int b = 0; b < G; ++b) { const int c = tab[b * 8 + tix]; if (b < (int)blockIdx.x) mine += c; tot += c; } sh[17 + tix] = tot; sh[tix] = mine; }
    __syncthreads();
    if (tix == 0) { int ps = 0, nt = 0;
#pragma unroll 1
        for (int e = 0; e < 8; ++e) { sh[8 + e] = ps; const int tl = (sh[17 + e] + 255) / 256;
            if (blockIdx.x == 0) { int ev = e; asm volatile("" : "+v"(ev));
#pragma unroll 1
                for (int j = 0; j < tl; ++j) stc_u32(p.moe_i + 32 + nt + j, (unsigned)ev); }
            nt += tl; ps += tl * 256; }
        sh[16] = ps; if (blockIdx.x == 0) stc_u32(p.moe_i + 25, (unsigned)nt); }
    __syncthreads();
    for (int row = RC + blockIdx.x * 8 + wid; row < MT; row += G * 8) {
        const int tok = row - RC;
        const int e0 = (int)ldc_u32(p.top_i + tok * 2), e1 = (int)ldc_u32(p.top_i + tok * 2 + 1), k0 = (int)ldc_u32(p.row_tok + tok * 2), k1 = (int)ldc_u32(p.row_tok + tok * 2 + 1);
        const int d0 = sh[8 + e0] + sh[e0] + k0, d1 = sh[8 + e1] + sh[e1] + k1;
        if (lane == 0) { stc_u32(p.dest_of + tok * 2, (unsigned)d0); stc_u32(p.dest_of + tok * 2 + 1, (unsigned)d1); }
        const u32x4 a = ldc_16((const char*)p.hn + (size_t)row * 1024 + lane * 16);
        stc_16((char*)p.xb8 + (size_t)d0 * 1024 + lane * 16, a); stc_16((char*)p.xb8 + (size_t)d1 * 1024 + lane * 16, a);
    }
}
__device__ __forceinline__ void ph_final(PP pp) {
    PREF;
    const int wid = tix >> 6, lane = tix & 63;
    const float* g = p.in[I_final_norm_g];
    for (int tok = blockIdx.x * 8 + wid; tok < 32768; tok += gridDim.x * 8) {
        const float* gt = p.mod + (size_t)(17 + (tok >> 11)) * 6144 + 5120;
        const int d0 = (int)ldc_u32(p.dest_of + tok * 2), d1 = (int)ldc_u32(p.dest_of + tok * 2 + 1); const float g0 = ldc_f32(p.top_g + tok * 2), g1 = ldc_f32(p.top_g + tok * 2 + 1);
        float* hp = p.out + (size_t)tok * 1024;
        f32x4 v[4]; float ss = 0.f;
#pragma unroll
        for (int i = 0; i < 4; ++i) { const int k = i * 256 + lane * 4;
            const u32x2 a = ldc_8(p.yb + (size_t)d0 * 1024 + k), b = ldc_8(p.yb + (size_t)d1 * 1024 + k);
            const f32x4 hh = ldc_f4(hp + k), gg = *(const f32x4*)(gt + k);
            float ya[4] = {__uint_as_float(a.x << 16), __uint_as_float(a.x & 0xffff0000u), __uint_as_float(a.y << 16), __uint_as_float(a.y & 0xffff0000u)};
            float yc[4] = {__uint_as_float(b.x << 16), __uint_as_float(b.x & 0xffff0000u), __uint_as_float(b.y << 16), __uint_as_float(b.y & 0xffff0000u)};
#pragma unroll
            for (int j = 0; j < 4; ++j) { v[i][j] = hh[j] + gg[j] * (g0 * ya[j] + g1 * yc[j]); ss += v[i][j] * v[i][j]; } }
        ss = wsum(ss); const float rs = rsqrtf(ss * (1.f / 1024.f) + 1e-6f);
#pragma unroll
        for (int i = 0; i < 4; ++i) { const int k = i * 256 + lane * 4; const f32x4 gg = *(const f32x4*)(g + k); f32x4 o;
#pragma unroll
            for (int j = 0; j < 4; ++j) o[j] = v[i][j] * rs * gg[j];
            stc_f4(hp + k, o); }
    }
}


__device__ __forceinline__ GPb mkg(const u16* A, long lda, const u16* Bt, long ldb, int K, int tm0, int ntm, int ntn) { GPb g; g.A = A; g.lda = lda; g.Bt = Bt; g.ldb = ldb; g.Kd = K; g.tm0 = tm0; g.ntm = ntm; g.ntn = ntn; return g; }
#define BIGG (1 << 30)
__device__ __forceinline__ void ph_gemm_in(PP pp, int l, int part) {
    PREF; l = uni(l); part = uni(part);
    const int last = (l == 1);
    const u16* wt = p.wt_in + (size_t)l * 9984 * 1024;
    Dense8<PrStore> g;
    if (part == 0) { (GPb&)g = mkg(p.hn, 1024, wt, 1024, 1024, last ? 16 : 0, last ? 128 : 144, 6); g.ldo = 1536; g.act = 0; }
    else if (part == 1) { (GPb&)g = mkg(p.hn, 1024, wt + (size_t)1536 * 1024, 1024, 1024, 0, 144, 8); g.ldo = 2048; g.act = 0; }
    else if (part == 2) { (GPb&)g = mkg(p.hn, 1024, wt + (size_t)3584 * 1024, 1024, 1024, 0, 144, 2); g.ldo = 512; g.act = 0; }
    else if (part == 3) { (GPb&)g = mkg(p.hn, 1024, wt + (size_t)4096 * 1024, 1024, 1024, 0, 144, 7); g.ldo = 1792; g.act = 0; }
    else { (GPb&)g = mkg(p.hn, 1024, wt + (size_t)5888 * 1024, 1024, 1024, last ? 16 : 0, last ? 128 : 144, 16); g.ldo = 4096; g.act = 1; }
    g.O = part == 2 ? p.y + (size_t)3 * MT * 512 : (u16*)p.arena;
    if (FP8IN_LAST && last && part < 4) {
        const int roff = part == 0 ? 0 : part == 1 ? 1536 : part == 2 ? 3584 : 4096;
        Dense8F<PrStore> g8; (GPb&)g8 = (GPb&)g; g8.A = (const u16*)HN8(p); g8.Bt = (const u16*)((const char*)p.wt_in8 + (size_t)roff * 1024); g8.O = g.O; g8.ldo = g.ldo; g8.act = 0; g8.sa_ = 127; g8.sb_ = 122;
        GEMM8F(g8);
    } else GEMM8(g);
}
__device__ __forceinline__ void ph_hn8(PP pp, int r0) {
    PREF; r0 = uni(r0);
    const int wid = tix >> 6, lane = tix & 63;
    for (int row = r0 + blockIdx.x * 8 + wid; row < MT; row += gridDim.x * 8) {
        float a[8], b[8]; unpack8(ldc_16(p.hn + (size_t)row * 1024 + lane * 16), a); unpack8(ldc_16(p.hn + (size_t)row * 1024 + lane * 16 + 8), b);
        u32x4 w; w.x = pk4_fp8(a[0], a[1], a[2], a[3]); w.y = pk4_fp8(a[4], a[5], a[6], a[7]); w.z = pk4_fp8(b[0], b[1], b[2], b[3]); w.w = pk4_fp8(b[4], b[5], b[6], b[7]);
        stc_16(HN8(p) + (size_t)row * 1024 + lane * 16, w);
    }
}
__device__ __forceinline__ void ph_gemm_gates(PP pp, int l) {
    PREF; l = uni(l); const int last = (l == 1);
    Dense8F<PrStore> g; (GPb&)g = mkg((const u16*)HN8(p), 1024, (const u16*)((const char*)p.wt_gate8 + (size_t)l * 4096 * 1024), 1024, 1024, last ? 16 : 0, last ? 128 : 144, 16); g.ldo = 4096; g.act = 1; g.O = (u16*)p.arena; g.sa_ = 127; g.sb_ = 122;
    GEMM8F(g);
}
__device__ __forceinline__ void ph_gemm_in12(PP pp, int l) {
    PREF; l = uni(l);
    In12 g; g.A = p.hn; g.Wt = p.wt_in + (size_t)l * 9984 * 1024; g.Orw = (u16*)p.arena; g.Os5 = p.y + (size_t)3 * MT * 512;
    GEMM8(g);
}
__device__ __forceinline__ void ph_gemm_rwg(PP pp, int l) {
    PREF; l = uni(l); const int last = (l == 1);
    Dense8<PrStore> g; (GPb&)g = mkg((const u16*)p.arena + 1792, 2048, p.wt_g + (size_t)l * 512 * 256, 256, 256, last ? 16 : 0, last ? 128 : 144, 2); g.O = RW_GG(p); g.ldo = 512; g.act = 0;
    GEMM8(g);
}
__device__ __forceinline__ void ph_gemm_glu(PP pp, int l) {
    PREF; l = uni(l); const int last = (l == 1);
    u16* ya = (u16*)(p.arena + (size_t)MT * 512 * 2 + (size_t)2 * MT * 512 * 4);
    Dense8<PrGlu> q; (GPb&)q = mkg(ya, 512, p.wt_glu + (size_t)l * 512 * 512, 512, 512, last ? 16 : 0, last ? 128 : 144, 2); q.ya = ya; q.gb = p.in[I_s5_glu_b] + l * 512; q.O = p.y + (size_t)2 * MT * 512;
    GEMM8(q);
}
__device__ __forceinline__ void ph_gemm_branch4(PP pp, int l) {
    PREF; l = uni(l); const int last = (l == 1);
    Branch8 q; q.y = p.y; q.wt = p.wt_br + (size_t)l * 4 * 1024 * 512; q.G = (const u16*)p.arena; q.acc = p.hn; q.tm0 = last ? 16 : 0; q.ntm = last ? 128 : 144;
    GEMM8(q);
}
__device__ __forceinline__ void ph_gemm_resid(PP pp, int l, int which, float scale) {
    PREF; l = uni(l); which = uni(which); const int last = (l == 1), first = (l == 0);
    Dense8<PrResid> r;
    if (which == 0) { (GPb&)r = mkg(p.hn, 1024, p.wt_out + (size_t)l * 1024 * 1024, 1024, 1024, last ? 16 : 0, last ? 128 : 144, 4);
        r.oc = first ? p.in[I_ctx] : p.hctx; r.ol = first ? p.in[I_x] : p.out; r.goff = 2048; }
    else { (GPb&)r = mkg((const u16*)p.arena, 2816, p.wt_f2, 2816, 2816, 0, 144, 4); r.oc = p.hctx; r.ol = p.out; r.goff = 5120; }
    r.nc = p.hctx; r.nl = p.out; r.mod = p.mod + (size_t)l * 17 * 6144; r.scale = scale;
    GEMM8(r);
}
__device__ __forceinline__ void ph_gemm_ffn_up(PP pp) {
    PREF;
    Dense8<PrSwiglu> s; (GPb&)s = mkg(p.hn, 1024, p.wt_f13, 1024, 1024, 0, 144, 22); s.G = (u16*)p.arena; s.ldg = 2816;
    GEMM8(s);
}
__device__ __forceinline__ void ph_gemm_moe_up(PP pp, int ch) {
    PREF; ch = uni(ch);
    MoeUp8F u; u.xb8 = (const char*)p.xb8; u.mi = p.moe_i; u.W8 = (const char*)p.wt_m13; u.G8 = (char*)p.gch; u.t0 = ch * 128; u.nt = ch ? 136 : 128;
    GEMM8F(u);
}
__device__ __forceinline__ void ph_gemm_moe_down(PP pp, int ch) {
    PREF; ch = uni(ch);
    MoeDown8F dn; dn.G8 = (const char*)p.gch; dn.mi = p.moe_i; dn.W8 = (const char*)p.wt_m2; dn.yb = p.yb; dn.t0 = ch * 128; dn.nt = ch ? 136 : 128;
    GEMM8F(dn);
}
__device__ __forceinline__ void ph_prep(PP pp) {
    PREF;
    for (int l = 0; l < 2; ++l) {
        const float* wi = p.in[I_w_in] + (size_t)l * 1024 * 9632; u16* wt = p.wt_in + (size_t)l * 9984 * 1024;
        do_transpose(wi + 0, 1024, 1536, 9632, wt, BIGG, 0, 0, smem);
        do_transpose(wi + 1536, 1024, 1920, 9632, wt, BIGG, 0, 1536, smem);
        do_transpose(wi + 3456, 1024, 512, 9632, wt, BIGG, 0, 3584, smem);
        do_transpose(wi + 3968, 1024, 1568, 9632, wt, BIGG, 0, 4096, smem);
        do_transpose(wi + 5536, 1024, 4096, 9632, (u16*)((char*)p.wt_gate8 + (size_t)l * 4096 * 1024), BIGG, 0, 0, smem, 1);
        if (FP8IN_LAST && l == 1) { do_transpose(wi + 0, 1024, 1536, 9632, p.wt_in8, BIGG, 0, 0, smem, 1); do_transpose(wi + 1536, 1024, 1920, 9632, p.wt_in8, BIGG, 0, 1536, smem, 1);
                      do_transpose(wi + 3456, 1024, 512, 9632, p.wt_in8, BIGG, 0, 3584, smem, 1); do_transpose(wi + 3968, 1024, 1568, 9632, p.wt_in8, BIGG, 0, 4096, smem, 1); }
        for (int m = 0; m < 4; ++m) do_transpose(p.in[I_w_branch] + (size_t)(l * 4 + m) * 512 * 1024, 512, 1024, 1024, p.wt_br + (size_t)(l * 4 + m) * 1024 * 512, BIGG, 0, 0, smem);
        do_transpose(p.in[I_w_out] + (size_t)l * 1024 * 1024, 1024, 1024, 1024, p.wt_out + (size_t)l * 1024 * 1024, BIGG, 0, 0, smem);
        do_transpose(p.in[I_s5_glu_w] + (size_t)l * 512 * 512, 512, 512, 512, p.wt_glu + (size_t)l * 512 * 512, BIGG, 0, 0, smem);
        for (int i = blockIdx.x * NT + tix; i < 128 * 512; i += gridDim.x * NT) { const int n = i >> 7, k = i & 127; p.wt_g[((size_t)l * 512 + n) * 256 + 128 + k] = f2bf(p.in[I_rw_g_up][((size_t)l * 128 + k) * 512 + n]); }
    }
    do_transpose(p.in[I_ffn_w1], 1024, 2816, 2816, p.wt_f13, 128, 256, 0, smem);
    do_transpose(p.in[I_ffn_w3], 1024, 2816, 2816, p.wt_f13, 128, 256, 128, smem);
    do_transpose(p.in[I_ffn_w2], 2816, 1024, 1024, p.wt_f2, BIGG, 0, 0, smem);
}
__device__ __forceinline__ void ph_prep_moe(PP pp) {
    PREF;
    for (int e = 0; e < 8; ++e) {
        do_transpose(p.in[I_moe_w1] + (size_t)e * 1024 * 3584, 1024, 3584, 3584, (u16*)((char*)p.wt_m13 + (size_t)e * 7168 * 1024), 128, 256, 0, smem, 1);
        do_transpose(p.in[I_moe_w3] + (size_t)e * 1024 * 3584, 1024, 3584, 3584, (u16*)((char*)p.wt_m13 + (size_t)e * 7168 * 1024), 128, 256, 128, smem, 1);
        do_transpose(p.in[I_moe_w2] + (size_t)e * 3584 * 1024, 3584, 1024, 1024, (u16*)((char*)p.wt_m2 + (size_t)e * 1024 * 3584), BIGG, 0, 0, smem, 1);
    }
}


__device__ __forceinline__ void l2_scrub(PP pp, int parity) {
    PREF; parity = uni(parity);
    const u32x4* src = (const u32x4*)(parity ? p.in[I_moe_w3] : p.in[I_moe_w1]) + (size_t)blockIdx.x * 16384;
    u32x4 a = (u32x4){0u, 0u, 0u, 0u};
#pragma unroll 8
    for (int i = tix; i < 16384; i += NT) { const u32x4 v = src[i]; a.x ^= v.x; a.y ^= v.y; a.z ^= v.z; a.w ^= v.w; }
    asm volatile("" :: "v"(a.x), "v"(a.y), "v"(a.z), "v"(a.w));
}

__global__ void __launch_bounds__(NT, 2) k_fwd(P p_) {
    extern __shared__ __attribute__((aligned(16))) char smem_raw[];
    PP pp = (PP)__builtin_amdgcn_kernarg_segment_ptr();
    if (threadIdx.x == 0) *(uint4*)smem_raw = make_uint4(0u, 0u, 0u, 0u);
    __syncthreads();
    XcdBarrier bar = xcd_barrier_post(pp->bar, (volatile LAS unsigned*)smem_raw);
    int scr = 0;
#define GSYNC() do { (void)scr; for (int _b = 0; _b < (((REPMASK) >> 9) & 1) + 1; ++_b) xcd_barrier(bar); } while (0)
#ifndef REPN
#define REPN 1
#endif
#define RP(bit) for (int _r = 0; _r < (((REPMASK) >> (bit)) & 1) * REPN + 1; ++_r)
    RP(0) { ph_mod(pp); ph_filt(pp); ph_prep(pp); }
    GSYNC();
    for (int l = 0; l < 2; ++l) {
        const int first = (l == 0), last = (l == 1);
        const int r0L = last ? RC : 0;
        RP(5) { ph_norm(pp, l, 0, 0, MT, first, 0, 0); GSYNC(); }
        RP(1) { ph_gemm_in(pp, l, 0); GSYNC(); }
        RP(2) { ph_hy_pre(pp, l); GSYNC(); }
        RP(2) { ph_hy_conv(pp, l); GSYNC(); }
        ph_hy_post(pp, l, 0);
        RP(1) { ph_gemm_in12(pp, l); GSYNC(); }
        RP(3) { rw_sg_rows(pp, l, r0L); ph_rw_scan(pp, l); GSYNC(); }
        RP(1) { ph_gemm_rwg(pp, l); GSYNC(); }
        RP(10) { ph_rw_out(pp, l, r0L); GSYNC(); }
        RP(4) { ph_s5_scan(pp, l); GSYNC(); }
        RP(5) { ph_s5_act(pp, l, r0L); GSYNC(); }
        RP(10) ph_gemm_glu(pp, l);
        RP(1) { ph_gemm_in(pp, l, 3); GSYNC(); }
        RP(6) { ph_gla_scan(pp, l); GSYNC(); }
        RP(5) { ph_gla_out(pp, l, r0L); GSYNC(); }
        RP(1) { ph_gemm_gates(pp, l); GSYNC(); }
        ph_gemm_branch4(pp, l); GSYNC();
        if ((REPMASK >> 11) & 1) { ph_gemm_resid(pp, l, 0, 0.f); GSYNC(); }
        ph_gemm_resid(pp, l, 0, 1.f); GSYNC();
        if (!last) {
            RP(5) { ph_norm(pp, l, 1, 0, MT, 0, 0, 0); GSYNC(); }
            RP(7) { ph_gemm_ffn_up(pp); GSYNC(); }
            ph_gemm_resid(pp, l, 1, 1.f); GSYNC();
        } else {
            RP(8) { ph_prep_moe(pp); }
            RP(11) { ph_norm(pp, l, 1, RC, MT, 0, 1, 1); GSYNC(); }
            RP(11) { ph_moe_slot(pp); GSYNC(); }
            for (int ch = 0; ch < 2; ++ch) {
                RP(7) { ph_gemm_moe_up(pp, ch); GSYNC(); }
                RP(7) { ph_gemm_moe_down(pp, ch); GSYNC(); }
            }
            ph_final(pp);
        }
    }
}

static inline size_t al256(size_t x) { return (x + 255) & ~(size_t)255; }

extern "C" void kernel_launch(void* const* d_in, const int* in_sizes, int n_in, void* d_out, int out_size, void* d_ws, size_t ws_size, hipStream_t stream) {
    P p; memset(&p, 0, sizeof(p));
    for (int i = 0; i < N_IN; ++i) p.in[i] = (const float*)d_in[i];
    p.out = (float*)d_out;
    char* ws = (char*)d_ws; size_t o = 0;
    auto take = [&](size_t bytes) { char* r = ws + o; o = al256(o + bytes); return r; };
    p.bar = (unsigned*)take(16384);
    p.moe_i = (int*)take(32768);
    p.row_tok = (int*)take((size_t)67584 * 4);
    p.mod = (float*)take((size_t)2 * 17 * 6144 * 4);
    p.rvl = (u16*)take((size_t)2 * 512 * 4096 * 2);
    p.rvc = (u16*)take((size_t)2 * 512 * 512 * 2);
    p.dest_of = (int*)take((size_t)65536 * 4);
    p.top_i = (int*)take((size_t)65536 * 4);
    p.top_g = (float*)take((size_t)65536 * 4);
    p.wt_in = (u16*)take((size_t)2 * 9984 * 1024 * 2);
    p.wt_br = (u16*)take((size_t)2 * 4 * 1024 * 512 * 2);
    p.wt_out = (u16*)take((size_t)2 * 1024 * 1024 * 2);
    p.wt_f13 = (u16*)take((size_t)5632 * 1024 * 2);
    p.wt_f2 = (u16*)take((size_t)1024 * 2816 * 2);
    p.wt_glu = (u16*)take((size_t)2 * 512 * 512 * 2);
    p.wt_g = (u16*)take((size_t)2 * 512 * 256 * 2);
    p.wt_gate8 = (u16*)take((size_t)2 * 4096 * 1024);
    p.wt_in8 = (u16*)take((size_t)5888 * 1024);
    p.hctx = (float*)take((size_t)RC * 1024 * 4);
    const size_t off_hn = o;
    p.hn = (u16*)take((size_t)MT * 1024 * 2);
    p.y = (u16*)take((size_t)4 * MT * 512 * 2);
    p.arena = ws + o;
    const size_t arena_need = (size_t)MT * 2048 * 2 + (size_t)2 * MT * 512 * 4 + (size_t)2 * MT * 8 * 4 + 4096 + (size_t)MT * 512 * 2;
    size_t mo = off_hn;
    p.gch = (u16*)(ws + mo); mo = al256(mo + (size_t)136 * 256 * 3584);
    p.wt_m13 = (u16*)(ws + mo); mo = al256(mo + (size_t)8 * 7168 * 1024);
    p.wt_m2 = (u16*)(ws + mo); mo = al256(mo + (size_t)8 * 1024 * 3584);
    p.yb = (u16*)(ws + mo); mo = al256(mo + (size_t)67584 * 1024 * 2);
    p.xb8 = (u16*)(ws + mo); mo = al256(mo + (size_t)67584 * 1024);
    if (o + arena_need > ws_size || mo > ws_size) return;

    static int grid = 0;
    if (!grid) {
        int dev = 0, cus = 0, per_cu = 0;
        hipGetDevice(&dev);
        hipDeviceGetAttribute(&cus, hipDeviceAttributeMultiprocessorCount, dev);
        hipFuncSetAttribute((const void*)k_fwd, hipFuncAttributeMaxDynamicSharedMemorySize, LDS_BYTES);
        hipOccupancyMaxActiveBlocksPerMultiprocessor(&per_cu, k_fwd, NT, LDS_BYTES);
        grid = per_cu >= 1 ? cus : 0;
    }
    if (!grid) return;
    hipMemsetAsync(p.bar, 0, 16384, stream);
    hipMemsetAsync(p.wt_in, 0, (size_t)2 * 9984 * 1024 * 2, stream);
    hipMemsetAsync(p.wt_g, 0, (size_t)2 * 512 * 256 * 2, stream);
    if (FP8IN_LAST) hipMemsetAsync(p.wt_in8, 0, (size_t)5888 * 1024, stream);
    k_fwd<<<grid, NT, LDS_BYTES, stream>>>(p);
}
```

```cpp
#define REPMASK 0
#define FP8IN_LAST 0
#define RWREP 0
#include <hip/hip_runtime.h>
#include <stdint.h>
#include <string.h>

typedef unsigned short u16;
typedef short bf16x8 __attribute__((ext_vector_type(8)));
typedef float f32x4 __attribute__((ext_vector_type(4)));
typedef unsigned u32x4 __attribute__((ext_vector_type(4)));
typedef unsigned u32x2 __attribute__((ext_vector_type(2)));

#define NT 512
#define MT 36864
#define RC 4096
#define LDS_BYTES 155648
#define SM_OFF 128

enum { I_x, I_c, I_ctx, I_c_ctx, I_ada_w, I_ada_b, I_norm_mix_g, I_norm_ffn_g, I_w_in, I_hy_conv_w, I_hy_conv_b, I_hy_f_w1, I_hy_f_b1, I_hy_f_w2, I_hy_f_b2,
       I_hy_f_w3, I_hy_f_b3, I_hy_bias, I_rw_mu, I_rw_w0, I_rw_w_up, I_rw_a0, I_rw_a_up, I_rw_g_up, I_rw_k_k, I_rw_k_a, I_rw_r_k, I_rw_ln_g, I_rw_ln_b,
       I_s5_a_re, I_s5_a_im, I_s5_log_dt, I_s5_b_re, I_s5_b_im, I_s5_c_re, I_s5_c_im, I_s5_d, I_s5_glu_w, I_s5_glu_b, I_gla_gate_up, I_gla_gate_b, I_gla_norm_g,
       I_w_branch, I_w_out, I_ffn_w1, I_ffn_w3, I_ffn_w2, I_moe_router_w, I_moe_router_b, I_moe_w1, I_moe_w3, I_moe_w2, I_final_norm_g, N_IN };

struct P {
    const float* in[N_IN];
    float* out;
    unsigned* bar;
    float* mod;
    u16* rvl;
    u16* rvc;
    int* moe_i;
    int* row_tok;
    int* dest_of;
    int* top_i;
    float* top_g;
    u16* wt_in;
    u16* wt_br;
    u16* wt_out;
    u16* wt_f13;
    u16* wt_f2;
    u16* wt_glu;
    u16* wt_g;
    float* hctx;
    u16* hn;
    u16* y;
    char* arena;
    u16* wt_m13;
    u16* wt_m2;
    u16* yb;
    u16* xb8;
    u16* wt_gate8;
    u16* wt_in8;
    u16* gch;
};

typedef const __attribute__((address_space(4))) P* PP;
#define PREF asm volatile("" : "+s"(pp)); const __attribute__((address_space(4))) P& p = *pp; extern __shared__ __attribute__((aligned(16))) char smem_raw[]; char* smem = smem_raw + SM_OFF; (void)smem; const int tix = ltid(); (void)tix
__device__ __forceinline__ int ltid() { int t = threadIdx.x; asm volatile("" : "+v"(t)); return t; }
__device__ __forceinline__ int uni(int v) { return __builtin_amdgcn_readfirstlane(v); }
__device__ __forceinline__ float bf2f(u16 b) { return __uint_as_float(((unsigned)b) << 16); }

#define RLXA __ATOMIC_RELAXED, __HIP_MEMORY_SCOPE_AGENT
#ifndef COH
#define COH 0
#endif
#if COH
__device__ __forceinline__ unsigned ldc_u32(const void* q) { return __hip_atomic_load((unsigned*)q, RLXA); }
__device__ __forceinline__ unsigned long long ldc_u64(const void* q) { return __hip_atomic_load((unsigned long long*)q, RLXA); }
__device__ __forceinline__ float ldc_f32(const void* q) { return __uint_as_float(ldc_u32(q)); }
__device__ __forceinline__ u32x2 ldc_8(const void* q) { const unsigned long long v = ldc_u64(q); u32x2 r; r.x = (unsigned)v; r.y = (unsigned)(v >> 32); return r; }
__device__ __forceinline__ u32x4 ldc_16(const void* q) { const unsigned long long a = ldc_u64(q), b = ldc_u64((const char*)q + 8); u32x4 r; r.x = (unsigned)a; r.y = (unsigned)(a >> 32); r.z = (unsigned)b; r.w = (unsigned)(b >> 32); return r; }
__device__ __forceinline__ f32x4 ldc_f4(const void* q) { const u32x4 v = ldc_16(q); return (f32x4){__uint_as_float(v.x), __uint_as_float(v.y), __uint_as_float(v.z), __uint_as_float(v.w)}; }
__device__ __forceinline__ void stc_u32(void* q, unsigned v) { __hip_atomic_store((unsigned*)q, v, RLXA); }
__device__ __forceinline__ void stc_f32(void* q, float v) { __hip_atomic_store((unsigned*)q, __float_as_uint(v), RLXA); }
__device__ __forceinline__ void stc_8(void* q, u32x2 v) { __hip_atomic_store((unsigned long long*)q, ((unsigned long long)v.y << 32) | v.x, RLXA); }
__device__ __forceinline__ void stc_16(void* q, u32x4 v) { __hip_atomic_store((unsigned long long*)q, ((unsigned long long)v.y << 32) | v.x, RLXA); __hip_atomic_store((unsigned long long*)q + 1, ((unsigned long long)v.w << 32) | v.z, RLXA); }
__device__ __forceinline__ void stc_u16(void* q, u16 v) { __hip_atomic_store((unsigned short*)q, v, RLXA); }
__device__ __forceinline__ void stc_f4(void* q, f32x4 v) { stc_16(q, (u32x4){__float_as_uint(v[0]), __float_as_uint(v[1]), __float_as_uint(v[2]), __float_as_uint(v[3])}); }
__device__ __forceinline__ float ldc_bf(const u16* q) { const unsigned w = ldc_u32((const void*)((size_t)q & ~(size_t)3)); return ((size_t)q & 2) ? __uint_as_float(w & 0xffff0000u) : __uint_as_float(w << 16); }
#define SC1_AUX 16
#else
__device__ __forceinline__ unsigned ldc_u32(const void* q) { return *(const unsigned*)q; }
__device__ __forceinline__ float ldc_f32(const void* q) { return *(const float*)q; }
__device__ __forceinline__ u32x2 ldc_8(const void* q) { return *(const u32x2*)q; }
__device__ __forceinline__ u32x4 ldc_16(const void* q) { return *(const u32x4*)q; }
__device__ __forceinline__ f32x4 ldc_f4(const void* q) { return *(const f32x4*)q; }
__device__ __forceinline__ void stc_u32(void* q, unsigned v) { *(unsigned*)q = v; }
__device__ __forceinline__ void stc_f32(void* q, float v) { *(float*)q = v; }
__device__ __forceinline__ void stc_8(void* q, u32x2 v) { *(u32x2*)q = v; }
__device__ __forceinline__ void stc_16(void* q, u32x4 v) { *(u32x4*)q = v; }
__device__ __forceinline__ void stc_u16(void* q, u16 v) { *(u16*)q = v; }
__device__ __forceinline__ void stc_f4(void* q, f32x4 v) { *(f32x4*)q = v; }
__device__ __forceinline__ float ldc_bf(const u16* q) { return __uint_as_float(((unsigned)*q) << 16); }
#define SC1_AUX 0
#endif
typedef __bf16 bf16x2_t __attribute__((ext_vector_type(2)));
typedef float f32x2_t __attribute__((ext_vector_type(2)));
__device__ __forceinline__ unsigned pk2(float lo, float hi) { const f32x2_t v = {lo, hi}; return __builtin_bit_cast(unsigned, __builtin_convertvector(v, bf16x2_t)); }
__device__ __forceinline__ u16 f2bf(float f) { return (u16)(pk2(f, 0.f) & 0xffffu); }
__device__ __forceinline__ float fexp(float x) { return __builtin_amdgcn_exp2f(x * 1.4426950408889634f); }
__device__ __forceinline__ float frcp(float x) { return __builtin_amdgcn_rcpf(x); }
__device__ __forceinline__ float sigm(float x) { return frcp(1.f + fexp(-x)); }
__device__ __forceinline__ float ftanh(float x) { return 1.f - 2.f * frcp(1.f + fexp(2.f * x)); }
template <int CTRL> __device__ __forceinline__ float dppf(float v) { return __int_as_float(__builtin_amdgcn_update_dpp(0, __float_as_int(v), CTRL, 0xF, 0xF, true)); }
__device__ __forceinline__ float rowsum16(float v) { v += dppf<0xB1>(v); v += dppf<0x4E>(v); v += dppf<0x141>(v); v += dppf<0x140>(v); return v; }
__device__ __forceinline__ float rdl(float v, int l) { return __int_as_float(__builtin_amdgcn_readlane(__float_as_int(v), l)); }
__device__ __forceinline__ float wsum(float v) { v = rowsum16(v); return (rdl(v, 0) + rdl(v, 16)) + (rdl(v, 32) + rdl(v, 48)); }

__device__ __forceinline__ void unpack8(const u32x4 w, float (&o)[8]) { o[0] = __uint_as_float(w.x << 16); o[1] = __uint_as_float(w.x & 0xffff0000u); o[2] = __uint_as_float(w.y << 16); o[3] = __uint_as_float(w.y & 0xffff0000u);
    o[4] = __uint_as_float(w.z << 16); o[5] = __uint_as_float(w.z & 0xffff0000u); o[6] = __uint_as_float(w.w << 16); o[7] = __uint_as_float(w.w & 0xffff0000u); }
__device__ __forceinline__ u32x4 pack8(const float (&o)[8]) { u32x4 w; w.x = pk2(o[0], o[1]); w.y = pk2(o[2], o[3]); w.z = pk2(o[4], o[5]); w.w = pk2(o[6], o[7]); return w; }
__device__ __forceinline__ unsigned pk4_fp8(float a, float b, float c, float d) {
    a = fminf(fmaxf(a, -448.f), 448.f); b = fminf(fmaxf(b, -448.f), 448.f); c = fminf(fmaxf(c, -448.f), 448.f); d = fminf(fmaxf(d, -448.f), 448.f);
    const unsigned w = __builtin_amdgcn_cvt_pk_fp8_f32(a, b, 0, false); return __builtin_amdgcn_cvt_pk_fp8_f32(c, d, w, true); }
__device__ __forceinline__ u32x2 pk4bf(const f32x4 v) { u32x2 w; w.x = pk2(v[0], v[1]); w.y = pk2(v[2], v[3]); return w; }
__device__ __forceinline__ void ld8bf(const u16* q, f32x4& lo, f32x4& hi) { float t[8]; unpack8(ldc_16(q), t); lo = (f32x4){t[0], t[1], t[2], t[3]}; hi = (f32x4){t[4], t[5], t[6], t[7]}; }
__device__ __forceinline__ float sum8lanes(float v) { v += dppf<0xB1>(v); v += dppf<0x4E>(v); v += dppf<0x141>(v); return v; }
__device__ __forceinline__ int mrow_of(int row) { return row < RC ? 16 : ((row - RC) >> 11); }
#define LDSWAIT() asm volatile("s_waitcnt lgkmcnt(0)" ::: "memory")

#define XB_TMO      128
#define XB_XCNT(j)  (256  + 64 * (j))
#define XB_XSUB(j)  (1280 + 64 * (j))
#define XB_XGEN(j)  (2304 + 64 * (j))
#define XB_TOP      3328
#define XB_TOPGEN   3392
#define XCD_BAR_WORDS 3456
#define XB_SPIN_CAP (1u << 18)
#define LAS __attribute__((address_space(3)))

__device__ __forceinline__ unsigned xb_ld(unsigned* p)              { return __hip_atomic_load(p, __ATOMIC_RELAXED, __HIP_MEMORY_SCOPE_AGENT); }
__device__ __forceinline__ unsigned xb_add(unsigned* p, unsigned v) { return __hip_atomic_fetch_add(p, v, __ATOMIC_RELAXED, __HIP_MEMORY_SCOPE_AGENT); }
__device__ __forceinline__ unsigned xb_xcc_id() { return (unsigned)__builtin_amdgcn_s_getreg((3 << 11) | 20) & 0xFu; }
#define XB_SPIN(cond, bar) do { unsigned _sp = 0; while (cond) { __builtin_amdgcn_s_sleep(1); \
    if ((++_sp & 255u) == 0u) { if (xb_ld(&(bar)[XB_TMO])) break; if (_sp > XB_SPIN_CAP) { atomicAdd(&(bar)[XB_TMO], 1u); break; } } } } while (0)

struct XcdBarrier {
    unsigned* bar; unsigned x;
    volatile LAS unsigned* st;
};

__device__ __forceinline__ XcdBarrier xcd_barrier_post(unsigned* bar, volatile LAS unsigned* st) {
    XcdBarrier b; b.bar = bar; b.x = xb_xcc_id(); b.st = st;
    if (threadIdx.x == 0) (void)xb_add(&bar[XB_XCNT(b.x)], 1u);
    return b;
}
__device__ __forceinline__ void xcd_barrier_complete(unsigned* bar, unsigned x, unsigned& nloc, unsigned& nx) {
    const unsigned G = gridDim.x * gridDim.y * gridDim.z;
    unsigned sum, cnt, mine, sp = 0u;
    for (;;) {
        sum = 0u; cnt = 0u; mine = 0u;
#pragma unroll
        for (unsigned j = 0; j < 16; ++j) { const unsigned c = xb_ld(&bar[XB_XCNT(j)]); sum += c; cnt += (c > 0u) ? 1u : 0u; mine = (j == x) ? c : mine; }
        if (sum == G) break;
        __builtin_amdgcn_s_sleep(1);
        if ((++sp & 255u) == 0u) { if (xb_ld(&bar[XB_TMO])) break; if (sp > XB_SPIN_CAP) { atomicAdd(&bar[XB_TMO], 1u); break; } }
    }
    nloc = mine > 0u ? mine : 1u; nx = cnt > 0u ? cnt : 1u;
}

__device__ __forceinline__ void xcd_barrier(const XcdBarrier& b) {
    asm volatile("s_waitcnt vmcnt(0)" ::: "memory");
    __syncthreads();
    if (threadIdx.x == 0) {
        unsigned* bar = b.bar; unsigned bx = b.x; asm volatile("" : "+s"(bar), "+s"(bx));
        __builtin_amdgcn_s_waitcnt(0);
        unsigned nloc = b.st[0], nx = b.st[1];
        if (nloc == 0u) { xcd_barrier_complete(bar, bx, nloc, nx); b.st[0] = nloc; b.st[1] = nx; }
        const unsigned old = xb_add(&bar[XB_XSUB(bx)], 1u);
        const unsigned gen = old / nloc;
        if (old + 1u == (gen + 1u) * nloc) {
            __builtin_amdgcn_fence(__ATOMIC_RELEASE, "agent");
            asm volatile("s_waitcnt vmcnt(0)" ::: "memory");
            const unsigned og = xb_add(&bar[XB_TOP], 1u);
            const unsigned tg = og / nx;
            if (og + 1u == (tg + 1u) * nx) xb_add(&bar[XB_TOPGEN], 1u);
            else XB_SPIN(xb_ld(&bar[XB_TOPGEN]) == tg, bar);
            __builtin_amdgcn_fence(__ATOMIC_ACQUIRE, "agent");
            xb_add(&bar[XB_XGEN(bx)], 1u);
            asm volatile("s_waitcnt vmcnt(0)" ::: "memory");
        } else {
            XB_SPIN(xb_ld(&bar[XB_XGEN(bx)]) == gen, bar);
            __builtin_amdgcn_fence(__ATOMIC_ACQUIRE, "agent");
            asm volatile("s_waitcnt vmcnt(0)" ::: "memory");
        }
    }
    __syncthreads();
}

__device__ __forceinline__ void do_transpose(const float* src, int K, int N, long ldsrc, u16* dst, int G, int GS, int off, char* smem, int f8 = 0) {
    const int tix = ltid();
    float (*t)[65] = (float (*)[65])smem;
    const int tk = K / 64, tn = (N + 63) / 64;
    const int sn = tix >> 3, sk = (tix & 7) * 8;
    for (int u = blockIdx.x; u < tk * tn; u += gridDim.x) {
        const int k0 = (u % tk) * 64, n0 = (u / tk) * 64;
        __syncthreads();
#pragma unroll
        for (int q2 = 0; q2 < 2; ++q2) { const int q = tix + q2 * NT, i = q >> 4, c4 = (q & 15) * 4, n = n0 + c4;
            f32x4 v = (f32x4){0.f, 0.f, 0.f, 0.f};
            if (n < N) v = *(const f32x4*)(src + (long)(k0 + i) * ldsrc + n);
            t[i][c4] = v[0]; t[i][c4 + 1] = v[1]; t[i][c4 + 2] = v[2]; t[i][c4 + 3] = v[3]; }
        __syncthreads();
        { const int n = n0 + sn;
          if (n < N) { float o[8];
#pragma unroll
              for (int e = 0; e < 8; ++e) o[e] = t[sk + e][sn];
              const long dr = (long)(n / G) * GS + (n % G) + off;
              if (f8) { u32x2 w8; w8.x = pk4_fp8(o[0] * 32.f, o[1] * 32.f, o[2] * 32.f, o[3] * 32.f); w8.y = pk4_fp8(o[4] * 32.f, o[5] * 32.f, o[6] * 32.f, o[7] * 32.f); *(u32x2*)((char*)dst + dr * K + k0 + sk) = w8; }
              else *(u32x4*)(dst + dr * K + k0 + sk) = pack8(o); } }
    }
}

__device__ __forceinline__ void ph_mod(PP pp) {
    PREF;
    float* s = (float*)smem; float* red = s + 17 * 1024;
    const int G = (int)gridDim.x, bsh = (int)((blockIdx.x + 64u) % gridDim.x);
    if (bsh >= 192) return;
    for (int i = tix; i < 17 * 1024; i += NT) { const int r = i >> 10, k = i & 1023; const float v = r < 16 ? p.in[I_c][r * 1024 + k] : p.in[I_c_ctx][k]; s[i] = v / (1.f + expf(-v)); }
    __syncthreads();
    const int j = tix & 63, kq = tix >> 6;
    for (int u = bsh; u < 192; u += G) {
        const int l = u / 96, jc = (u % 96) * 64;
        float acc[17];
#pragma unroll
        for (int r = 0; r < 17; ++r) acc[r] = 0.f;
        const float* w = p.in[I_ada_w] + ((size_t)l * 1024 + kq * 128) * 6144 + jc + j;
#pragma unroll 8
        for (int k = 0; k < 128; ++k) { const float wv = w[(size_t)k * 6144];
#pragma unroll
            for (int r = 0; r < 17; ++r) acc[r] += s[r * 1024 + kq * 128 + k] * wv; }
        __syncthreads();
#pragma unroll
        for (int r = 0; r < 17; ++r) red[(kq * 17 + r) * 64 + j] = acc[r];
        __syncthreads();
        for (int o = tix; o < 17 * 64; o += NT) { const int r = o >> 6, jj = o & 63; float a = p.in[I_ada_b][l * 6144 + jc + jj];
#pragma unroll
            for (int q = 0; q < 8; ++q) a += red[(q * 17 + r) * 64 + jj];
            p.mod[(size_t)(l * 17 + r) * 6144 + jc + jj] = a; }
    }
}

__device__ __forceinline__ void ph_filt(PP pp) {
    PREF;
    float* z = (float*)smem; float* h1 = z + 65 * 36; float* h2 = h1 + 65 * 64; u16* tile = (u16*)(h2 + 65 * 64);
    const int tid = tix, wid = tid >> 6, lane = tid & 63;
    const int G = (int)gridDim.x;
    for (int u = (int)((blockIdx.x + 128u) % gridDim.x); u < 288; u += G) {
        const int l = u / 144, r = (u % 144) >> 2, cq = u & 3;
        const int L = r < 4 ? 256 : 2048, k = r < 4 ? r : r - 4;
        __syncthreads();
        for (int idx = tid; idx < 65 * 17; idx += NT) { const int pj = idx / 17, i = idx - pj * 17; const int pos = 64 * k + pj;
            if (i == 16) z[pj * 36] = (float)pos / (float)(L - 1);
            else { const float fr = 1e-4f + (float)i * ((15.f - 1e-4f) / 15.f); const float ang = (6.283185307179586f / (float)L) * (float)pos * fr; z[pj * 36 + 1 + i] = cosf(ang); z[pj * 36 + 17 + i] = -sinf(ang); } }
        __syncthreads();
        for (int idx = tid; idx < 65 * 64; idx += NT) { const int pj = idx >> 6, uu = idx & 63; float a = p.in[I_hy_f_b1][l * 64 + uu];
            for (int i = 0; i < 33; ++i) a += z[pj * 36 + i] * p.in[I_hy_f_w1][(l * 33 + i) * 64 + uu];
            h1[idx] = sinf(a); }
        __syncthreads();
        for (int idx = tid; idx < 65 * 64; idx += NT) { const int pj = idx >> 6, uu = idx & 63; float a = p.in[I_hy_f_b2][l * 64 + uu];
            for (int i = 0; i < 64; ++i) a += h1[pj * 64 + i] * p.in[I_hy_f_w2][(l * 64 + i) * 64 + uu];
            h2[idx] = sinf(a); }
        __syncthreads();
        {
            const int c = tid & 255, ph = tid >> 8, cg = (c < 128 ? 0 : 512) + cq * 128 + (c & 127);
            float wc[64];
#pragma unroll
            for (int i = 0; i < 64; ++i) wc[i] = p.in[I_hy_f_w3][(l * 64 + i) * 1024 + cg];
            const float b3 = p.in[I_hy_f_b3][l * 1024 + cg];
            const float ra = 3.0701134573f, rb = 15.3505672867f;
            const float rate = ra + (float)(cg & 511) * ((rb - ra) / 511.f);
            const float bias0 = cg < 512 ? p.in[I_hy_bias][l * 512 + cg] : 0.f;
            for (int pj = ph * 33; pj < (ph ? 65 : 33); ++pj) {
                const int pos = 64 * k + pj; const float t = (float)pos / (float)(L - 1);
                float a = b3;
#pragma unroll
                for (int i4 = 0; i4 < 16; ++i4) { const f32x4 hv = *(const f32x4*)(h2 + pj * 64 + i4 * 4); a += hv[0] * wc[i4 * 4] + hv[1] * wc[i4 * 4 + 1] + hv[2] * wc[i4 * 4 + 2] + hv[3] * wc[i4 * 4 + 3]; }
                float val = a * expf(-t * rate);
                if (pos == 0) val += bias0;
                if (pos >= L) val = 0.f;
                tile[c * 66 + pj] = f2bf(val);
            }
        }
        __syncthreads();
        u16* rv = L == 2048 ? p.rvl + (size_t)l * 512 * 4096 : p.rvc + (size_t)l * 512 * 512;
        for (int cl = wid; cl < 128; cl += 8) {
            u16* row = rv + (size_t)(cq * 128 + cl) * (2 * L);
            row[L - 64 * k - 64 + lane] = tile[cl * 66 + 64 - lane];
            row[L + 64 * k + lane] = (k == 0 && lane == 0) ? tile[cl * 66] : tile[(128 + cl) * 66 + lane];
        }
    }
}

#define HN8(p) ((char*)(p).arena + (size_t)MT * 4096 * 2)
__device__ __forceinline__ void ph_norm(PP pp, int l, int which, int r0, int r1, int first, int router, int f8) {
    PREF; l = uni(l); which = uni(which); r0 = uni(r0); r1 = uni(r1); first = uni(first); router = uni(router); f8 = uni(f8);
    const int wid = tix >> 6, lane = tix & 63;
    const float* g = p.in[which ? I_norm_ffn_g : I_norm_mix_g] + l * 1024;
    const int shoff = which ? 3072 : 0, scoff = which ? 4096 : 1024;
    LAS int* lc = (LAS int*)smem;
    float* rwT = (float*)smem + 64;
    if (router) { __syncthreads(); if (tix < 8) lc[tix] = 0;
        for (int i = tix; i < 8192; i += NT) rwT[(i & 7) * 1024 + (i >> 3)] = p.in[I_moe_router_w][i];
        __syncthreads(); }
    for (int row = r0 + blockIdx.x * 8 + wid; row < r1; row += gridDim.x * 8) {
        const float* src = row < RC ? ((first ? p.in[I_ctx] : p.hctx) + (size_t)row * 1024) : ((first ? p.in[I_x] : p.out) + (size_t)(row - RC) * 1024);
        const float* md = p.mod + (size_t)(l * 17 + mrow_of(row)) * 6144;
        f32x4 v[4]; float ss = 0.f;
#pragma unroll
        for (int i = 0; i < 4; ++i) { v[i] = ldc_f4(src + i * 256 + lane * 4); ss += v[i][0] * v[i][0] + v[i][1] * v[i][1] + v[i][2] * v[i][2] + v[i][3] * v[i][3]; }
        ss = wsum(ss);
        const float rs = rsqrtf(ss * (1.f / 1024.f) + 1e-6f);
        float lg[8];
#pragma unroll
        for (int e = 0; e < 8; ++e) lg[e] = 0.f;
        f32x4 gg4[4], sc4[4], sh4[4];
#pragma unroll
        for (int i = 0; i < 4; ++i) { const int k = i * 256 + lane * 4; gg4[i] = *(const f32x4*)(g + k); sc4[i] = *(const f32x4*)(md + scoff + k); sh4[i] = *(const f32x4*)(md + shoff + k); }
#pragma unroll
        for (int i = 0; i < 4; ++i) {
            const int k = i * 256 + lane * 4;
            const f32x4 gg = gg4[i], sc = sc4[i], sh = sh4[i];
            f32x4 o;
#pragma unroll
            for (int j = 0; j < 4; ++j) o[j] = v[i][j] * rs * gg[j] * (1.f + sc[j]) + sh[j];
            if (f8) stc_u32((char*)p.hn + (size_t)row * 1024 + k, pk4_fp8(o[0], o[1], o[2], o[3]));
            else { u32x2 w; w.x = pk2(o[0], o[1]); w.y = pk2(o[2], o[3]); stc_8(p.hn + (size_t)row * 1024 + k, w);
                   if (!which) stc_u32(HN8(p) + (size_t)row * 1024 + k, pk4_fp8(o[0], o[1], o[2], o[3])); }
            if (router) {
#pragma unroll
                for (int e = 0; e < 8; ++e) { const f32x4 wv = *(const f32x4*)(rwT + e * 1024 + k); lg[e] += (o[0] * wv[0] + o[1] * wv[1]) + (o[2] * wv[2] + o[3] * wv[3]); }
            }
        }
        if (router) {
#pragma unroll
            for (int e = 0; e < 8; ++e) lg[e] = wsum(lg[e]) + p.in[I_moe_router_b][e];
            if (lane == 0) {
                int i0 = 0; float v0 = lg[0];
#pragma unroll
                for (int e = 1; e < 8; ++e) if (lg[e] > v0) { v0 = lg[e]; i0 = e; }
                int i1 = -1; float v1 = -3.4e38f;
#pragma unroll
                for (int e = 0; e < 8; ++e) if (e != i0 && lg[e] > v1) { v1 = lg[e]; i1 = e; }
                const float e1 = expf(v1 - v0), g0 = 1.f / (1.f + e1), g1 = e1 / (1.f + e1);
                const int tok = row - RC;
                stc_u32(p.top_i + tok * 2, (unsigned)i0); stc_u32(p.top_i + tok * 2 + 1, (unsigned)i1); stc_f32(p.top_g + tok * 2, g0); stc_f32(p.top_g + tok * 2 + 1, g1);
                const int k0 = __hip_atomic_fetch_add(lc + i0, 1, __ATOMIC_RELAXED, __HIP_MEMORY_SCOPE_WORKGROUP), k1 = __hip_atomic_fetch_add(lc + i1, 1, __ATOMIC_RELAXED, __HIP_MEMORY_SCOPE_WORKGROUP);
                stc_u32(p.row_tok + tok * 2, (unsigned)k0); stc_u32(p.row_tok + tok * 2 + 1, (unsigned)k1);
            }
        }
    }
    if (router) { __syncthreads(); if (tix < 8) stc_u32(p.moe_i + 1024 + blockIdx.x * 8 + tix, (unsigned)lc[tix]); }
}

typedef f32x4 Acc[2][2][4][2];
__device__ __forceinline__ int perm32(int rho) { const int n = rho >> 4, i = rho & 15; return 8 * (i >> 2) + 4 * n + (i & 3); }

template <class Pr>
__device__ __forceinline__ void gemm_v1(const Pr& pr, char* smem) {
    const int tid = ltid(), wid = tid >> 6, lane = tid & 63, wr = wid >> 2, wc = wid & 3, fr = lane & 15, fq = lane >> 4;
    u16* sA = (u16*)smem; u16* sB = sA + 256 * 40;
    const int nu = pr.num_units();
    const int kp = (tid & 3) * 8;
    for (int u = blockIdx.x; u < nu; u += gridDim.x) {
        int pm, pn; if (!pr.unit(u, pm, pn)) continue;
        const u16* arow[2]; const u16* brow[2];
#pragma unroll
        for (int i = 0; i < 2; ++i) { const int row = (tid + i * 512) >> 2; arow[i] = pr.a_row(pm, row); brow[i] = pr.b_row(pm, pn, (row & ~31) + perm32(row & 31)); }
        Acc acc;
#pragma unroll
        for (int a = 0; a < 2; ++a)
#pragma unroll
            for (int b = 0; b < 2; ++b)
#pragma unroll
                for (int m = 0; m < 4; ++m)
#pragma unroll
                    for (int n = 0; n < 2; ++n) acc[a][b][m][n] = (f32x4){0.f, 0.f, 0.f, 0.f};
        const int K = pr.K();
        for (int k0 = 0; k0 < K; k0 += 32) {
            u32x4 ra[2], rb[2];
#pragma unroll
            for (int i = 0; i < 2; ++i) { ra[i] = arow[i] ? *(const u32x4*)(arow[i] + k0 + kp) : (u32x4){0u, 0u, 0u, 0u}; rb[i] = *(const u32x4*)(brow[i] + k0 + kp); }
            __syncthreads();
#pragma unroll
            for (int i = 0; i < 2; ++i) { const int row = (tid + i * 512) >> 2; *(u32x4*)(sA + row * 40 + kp) = ra[i]; *(u32x4*)(sB + row * 40 + kp) = rb[i]; }
            __syncthreads();
            bf16x8 af[2][4], bf[2][2];
#pragma unroll
            for (int a = 0; a < 2; ++a)
#pragma unroll
                for (int m = 0; m < 4; ++m) af[a][m] = *(const bf16x8*)(sA + (a * 128 + wr * 64 + m * 16 + fr) * 40 + fq * 8);
#pragma unroll
            for (int b = 0; b < 2; ++b)
#pragma unroll
                for (int n = 0; n < 2; ++n) bf[b][n] = *(const bf16x8*)(sB + (b * 128 + wc * 32 + n * 16 + fr) * 40 + fq * 8);
#pragma unroll
            for (int a = 0; a < 2; ++a)
#pragma unroll
                for (int b = 0; b < 2; ++b)
#pragma unroll
                    for (int m = 0; m < 4; ++m)
#pragma unroll
                        for (int n = 0; n < 2; ++n) acc[a][b][m][n] = __builtin_amdgcn_mfma_f32_16x16x32_bf16(bf[b][n], af[a][m], acc[a][b][m][n], 0, 0, 0);
        }
        pr.epi(acc, pm, pn, wr, wc, fr, fq);
    }
}

struct GPb {
    const u16* A; long lda; const u16* Bt; long ldb; int Kd; int tm0, ntm, ntn;
    __device__ int num_units() const { return ntm * ntn; }
    __device__ bool unit(int u, int& pm, int& pn) const { pm = tm0 + u / ntn; pn = u % ntn; return true; }
    __device__ const u16* a_row(int pm, int r) const { return A + (size_t)(pm * 256 + r) * lda; }
    __device__ const u16* b_row(int pm, int pn, int r) const { return Bt + (size_t)(pn * 256 + r) * ldb; }
    __device__ int K() const { return Kd; }
};
struct PrStore : GPb { u16* O; long ldo; int act; int pad_;
    __device__ void epi(Acc& acc, int pm, int pn, int wr, int wc, int fr, int fq) const {
#pragma unroll
        for (int a = 0; a < 2; ++a)
#pragma unroll
            for (int m = 0; m < 4; ++m) { const size_t row = (size_t)pm * 256 + a * 128 + wr * 64 + m * 16 + fr;
#pragma unroll
                for (int b = 0; b < 2; ++b) { const int col = pn * 256 + b * 128 + wc * 32 + fq * 8; f32x4 v0 = acc[a][b][m][0], v1 = acc[a][b][m][1];
                    if (act == 1) {
#pragma unroll
                        for (int j = 0; j < 4; ++j) { v0[j] = sigm(v0[j]); v1[j] = sigm(v1[j]); } }
                    u32x4 w; w.x = pk2(v0[0], v0[1]); w.y = pk2(v0[2], v0[3]); w.z = pk2(v1[0], v1[1]); w.w = pk2(v1[2], v1[3]);
                    stc_16(O + row * ldo + col, w); } }
    }
};
struct PrBranch : GPb { const u16* g; float* ACC; u16* accb; int mi; float scale;
    __device__ void epi(Acc& acc, int pm, int pn, int wr, int wc, int fr, int fq) const {
#pragma unroll
        for (int a = 0; a < 2; ++a)
#pragma unroll
            for (int m = 0; m < 4; ++m) { const size_t row = (size_t)pm * 256 + a * 128 + wr * 64 + m * 16 + fr;
#pragma unroll
                for (int b = 0; b < 2; ++b) { const int col = pn * 256 + b * 128 + wc * 32 + fq * 8;
                    const u32x4 gw = ldc_16(g + row * 1024 + col);
                    float gv[8]; gv[0] = __uint_as_float(gw.x << 16); gv[1] = __uint_as_float(gw.x & 0xffff0000u); gv[2] = __uint_as_float(gw.y << 16); gv[3] = __uint_as_float(gw.y & 0xffff0000u);
                    gv[4] = __uint_as_float(gw.z << 16); gv[5] = __uint_as_float(gw.z & 0xffff0000u); gv[6] = __uint_as_float(gw.w << 16); gv[7] = __uint_as_float(gw.w & 0xffff0000u);
                    float* ap = ACC + row * 1024 + col;
                    f32x4 o0, o1;
                    if (mi == 0) { o0 = (f32x4){0.f, 0.f, 0.f, 0.f}; o1 = o0; } else { o0 = ldc_f4(ap); o1 = ldc_f4(ap + 4); }
#pragma unroll
                    for (int j = 0; j < 4; ++j) { o0[j] += scale * gv[j] * acc[a][b][m][0][j]; o1[j] += scale * gv[4 + j] * acc[a][b][m][1][j]; }
                    if (mi == 3) { u32x4 w; w.x = pk2(o0[0], o0[1]); w.y = pk2(o0[2], o0[3]); w.z = pk2(o1[0], o1[1]); w.w = pk2(o1[2], o1[3]); stc_16(accb + row * 1024 + col, w); }
                    else { stc_f4(ap, o0); stc_f4(ap + 4, o1); } } }
    }
};
struct PrResid : GPb { const float* oc; const float* ol; float* nc; float* nl; const float* mod; int goff; float scale;
    __device__ void epi(Acc& acc, int pm, int pn, int wr, int wc, int fr, int fq) const {
        const float* gt = mod + (size_t)mrow_of(pm * 256) * 6144 + goff;
#pragma unroll
        for (int a = 0; a < 2; ++a)
#pragma unroll
            for (int m = 0; m < 4; ++m) { const int row = pm * 256 + a * 128 + wr * 64 + m * 16 + fr;
                const float* op = row < RC ? oc + (size_t)row * 1024 : ol + (size_t)(row - RC) * 1024;
                float* np = row < RC ? nc + (size_t)row * 1024 : nl + (size_t)(row - RC) * 1024;
#pragma unroll
                for (int b = 0; b < 2; ++b) { const int col = pn * 256 + b * 128 + wc * 32 + fq * 8;
#pragma unroll
                    for (int n = 0; n < 2; ++n) { const f32x4 o = ldc_f4(op + col + 4 * n), gg = *(const f32x4*)(gt + col + 4 * n); f32x4 r;
#pragma unroll
                        for (int j = 0; j < 4; ++j) r[j] = o[j] + scale * gg[j] * acc[a][b][m][n][j];
                        stc_f4(np + col + 4 * n, r); } } }
    }
};
struct PrSwiglu : GPb { u16* G; long ldg;
    __device__ void epi(Acc& acc, int pm, int pn, int wr, int wc, int fr, int fq) const {
#pragma unroll
        for (int a = 0; a < 2; ++a)
#pragma unroll
            for (int m = 0; m < 4; ++m) { const size_t row = (size_t)pm * 256 + a * 128 + wr * 64 + m * 16 + fr; const int col = pn * 128 + wc * 32 + fq * 8;
                float o[8];
#pragma unroll
                for (int n = 0; n < 2; ++n)
#pragma unroll
                    for (int j = 0; j < 4; ++j) { const float x = acc[a][0][m][n][j]; o[n * 4 + j] = x * sigm(x) * acc[a][1][m][n][j]; }
                stc_16(G + row * ldg + col, pack8(o)); }
    }
};
struct PrGlu : GPb { const u16* ya; const float* gb; u16* O;
    __device__ void epi(Acc& acc, int pm, int pn, int wr, int wc, int fr, int fq) const {
#pragma unroll
        for (int a = 0; a < 2; ++a)
#pragma unroll
            for (int m = 0; m < 4; ++m) { const size_t row = (size_t)pm * 256 + a * 128 + wr * 64 + m * 16 + fr;
#pragma unroll
                for (int b = 0; b < 2; ++b) { const int col = pn * 256 + b * 128 + wc * 32 + fq * 8;
                    const u32x4 yw = ldc_16(ya + row * 512 + col);
                    float yv[8]; yv[0] = __uint_as_float(yw.x << 16); yv[1] = __uint_as_float(yw.x & 0xffff0000u); yv[2] = __uint_as_float(yw.y << 16); yv[3] = __uint_as_float(yw.y & 0xffff0000u);
                    yv[4] = __uint_as_float(yw.z << 16); yv[5] = __uint_as_float(yw.z & 0xffff0000u); yv[6] = __uint_as_float(yw.w << 16); yv[7] = __uint_as_float(yw.w & 0xffff0000u);
                    float o[8];
#pragma unroll
                    for (int n = 0; n < 2; ++n)
#pragma unroll
                        for (int j = 0; j < 4; ++j) o[n * 4 + j] = yv[n * 4 + j] * sigm(acc[a][b][m][n][j] + gb[col + n * 4 + j]);
                    u32x4 w; w.x = pk2(o[0], o[1]); w.y = pk2(o[2], o[3]); w.z = pk2(o[4], o[5]); w.w = pk2(o[6], o[7]);
                    stc_16(O + row * 512 + col, w); } }
    }
};
struct PrMoeUp { const u16* h2; const int* row_tok; const int* mi; const u16* W; u16* G; int t0, nt;
    __device__ int num_units() const { return nt * 28; }
    __device__ bool unit(int u, int& pm, int& pn) const { pm = t0 + u / 28; pn = u % 28; return pm < mi[25]; }
    __device__ const u16* a_row(int pm, int r) const { const int t = row_tok[pm * 256 + r]; return t >= 0 ? h2 + (size_t)(RC + t) * 1024 : (const u16*)0; }
    __device__ const u16* b_row(int pm, int pn, int r) const { return W + ((size_t)mi[32 + pm] * 7168 + pn * 256 + r) * 1024; }
    __device__ int K() const { return 1024; }
    __device__ void epi(Acc& acc, int pm, int pn, int wr, int wc, int fr, int fq) const {
#pragma unroll
        for (int a = 0; a < 2; ++a)
#pragma unroll
            for (int m = 0; m < 4; ++m) { const size_t row = (size_t)(pm - t0) * 256 + a * 128 + wr * 64 + m * 16 + fr; const int col = pn * 128 + wc * 32 + fq * 8;
                float o[8];
#pragma unroll
                for (int n = 0; n < 2; ++n)
#pragma unroll
                    for (int j = 0; j < 4; ++j) { const float x = acc[a][0][m][n][j]; o[n * 4 + j] = x * sigm(x) * acc[a][1][m][n][j]; }
                u32x4 w; w.x = pk2(o[0], o[1]); w.y = pk2(o[2], o[3]); w.z = pk2(o[4], o[5]); w.w = pk2(o[6], o[7]);
                stc_16(G + row * 3584 + col, w); }
    }
};
struct PrMoeDown { const u16* G; const int* mi; const u16* W; u16* yb; int t0, nt;
    __device__ int num_units() const { return nt * 4; }
    __device__ bool unit(int u, int& pm, int& pn) const { pm = t0 + u / 4; pn = u % 4; return pm < mi[25]; }
    __device__ const u16* a_row(int pm, int r) const { return G + (size_t)((pm - t0) * 256 + r) * 3584; }
    __device__ const u16* b_row(int pm, int pn, int r) const { return W + ((size_t)mi[32 + pm] * 1024 + pn * 256 + r) * 3584; }
    __device__ int K() const { return 3584; }
    __device__ void epi(Acc& acc, int pm, int pn, int wr, int wc, int fr, int fq) const {
#pragma unroll
        for (int a = 0; a < 2; ++a)
#pragma unroll
            for (int m = 0; m < 4; ++m) { const size_t row = (size_t)pm * 256 + a * 128 + wr * 64 + m * 16 + fr;
#pragma unroll
                for (int b = 0; b < 2; ++b) { const int col = pn * 256 + b * 128 + wc * 32 + fq * 8; const f32x4 v0 = acc[a][b][m][0], v1 = acc[a][b][m][1];
                    u32x4 w; w.x = pk2(v0[0], v0[1]); w.y = pk2(v0[2], v0[3]); w.z = pk2(v1[0], v1[1]); w.w = pk2(v1[2], v1[3]);
                    stc_16(yb + row * 1024 + col, w); } }
    }
};


#define LAS3 __attribute__((address_space(3)))
#ifndef G8_AUXA
#define G8_AUXA 0
#endif
namespace g8 {
constexpr int BK = 64, HALF = 128, HTB = HALF * BK * 2, STAGE_BYTES = 8 * HTB;
__device__ __forceinline__ int lds_byte(int r, int c) { const int st = (r >> 4) * 2 + (c >> 5), rr = r & 15, cc = c & 31, ob = rr * 64 + cc * 2; return st * 1024 + (ob ^ (((ob >> 9) & 1) << 5)); }
__device__ __forceinline__ void stage_rc(int b, int& R, int& C) { const int st = b / 1024, sb = b % 1024, swz = sb ^ (((sb >> 9) & 1) << 5); R = (st >> 1) * 16 + swz / 64; C = (st & 1) * 32 + (swz % 64) / 2; }
struct U8 { const char* a; const char* b; int kb, kbb; int nt; int pm, pn, kind; };
__device__ __forceinline__ bool order8(int L, int nM, int nN, int& pm, int& pn) {
    const int nwg = nM * nN; if (L >= nwg) return false;
    int wgid = L; { const int q = nwg / 8, r = nwg % 8, xcd = wgid % 8, off = wgid / 8; wgid = (xcd < r ? xcd * (q + 1) : r * (q + 1) + (xcd - r) * q) + off; }
    const int nig = 8 * nN, gid = wgid / nig, fm = gid * 8, gsz = (nM - fm) < 8 ? (nM - fm) : 8;
    pm = fm + ((wgid % nig) % gsz); pn = (wgid % nig) / gsz; return true;
}
template <class Pr>
__device__ __forceinline__ void gemm8(LAS3 unsigned char* lds, const Pr& pr) {
    const int tid = ltid(), wid = __builtin_amdgcn_readfirstlane(tid >> 6), lane = tid & 63, wr = wid >> 2, wc = wid & 3, fr = lane & 15, fq = lane >> 4;
    unsigned RA[2], RB[2], C2[2];
#pragma unroll
    for (int i = 0; i < 2; ++i) { int R, C; stage_rc(tid * 16 + i * 8192, R, C); RA[i] = (unsigned)R; RB[i] = (unsigned)((R & ~31) + perm32(R & 31)); C2[i] = (unsigned)C * 2u; }
    const size_t kstep = (size_t)(BK * 2);
    const unsigned ldsw = (unsigned)wid * 1024u;
    const int aoff = lds_byte(wr * 64 + fr, fq * 8), boff = lds_byte(wc * 32 + fr, fq * 8);
#define G8_SA(b, h) (((b) * 2 + (h)) * HTB)
#define G8_SB(b, h) ((4 + (b) * 2 + (h)) * HTB)
#define G8_STAGE(bufoff, gbase, RR, kb) do { _Pragma("unroll") for (int _i = 0; _i < 2; ++_i) { \
        if ((const void*)RR == (const void*)RA) __builtin_amdgcn_global_load_lds((const unsigned*)((const char*)(gbase) + (RR[_i] * (unsigned)(kb) + C2[_i])), (LAS3 unsigned*)(lds + (bufoff) + ldsw + _i * 8192), 16, 0, G8_AUXA); \
        else __builtin_amdgcn_global_load_lds((const unsigned*)((const char*)(gbase) + (RR[_i] * (unsigned)(kb) + C2[_i])), (LAS3 unsigned*)(lds + (bufoff) + ldsw + _i * 8192), 16, 0, 0); } } while (0)
#define G8_LDA(dst, b, h) do { _Pragma("unroll") for (int m = 0; m < 4; ++m) _Pragma("unroll") for (int k = 0; k < 2; ++k) dst[m][k] = *(const LAS3 bf16x8*)(lds + G8_SA(b, h) + aoff + m * 2048 + k * 1024); } while (0)
#define G8_LDB(dst, b, h) do { _Pragma("unroll") for (int n = 0; n < 2; ++n) _Pragma("unroll") for (int k = 0; k < 2; ++k) dst[n][k] = *(const LAS3 bf16x8*)(lds + G8_SB(b, h) + boff + n * 2048 + k * 1024); } while (0)
#define G8_MMA(ai, bj, At, Bt) do { __builtin_amdgcn_s_setprio(1); _Pragma("unroll") for (int m = 0; m < 4; ++m) _Pragma("unroll") for (int n = 0; n < 2; ++n) _Pragma("unroll") for (int k = 0; k < 2; ++k) \
        acc[ai][bj][m][n] = __builtin_amdgcn_mfma_f32_16x16x32_bf16(Bt[n][k], At[m][k], acc[ai][bj][m][n], 0, 0, 0); __builtin_amdgcn_s_setprio(0); } while (0)
#define G8_WAIT_V(n) asm volatile("s_waitcnt vmcnt(" #n ")" ::: "memory")
#define G8_WAIT_L(n) asm volatile("s_waitcnt lgkmcnt(" #n ")" ::: "memory")
#define G8_BAR __builtin_amdgcn_s_barrier()
#define G8_SCHED __builtin_amdgcn_sched_barrier(0)
    U8 cur, nxt; int ui = 0;
    if (!pr.unit8(0, cur)) return;
    nxt = cur;
    f32x4 acc[2][2][4][2];
#pragma unroll
    for (int a = 0; a < 2; ++a)
#pragma unroll
        for (int b = 0; b < 2; ++b)
#pragma unroll
            for (int m = 0; m < 4; ++m)
#pragma unroll
                for (int n = 0; n < 2; ++n) acc[a][b][m][n] = (f32x4){0.f, 0.f, 0.f, 0.f};
    bf16x8 At[4][2], B0[2][2], B1[2][2];
    const char* cA = cur.a; const char* cB = cur.b; int ckb = cur.kb, ckbb = cur.kbb; size_t chs = (size_t)HALF * ckb, chsb = (size_t)HALF * ckbb;
    G8_STAGE(G8_SB(0, 0), cB, RB, ckbb); G8_STAGE(G8_SB(0, 1), cB + chsb, RB, ckbb); G8_STAGE(G8_SA(0, 0), cA, RA, ckb); G8_STAGE(G8_SA(0, 1), cA + chs, RA, ckb);
    if (wr == 1) G8_BAR;
    G8_WAIT_V(2); G8_BAR;
    G8_STAGE(G8_SB(1, 0), cB + kstep, RB, ckbb); G8_STAGE(G8_SA(1, 0), cA + kstep, RA, ckb); G8_STAGE(G8_SB(1, 1), cB + chsb + kstep, RB, ckbb);
    G8_WAIT_V(6); G8_BAR;
    for (;;) {
        const bool has_next = pr.unit8(ui + 1, nxt);
        const char* nA = has_next ? nxt.a : cA; const char* nB = has_next ? nxt.b : cB; const int nkb = has_next ? nxt.kb : ckb, nkbb = has_next ? nxt.kbb : ckbb;
        const int nt = cur.nt;
        for (int t = 0; t < nt; t += 2) {
            const bool last = (t == nt - 2);
            const char* a1 = cA + (size_t)(t + 1) * kstep;
            const char* a2 = last ? nA : cA + (size_t)(t + 2) * kstep; const char* b2 = last ? nB : cB + (size_t)(t + 2) * kstep;
            const int kb2 = last ? nkb : ckb, kbb2 = last ? nkbb : ckbb; const size_t hs2 = (size_t)HALF * kb2, hsb2 = (size_t)HALF * kbb2;
            const char* a3 = a2 + kstep; const char* b3 = b2 + kstep;
            G8_LDB(B0, 0, 0); G8_LDB(B1, 0, 1); G8_SCHED; G8_LDA(At, 0, 0); G8_STAGE(G8_SA(1, 1), a1 + chs, RA, ckb);
            G8_WAIT_V(8); G8_WAIT_L(0); G8_BAR; G8_MMA(0, 0, At, B0); G8_MMA(0, 1, At, B1); G8_BAR; G8_SCHED;
            G8_LDA(At, 0, 1); G8_STAGE(G8_SB(0, 0), b2, RB, kbb2); G8_STAGE(G8_SB(0, 1), b2 + hsb2, RB, kbb2); G8_STAGE(G8_SA(0, 0), a2, RA, kb2);
            G8_WAIT_V(8); G8_WAIT_L(0); G8_BAR; G8_MMA(1, 0, At, B0); G8_MMA(1, 1, At, B1); G8_BAR; G8_SCHED;
            G8_LDB(B0, 1, 0); G8_LDB(B1, 1, 1); G8_SCHED; G8_LDA(At, 1, 0); G8_STAGE(G8_SA(0, 1), a2 + hs2, RA, kb2);
            G8_WAIT_V(8); G8_WAIT_L(0); G8_BAR; G8_MMA(0, 0, At, B0); G8_MMA(0, 1, At, B1); G8_BAR; G8_SCHED;
            G8_LDA(At, 1, 1); G8_STAGE(G8_SB(1, 0), b3, RB, kbb2); G8_STAGE(G8_SB(1, 1), b3 + hsb2, RB, kbb2); G8_STAGE(G8_SA(1, 0), a3, RA, kb2);
            G8_WAIT_V(8); G8_WAIT_L(0); G8_BAR; G8_MMA(1, 0, At, B0); G8_MMA(1, 1, At, B1); G8_BAR; G8_SCHED;
        }
        if (wr == 0) G8_BAR;
        const bool clr = pr.epi8(acc, cur, wr, wc, fr, fq);
        if (!has_next) break;
        if (clr) {
#pragma unroll
            for (int a = 0; a < 2; ++a)
#pragma unroll
                for (int b = 0; b < 2; ++b)
#pragma unroll
                    for (int m = 0; m < 4; ++m)
#pragma unroll
                        for (int n = 0; n < 2; ++n) acc[a][b][m][n] = (f32x4){0.f, 0.f, 0.f, 0.f};
        }
        cur = nxt; cA = nA; cB = nB; ckb = nkb; ckbb = nkbb; chs = (size_t)HALF * ckb; chsb = (size_t)HALF * ckbb; ++ui;
        if (wr == 1) G8_BAR;
    }
    G8_WAIT_V(0);
    G8_BAR;
#undef G8_SA
#undef G8_SB
#undef G8_STAGE
#undef G8_LDA
#undef G8_LDB
#undef G8_MMA
#undef G8_WAIT_V
#undef G8_WAIT_L
#undef G8_BAR
#undef G8_SCHED
}
typedef int i32x8 __attribute__((ext_vector_type(8)));
typedef short s16x16a __attribute__((ext_vector_type(16), aligned(16)));
template <class Pr>
__device__ __forceinline__ void gemm8f(LAS3 unsigned char* lds, const Pr& pr) {
    const int tid = ltid(), wid = __builtin_amdgcn_readfirstlane(tid >> 6), lane = tid & 63, wr = wid >> 2, wc = wid & 3, fr = lane & 15, fq = lane >> 4;
    unsigned RA[2], RB[2], C2[2];
#pragma unroll
    for (int i = 0; i < 2; ++i) { int R, C; stage_rc(tid * 16 + i * 8192, R, C); RA[i] = (unsigned)R; RB[i] = (unsigned)((R & ~31) + perm32(R & 31)); C2[i] = (unsigned)C * 2u; }
    const size_t kstep = (size_t)(BK * 2);
    const unsigned ldsw = (unsigned)wid * 1024u;
    const int aoff = lds_byte(wr * 64 + fr, fq * 16), boff = lds_byte(wc * 32 + fr, fq * 16);
    const int sca = pr.scale_a(), scb = pr.scale_b();
#define G8_SA(b, h) (((b) * 2 + (h)) * HTB)
#define G8_SB(b, h) ((4 + (b) * 2 + (h)) * HTB)
#define G8_STAGE(bufoff, gbase, RR, kb) do { _Pragma("unroll") for (int _i = 0; _i < 2; ++_i) { \
        if ((const void*)RR == (const void*)RA) __builtin_amdgcn_global_load_lds((const unsigned*)((const char*)(gbase) + (RR[_i] * (unsigned)(kb) + C2[_i])), (LAS3 unsigned*)(lds + (bufoff) + ldsw + _i * 8192), 16, 0, G8_AUXA); \
        else __builtin_amdgcn_global_load_lds((const unsigned*)((const char*)(gbase) + (RR[_i] * (unsigned)(kb) + C2[_i])), (LAS3 unsigned*)(lds + (bufoff) + ldsw + _i * 8192), 16, 0, 0); } } while (0)
#define G8_LDA(dst, b, h) do { _Pragma("unroll") for (int m = 0; m < 4; ++m) { const bf16x8 lo_ = *(const LAS3 bf16x8*)(lds + G8_SA(b, h) + aoff + m * 2048), hi_ = *(const LAS3 bf16x8*)(lds + G8_SA(b, h) + aoff + m * 2048 + 16); dst[m] = __builtin_bit_cast(i32x8, __builtin_shufflevector(lo_, hi_, 0, 1, 2, 3, 4, 5, 6, 7, 8, 9, 10, 11, 12, 13, 14, 15)); } } while (0)
#define G8_LDB(dst, b, h) do { _Pragma("unroll") for (int n = 0; n < 2; ++n) { const bf16x8 lo_ = *(const LAS3 bf16x8*)(lds + G8_SB(b, h) + boff + n * 2048), hi_ = *(const LAS3 bf16x8*)(lds + G8_SB(b, h) + boff + n * 2048 + 16); dst[n] = __builtin_bit_cast(i32x8, __builtin_shufflevector(lo_, hi_, 0, 1, 2, 3, 4, 5, 6, 7, 8, 9, 10, 11, 12, 13, 14, 15)); } } while (0)
#define G8_MMA(ai, bj, At, Bt) do { __builtin_amdgcn_s_setprio(1); asm volatile("s_nop 1"); _Pragma("unroll") for (int m = 0; m < 4; ++m) _Pragma("unroll") for (int n = 0; n < 2; ++n) \
        asm volatile("v_mfma_scale_f32_16x16x128_f8f6f4 %0, %1, %2, %0, %3, %4 op_sel_hi:[0,0,0]" : "+v"(acc[ai][bj][m][n]) : "v"(Bt[n]), "v"(At[m]), "v"(scb), "v"(sca)); __builtin_amdgcn_s_setprio(0); } while (0)
#define G8_WAIT_V(n) asm volatile("s_waitcnt vmcnt(" #n ")" ::: "memory")
#define G8_WAIT_L(n) asm volatile("s_waitcnt lgkmcnt(" #n ")" ::: "memory")
#define G8_BAR __builtin_amdgcn_s_barrier()
#define G8_SCHED __builtin_amdgcn_sched_barrier(0)
    U8 cur, nxt; int ui = 0;
    if (!pr.unit8(0, cur)) return;
    nxt = cur;
    f32x4 acc[2][2][4][2];
#pragma unroll
    for (int a = 0; a < 2; ++a)
#pragma unroll
        for (int b = 0; b < 2; ++b)
#pragma unroll
            for (int m = 0; m < 4; ++m)
#pragma unroll
                for (int n = 0; n < 2; ++n) acc[a][b][m][n] = (f32x4){0.f, 0.f, 0.f, 0.f};
    i32x8 At[4], B0[2], B1[2];
    const char* cA = cur.a; const char* cB = cur.b; int ckb = cur.kb, ckbb = cur.kbb; size_t chs = (size_t)HALF * ckb, chsb = (size_t)HALF * ckbb;
    G8_STAGE(G8_SB(0, 0), cB, RB, ckbb); G8_STAGE(G8_SB(0, 1), cB + chsb, RB, ckbb); G8_STAGE(G8_SA(0, 0), cA, RA, ckb); G8_STAGE(G8_SA(0, 1), cA + chs, RA, ckb);
    if (wr == 1) G8_BAR;
    G8_WAIT_V(2); G8_BAR;
    G8_STAGE(G8_SB(1, 0), cB + kstep, RB, ckbb); G8_STAGE(G8_SA(1, 0), cA + kstep, RA, ckb); G8_STAGE(G8_SB(1, 1), cB + chsb + kstep, RB, ckbb);
    G8_WAIT_V(6); G8_BAR;
    for (;;) {
        const bool has_next = pr.unit8(ui + 1, nxt);
        const char* nA = has_next ? nxt.a : cA; const char* nB = has_next ? nxt.b : cB; const int nkb = has_next ? nxt.kb : ckb, nkbb = has_next ? nxt.kbb : ckbb;
        const int nt = cur.nt;
        for (int t = 0; t < nt; t += 2) {
            const bool last = (t == nt - 2);
            const char* a1 = cA + (size_t)(t + 1) * kstep;
            const char* a2 = last ? nA : cA + (size_t)(t + 2) * kstep; const char* b2 = last ? nB : cB + (size_t)(t + 2) * kstep;
            const int kb2 = last ? nkb : ckb, kbb2 = last ? nkbb : ckbb; const size_t hs2 = (size_t)HALF * kb2, hsb2 = (size_t)HALF * kbb2;
            const char* a3 = a2 + kstep; const char* b3 = b2 + kstep;
            G8_LDB(B0, 0, 0); G8_LDB(B1, 0, 1); G8_SCHED; G8_LDA(At, 0, 0); G8_STAGE(G8_SA(1, 1), a1 + chs, RA, ckb);
            G8_WAIT_V(8); G8_WAIT_L(0); G8_BAR; G8_MMA(0, 0, At, B0); G8_MMA(0, 1, At, B1); G8_BAR; G8_SCHED;
            G8_LDA(At, 0, 1); G8_STAGE(G8_SB(0, 0), b2, RB, kbb2); G8_STAGE(G8_SB(0, 1), b2 + hsb2, RB, kbb2); G8_STAGE(G8_SA(0, 0), a2, RA, kb2);
            G8_WAIT_V(8); G8_WAIT_L(0); G8_BAR; G8_MMA(1, 0, At, B0); G8_MMA(1, 1, At, B1); G8_BAR; G8_SCHED;
            G8_LDB(B0, 1, 0); G8_LDB(B1, 1, 1); G8_SCHED; G8_LDA(At, 1, 0); G8_STAGE(G8_SA(0, 1), a2 + hs2, RA, kb2);
            G8_WAIT_V(8); G8_WAIT_L(0); G8_BAR; G8_MMA(0, 0, At, B0); G8_MMA(0, 1, At, B1); G8_BAR; G8_SCHED;
            G8_LDA(At, 1, 1); G8_STAGE(G8_SB(1, 0), b3, RB, kbb2); G8_STAGE(G8_SB(1, 1), b3 + hsb2, RB, kbb2); G8_STAGE(G8_SA(1, 0), a3, RA, kb2);
            G8_WAIT_V(8); G8_WAIT_L(0); G8_BAR; G8_MMA(1, 0, At, B0); G8_MMA(1, 1, At, B1); G8_BAR; G8_SCHED;
        }
        asm volatile("s_nop 7\n\ts_nop 7\n\ts_nop 7" : "+v"(acc[1][0][0][0]), "+v"(acc[1][0][0][1]), "+v"(acc[1][0][1][0]), "+v"(acc[1][0][1][1]), "+v"(acc[1][0][2][0]), "+v"(acc[1][0][2][1]), "+v"(acc[1][0][3][0]), "+v"(acc[1][0][3][1]), "+v"(acc[1][1][0][0]), "+v"(acc[1][1][0][1]), "+v"(acc[1][1][1][0]), "+v"(acc[1][1][1][1]), "+v"(acc[1][1][2][0]), "+v"(acc[1][1][2][1]), "+v"(acc[1][1][3][0]), "+v"(acc[1][1][3][1]) :: "memory");
        if (wr == 0) G8_BAR;
        const bool clr = pr.epi8(acc, cur, wr, wc, fr, fq);
        if (!has_next) break;
        if (clr) {
#pragma unroll
            for (int a = 0; a < 2; ++a)
#pragma unroll
                for (int b = 0; b < 2; ++b)
#pragma unroll
                    for (int m = 0; m < 4; ++m)
#pragma unroll
                        for (int n = 0; n < 2; ++n) acc[a][b][m][n] = (f32x4){0.f, 0.f, 0.f, 0.f};
        }
        cur = nxt; cA = nA; cB = nB; ckb = nkb; ckbb = nkbb; chs = (size_t)HALF * ckb; chsb = (size_t)HALF * ckbb; ++ui;
        if (wr == 1) G8_BAR;
    }
    G8_WAIT_V(0);
    G8_BAR;
#undef G8_SA
#undef G8_SB
#undef G8_STAGE
#undef G8_LDA
#undef G8_LDB
#undef G8_MMA
#undef G8_WAIT_V
#undef G8_WAIT_L
#undef G8_BAR
#undef G8_SCHED
}
}

template <class Base> struct Dense8 : Base {
    __device__ bool unit8(int i, g8::U8& u) const { int pm, pn; if (!g8::order8(i * (int)gridDim.x + (int)blockIdx.x, this->ntm, this->ntn, pm, pn)) return false; pm += this->tm0;
        u.pm = pm; u.pn = pn; u.kind = 0; u.kb = (int)this->lda * 2; u.kbb = (int)this->ldb * 2; u.nt = this->Kd / 64; u.a = (const char*)(this->A + (size_t)pm * 256 * this->lda); u.b = (const char*)(this->Bt + (size_t)pn * 256 * this->ldb); return true; }
    __device__ bool epi8(Acc& acc, const g8::U8& u, int wr, int wc, int fr, int fq) const { this->epi(acc, u.pm, u.pn, wr, wc, fr, fq); return true; }
};
template <class Base> struct Dense8F : Base {
    int sa_, sb_;
    __device__ int scale_a() const { return sa_; }
    __device__ int scale_b() const { return sb_; }
    __device__ bool unit8(int i, g8::U8& u) const { int pm, pn; if (!g8::order8(i * (int)gridDim.x + (int)blockIdx.x, this->ntm, this->ntn, pm, pn)) return false; pm += this->tm0;
        u.pm = pm; u.pn = pn; u.kind = 0; u.kb = (int)this->lda; u.kbb = (int)this->ldb; u.nt = this->Kd / 128; u.a = (const char*)this->A + (size_t)pm * 256 * this->lda; u.b = (const char*)this->Bt + (size_t)pn * 256 * this->ldb; return true; }
    __device__ bool epi8(Acc& acc, const g8::U8& u, int wr, int wc, int fr, int fq) const { this->epi(acc, u.pm, u.pn, wr, wc, fr, fq); return true; }
};
struct In12 { const u16* A; const u16* Wt; u16* Orw; u16* Os5;
    __device__ bool unit8(int i, g8::U8& u) const { int pm, pn; if (!g8::order8(i * (int)gridDim.x + (int)blockIdx.x, 144, 10, pm, pn)) return false;
        u.pm = pm; u.pn = pn; u.kind = 0; u.kb = 2048; u.kbb = 2048; u.nt = 16; u.a = (const char*)(A + (size_t)pm * 256 * 1024);
        u.b = (const char*)(Wt + (size_t)((pn < 8 ? 1536 + pn * 256 : 3584 + (pn - 8) * 256)) * 1024); return true; }
    __device__ bool epi8(Acc& acc, const g8::U8& u, int wr, int wc, int fr, int fq) const {
        u16* O = u.pn < 8 ? Orw : Os5; const long ldo = u.pn < 8 ? 2048 : 512; const int cb = (u.pn < 8 ? u.pn : u.pn - 8) * 256;
#pragma unroll
        for (int a = 0; a < 2; ++a)
#pragma unroll
            for (int m = 0; m < 4; ++m) { const size_t row = (size_t)u.pm * 256 + a * 128 + wr * 64 + m * 16 + fr;
#pragma unroll
                for (int b = 0; b < 2; ++b) { const int col = cb + b * 128 + wc * 32 + fq * 8; const f32x4 v0 = acc[a][b][m][0], v1 = acc[a][b][m][1];
                    u32x4 w; w.x = pk2(v0[0], v0[1]); w.y = pk2(v0[2], v0[3]); w.z = pk2(v1[0], v1[1]); w.w = pk2(v1[2], v1[3]);
                    stc_16(O + row * ldo + col, w); } }
        return true; }
};
struct MoeUp8 : PrMoeUp { const u16* xb;
    __device__ bool unit8(int i, g8::U8& u) const { int nM = uni((int)ldc_u32(mi + 25)) - t0; nM = nM < 0 ? 0 : (nM > nt ? nt : nM); int pm, pn; if (!g8::order8(i * (int)gridDim.x + (int)blockIdx.x, nM, 28, pm, pn)) return false; pm += t0;
        u.pm = pm; u.pn = pn; u.kind = 0; u.kb = 2048; u.kbb = 2048; u.nt = 16; u.a = (const char*)(xb + (size_t)pm * 256 * 1024); u.b = (const char*)(W + ((size_t)uni((int)ldc_u32(mi + 32 + pm)) * 7168 + pn * 256) * 1024); return true; }
    __device__ bool epi8(Acc& acc, const g8::U8& u, int wr, int wc, int fr, int fq) const { this->epi(acc, u.pm, u.pn, wr, wc, fr, fq); return true; }
};
struct MoeDown8 : PrMoeDown {
    __device__ bool unit8(int i, g8::U8& u) const { int nM = uni((int)ldc_u32(mi + 25)) - t0; nM = nM < 0 ? 0 : (nM > nt ? nt : nM); int pm, pn; if (!g8::order8(i * (int)gridDim.x + (int)blockIdx.x, nM, 4, pm, pn)) return false; pm += t0;
        u.pm = pm; u.pn = pn; u.kind = 0; u.kb = 7168; u.kbb = 7168; u.nt = 56; u.a = (const char*)(G + (size_t)(pm - t0) * 256 * 3584); u.b = (const char*)(W + ((size_t)uni((int)ldc_u32(mi + 32 + pm)) * 1024 + pn * 256) * 3584); return true; }
    __device__ bool epi8(Acc& acc, const g8::U8& u, int wr, int wc, int fr, int fq) const { this->epi(acc, u.pm, u.pn, wr, wc, fr, fq); return true; }
};
struct Branch8 { const u16* y; const u16* wt; const u16* G; u16* acc; int tm0, ntm;
    __device__ bool unit8(int i, g8::U8& u) const { const int ti = i >> 2, m = i & 3; int pm, pn; if (!g8::order8(ti * (int)gridDim.x + (int)blockIdx.x, ntm, 4, pm, pn)) return false; pm += tm0;
        u.pm = pm; u.pn = pn; u.kind = m; u.kb = 1024; u.kbb = 1024; u.nt = 8; u.a = (const char*)(y + ((size_t)m * MT + (size_t)pm * 256) * 512); u.b = (const char*)(wt + ((size_t)m * 1024 + pn * 256) * 512); return true; }
    __device__ bool epi8(Acc& acc_, const g8::U8& u, int wr, int wc, int fr, int fq) const {
        const int m = u.kind;
#pragma unroll
        for (int a = 0; a < 2; ++a)
#pragma unroll
            for (int mm = 0; mm < 4; ++mm) { const size_t row = (size_t)u.pm * 256 + a * 128 + wr * 64 + mm * 16 + fr;
#pragma unroll
                for (int b = 0; b < 2; ++b) { const int col = u.pn * 256 + b * 128 + wc * 32 + fq * 8;
                    float gv[8], o[8]; unpack8(ldc_16(G + row * 4096 + m * 1024 + col), gv);
                    u16* ap = acc + row * 1024 + col;
                    if (m == 0) {
#pragma unroll
                        for (int j = 0; j < 8; ++j) o[j] = 0.f; }
                    else unpack8(*(const u32x4*)ap, o);
#pragma unroll
                    for (int j = 0; j < 4; ++j) { o[j] += gv[j] * acc_[a][b][mm][0][j]; o[4 + j] += gv[4 + j] * acc_[a][b][mm][1][j]; }
                    const u32x4 w = pack8(o);
                    if (m == 3) stc_16(ap, w); else *(u32x4*)ap = w; } }
        return true; }
};
struct MoeUp8F { const char* xb8; const int* mi; const char* W8; char* G8; int t0, nt;
    __device__ int scale_a() const { return 127; }
    __device__ int scale_b() const { return 122; }
    __device__ bool unit8(int i, g8::U8& u) const { int nM = uni((int)ldc_u32(mi + 25)) - t0; nM = nM < 0 ? 0 : (nM > nt ? nt : nM); int pm, pn; if (!g8::order8(i * (int)gridDim.x + (int)blockIdx.x, nM, 28, pm, pn)) return false; pm += t0;
        u.pm = pm; u.pn = pn; u.kind = 0; u.kb = 1024; u.kbb = 1024; u.nt = 8; u.a = xb8 + (size_t)pm * 256 * 1024; u.b = W8 + ((size_t)uni((int)ldc_u32(mi + 32 + pm)) * 7168 + pn * 256) * 1024; return true; }
    __device__ bool epi8(Acc& acc, const g8::U8& u, int wr, int wc, int fr, int fq) const {
#pragma unroll
        for (int a = 0; a < 2; ++a)
#pragma unroll
            for (int m = 0; m < 4; ++m) { const size_t row = (size_t)(u.pm - t0) * 256 + a * 128 + wr * 64 + m * 16 + fr; const int col = u.pn * 128 + wc * 32 + fq * 8;
                float o[8];
#pragma unroll
                for (int n = 0; n < 2; ++n)
#pragma unroll
                    for (int j = 0; j < 4; ++j) { const float x = acc[a][0][m][n][j]; o[n * 4 + j] = 4.f * x * sigm(x) * acc[a][1][m][n][j]; }
                u32x2 w; w.x = pk4_fp8(o[0], o[1], o[2], o[3]); w.y = pk4_fp8(o[4], o[5], o[6], o[7]);
                stc_8(G8 + row * 3584 + col, w); }
        return true; }
};
struct MoeDown8F { const char* G8; const int* mi; const char* W8; u16* yb; int t0, nt;
    __device__ int scale_a() const { return 125; }
    __device__ int scale_b() const { return 122; }
    __device__ bool unit8(int i, g8::U8& u) const { int nM = uni((int)ldc_u32(mi + 25)) - t0; nM = nM < 0 ? 0 : (nM > nt ? nt : nM); int pm, pn; if (!g8::order8(i * (int)gridDim.x + (int)blockIdx.x, nM, 4, pm, pn)) return false; pm += t0;
        u.pm = pm; u.pn = pn; u.kind = 0; u.kb = 3584; u.kbb = 3584; u.nt = 28; u.a = G8 + (size_t)(pm - t0) * 256 * 3584; u.b = W8 + ((size_t)uni((int)ldc_u32(mi + 32 + pm)) * 1024 + pn * 256) * 3584; return true; }
    __device__ bool epi8(Acc& acc, const g8::U8& u, int wr, int wc, int fr, int fq) const {
#pragma unroll
        for (int a = 0; a < 2; ++a)
#pragma unroll
            for (int m = 0; m < 4; ++m) { const size_t row = (size_t)u.pm * 256 + a * 128 + wr * 64 + m * 16 + fr;
#pragma unroll
                for (int b = 0; b < 2; ++b) { const int col = u.pn * 256 + b * 128 + wc * 32 + fq * 8; const f32x4 v0 = acc[a][b][m][0], v1 = acc[a][b][m][1];
                    u32x4 w; w.x = pk2(v0[0], v0[1]); w.y = pk2(v0[2], v0[3]); w.z = pk2(v1[0], v1[1]); w.w = pk2(v1[2], v1[3]);
                    stc_16(yb + row * 1024 + col, w); } }
        return true; }
};
#define GEMM8(pr) g8::gemm8((LAS3 unsigned char*)smem, pr)
#define GEMM8F(pr) g8::gemm8f((LAS3 unsigned char*)smem, pr)

__device__ __forceinline__ void seq_of(int row, int& base, int& t, int& L) {
    if (row < RC) { t = row & 255; L = 256; } else { t = (row - RC) & 2047; L = 2048; }
    base = row - t;
}
__device__ __forceinline__ void mfma_safe(f32x4& acc, const bf16x8 a, const bf16x8 b) {
    acc = __builtin_amdgcn_mfma_f32_16x16x32_bf16(a, b, acc, 0, 0, 0);
    asm volatile("" :: "v"(acc), "v"(a), "v"(b));
}
__device__ __forceinline__ void mfma_ip(f32x4& acc, const bf16x8 a, const bf16x8 b) { asm volatile("v_mfma_f32_16x16x32_bf16 %0, %1, %2, %0" : "+v"(acc) : "v"(a), "v"(b)); }
__device__ __forceinline__ void mfma_settle() { asm volatile("s_nop 7\n\ts_nop 7\n\ts_nop 3" ::: "memory"); }
#define HY_UTL(p) ((u16*)((p).arena + (size_t)MT * 1536 * 2))
#define HY_UTC(p) (HY_UTL(p) + (size_t)512 * 16 * 2048)
#define HY_YTL(p) (HY_UTC(p) + (size_t)512 * 16 * 256)
#define HY_YTC(p) (HY_YTL(p) + (size_t)512 * 16 * 2048)
__device__ __forceinline__ void ph_hy_pre(PP pp, int l) {
    PREF; l = uni(l); const u16* ph = (const u16*)p.arena;
    u16* T = (u16*)smem;
    const int w = tix >> 6, lane = tix & 63, tg = lane >> 3, cg = lane & 7, c0 = w * 64 + cg * 8, s0 = tg * 8;
    const float* cw = p.in[I_hy_conv_w] + l * 3 * 1536; const float* cb = p.in[I_hy_conv_b] + l * 1536;
    for (int tt = (l ? 64 : 0) + blockIdx.x; tt < 576; tt += gridDim.x) {
        const int row0 = tt * 64; int b, t0, L; u16* utb;
        if (row0 < RC) { b = row0 >> 8; t0 = row0 & 255; L = 256; utb = HY_UTC(p) + (size_t)b * 256 + t0; }
        else { b = (row0 - RC) >> 11; t0 = (row0 - RC) & 2047; L = 2048; utb = HY_UTL(p) + (size_t)b * 2048 + t0; }
        float uu[8][8];
#pragma unroll
        for (int j = 0; j < 3; ++j) {
            float w0[8], w1[8], w2[8], bb[8];
#pragma unroll
            for (int e4 = 0; e4 < 2; ++e4) { const f32x4 a0 = *(const f32x4*)(cw + j * 512 + c0 + e4 * 4), a1 = *(const f32x4*)(cw + 1536 + j * 512 + c0 + e4 * 4), a2 = *(const f32x4*)(cw + 3072 + j * 512 + c0 + e4 * 4), a3 = *(const f32x4*)(cb + j * 512 + c0 + e4 * 4);
#pragma unroll
                for (int e = 0; e < 4; ++e) { w0[e4 * 4 + e] = a0[e]; w1[e4 * 4 + e] = a1[e]; w2[e4 * 4 + e] = a2[e]; bb[e4 * 4 + e] = a3[e]; } }
            u32x4 raw[10];
#pragma unroll
            for (int r = 0; r < 10; ++r) { const int t = t0 + s0 - 1 + r; raw[r] = (u32x4){0u, 0u, 0u, 0u};
                if (t >= 0 && t < L) raw[r] = ldc_16(ph + (size_t)(row0 + s0 - 1 + r) * 1536 + j * 512 + c0); }
            float xr[10][8];
#pragma unroll
            for (int r = 0; r < 10; ++r) unpack8(raw[r], xr[r]);
#pragma unroll
            for (int i = 0; i < 8; ++i) {
                float r8[8];
#pragma unroll
                for (int e = 0; e < 8; ++e) r8[e] = xr[i][e] * w0[e] + xr[i + 1][e] * w1[e] + xr[i + 2][e] * w2[e] + bb[e];
                if (j == 0) stc_16(p.y + ((size_t)row0 + s0 + i) * 512 + c0, pack8(r8));
                else if (j == 1) {
#pragma unroll
                    for (int e = 0; e < 8; ++e) uu[i][e] = r8[e]; }
                else {
#pragma unroll
                    for (int e = 0; e < 8; ++e) uu[i][e] = r8[e] * uu[i][e]; }
            }
        }
        __syncthreads();
#pragma unroll
        for (int e = 0; e < 8; ++e) { u32x4 wv; wv.x = pk2(uu[0][e], uu[1][e]); wv.y = pk2(uu[2][e], uu[3][e]); wv.z = pk2(uu[4][e], uu[5][e]); wv.w = pk2(uu[6][e], uu[7][e]); *(u32x4*)(T + (c0 + e) * 72 + s0) = wv; }
        __syncthreads();
        { const int c = tix;
#pragma unroll
          for (int k8 = 0; k8 < 8; ++k8) stc_16(utb + (size_t)c * 16 * L + k8 * 8, *(const u32x4*)(T + c * 72 + k8 * 8)); }
    }
}
template <int L>
__device__ __forceinline__ void hy_conv_items(const u16* rvg, const u16* utg, u16* ytg, char* smem, const int tix) {
    constexpr int TPW = L / 128, CPN = 2 * L + 16, OFS = L + 8, RS = L + 8, NKS = L / 32, UNR = TPW / 2;
    u16* cp = (u16*)smem; u16* us = cp + 8 * CPN;
    const int wid = tix >> 6, lane = tix & 63, r = lane & 15, q = lane >> 4;
    const int a = (8 - (r & 7)) & 7;
    const int tb = a * CPN + 8 * q - r - a + OFS;
    const int ubs = r * RS + 8 * q;
    const int t_w = wid * (TPW * 16);
    for (int c = blockIdx.x; c < 512; c += gridDim.x) {
        __syncthreads();
        for (int idx = tix; idx < 8 * CPN; idx += NT) { const int a_ = idx / CPN, xi = idx - a_ * CPN; const int g = xi - OFS + a_ + L; cp[idx] = (g >= 0 && g < 2 * L) ? rvg[(size_t)c * (2 * L) + g] : (u16)0; }
        for (int pc = tix; pc < 16 * (L / 8); pc += NT) { const int b = pc / (L / 8), k8 = pc - b * (L / 8); *(u32x4*)(us + b * RS + k8 * 8) = ldc_16(utg + ((size_t)c * 16 + b) * L + k8 * 8); }
        __syncthreads();
        f32x4 acc[TPW]; bf16x8 W[TPW];
#pragma unroll
        for (int i = 0; i < TPW; ++i) { acc[i] = (f32x4){0.f, 0.f, 0.f, 0.f}; W[i] = *(const bf16x8*)(cp + tb - (t_w + 16 * i)); }
        for (int ks0 = 0; ks0 < NKS; ks0 += UNR) {
#pragma unroll
            for (int u = 0; u < UNR; ++u) {
                const int ks = ks0 + u;
                const bf16x8 U = *(const bf16x8*)(us + ubs + 32 * ks);
#pragma unroll
                for (int i = TPW - 2; i < TPW; ++i) mfma_safe(acc[i], W[(i - 2 * u + 2 * TPW) % TPW], U);
#pragma unroll
                for (int i = 0; i < 2; ++i) W[(i - 2 * (u + 1) + 2 * TPW) % TPW] = *(const bf16x8*)(cp + tb + 32 * (ks + 1) - (t_w + 16 * i));
#pragma unroll
                for (int i = 0; i < TPW - 2; ++i) mfma_safe(acc[i], W[(i - 2 * u + 2 * TPW) % TPW], U);
            }
        }
#pragma unroll
        for (int i = 0; i < TPW; ++i) { u32x2 w; w.x = pk2(acc[i][0], acc[i][1]); w.y = pk2(acc[i][2], acc[i][3]); stc_8(ytg + ((size_t)c * 16 + r) * L + t_w + 16 * i + 4 * q, w); }
    }
}
__device__ __forceinline__ void ph_hy_conv(PP pp, int l) {
    PREF; l = uni(l);
    hy_conv_items<2048>(p.rvl + (size_t)l * 512 * 4096, HY_UTL(p), HY_YTL(p), smem, tix);
    if (l == 0) hy_conv_items<256>(p.rvc + (size_t)l * 512 * 512, HY_UTC(p), HY_YTC(p), smem, tix);
}
__device__ __forceinline__ void ph_hy_post(PP pp, int l, int shadow) {
    PREF; l = uni(l); (void)shadow;
    u16* T = (u16*)smem;
    const int w = tix >> 6, lane = tix & 63, tg = lane >> 3, cg = lane & 7, c0 = w * 64 + cg * 8, s0 = tg * 8;
    for (int tt = (l ? 64 : 0) + blockIdx.x; tt < 576; tt += gridDim.x) {
        const int row0 = tt * 64; const u16* yt;
        if (row0 < RC) yt = HY_YTC(p) + ((size_t)tix * 16 + (row0 >> 8)) * 256 + (row0 & 255);
        else yt = HY_YTL(p) + ((size_t)tix * 16 + ((row0 - RC) >> 11)) * 2048 + ((row0 - RC) & 2047);
        u32x4 v[8], xr[8];
#pragma unroll
        for (int k = 0; k < 8; ++k) v[k] = ldc_16(yt + 8 * k);
#pragma unroll
        for (int i = 0; i < 8; ++i) xr[i] = ldc_16(p.y + ((size_t)row0 + s0 + i) * 512 + c0);
        __syncthreads();
#pragma unroll
        for (int k = 0; k < 8; ++k) *(u32x4*)(T + tix * 72 + 8 * k) = v[k];
        __syncthreads();
#pragma unroll
        for (int i = 0; i < 8; ++i) { float x0[8], o[8]; unpack8(xr[i], x0);
#pragma unroll
            for (int e = 0; e < 8; ++e) o[e] = x0[e] * bf2f(T[(c0 + e) * 72 + s0 + i]);
            stc_16(p.y + ((size_t)row0 + s0 + i) * 512 + c0, pack8(o)); }
    }
}

__device__ __forceinline__ void ph_rw_scan(PP pp, int l) {
    PREF; l = uni(l); const u16* pr = (const u16*)p.arena; u16* ob = (u16*)(p.arena + (size_t)MT * 2048 * 2); float* bon = (float*)(p.arena + (size_t)MT * 2048 * 2 + (size_t)2 * MT * 512 * 2);
    const int tid = tix, wid = tid >> 6, lane = tid & 63;
    u16* WUt = (u16*)smem;
    u16* AUt = WUt + 64 * 72;
    u16* RAW = AUt + 64 * 72;
    u16* TWb = RAW + 34 * 320;
    u16* ADb = TWb + 32 * 72;
    float* Ks = (float*)(ADb + 32 * 72);
    float* KKv = Ks + 2048; float* Rv = KKv + 2048; float* Vv = Rv + 2048; float* Wv = Vv + 2048; float* Bv = Wv + 2048; float* KDv = Bv + 2048;
    float* bonp = KDv + 2048;
    float* Oc = bonp + 128;
    u16* KT = RAW; u16* BT = KT + 32 * 72; u16* KD = BT + 32 * 72; u16* RT = KD + 32 * 72; u16* AB = RT + 32 * 72; u16* CC = AB + 2 * 16 * 40; u16* Tm = CC + 2 * 16 * 40;
    float* Amat = (float*)(Tm + 2 * 16 * 40);
    float* CUMS = Ks;
    u16* MtT = (u16*)KKv;
    u16* BKt = (u16*)(Oc + 2048);
    u16* UVt = BKt + 2 * 64 * 40;
    u16* Sb = UVt + 2 * 64 * 40;
    float* MUs = (float*)(Sb + 64 * 72);
    float* KKs = MUs + 640;
    float* PC = KKs + 64;
    const int pt = tid >> 4, pc4 = (tid & 15) * 4;
    const int r4 = lane >> 4, kq = lane & 15, v0 = wid * 8 + r4 * 2;
    const int tt = wid >> 2, ct = wid & 3, ech = ct * 16 + (lane & 15), eq = lane >> 4;
    for (int sid = blockIdx.x; sid < 256; sid += gridDim.x) {
        const int b = sid >> 4, h = (sid >> 1) & 7, d = sid & 1;
        __syncthreads();
        for (int i = tid; i < 4096; i += NT) { const int m = i >> 6, ch = i & 63;
            WUt[ch * 72 + m] = f2bf(p.in[I_rw_w_up][((size_t)(l * 2 + d) * 64 + m) * 512 + h * 64 + ch]);
            AUt[ch * 72 + m] = f2bf(p.in[I_rw_a_up][((size_t)(l * 2 + d) * 64 + m) * 512 + h * 64 + ch]); }
        const int cbase[5] = {h * 64, 512 + h * 64, 1024 + h * 64, 1536 + d * 64, 1664 + d * 64};
        for (int i = tid; i < 704; i += NT) { const int ch = i & 63, j = (i >> 6) % 5, wh = i / 320;
            MUs[i] = i < 640 ? p.in[I_rw_mu][(size_t)(l * 2 + wh) * 1920 + cbase[j] + ch] : p.in[I_rw_k_k][l * 512 + h * 64 + ch]; }
        const float e_w0 = p.in[I_rw_w0][(l * 2 + d) * 512 + h * 64 + ech], e_a0 = p.in[I_rw_a0][(l * 2 + d) * 512 + h * 64 + ech], e_ka = p.in[I_rw_k_a][l * 512 + h * 64 + ech], e_rk = p.in[I_rw_r_k][l * 512 + h * 64 + ech];
        f32x4 SS[4];
#pragma unroll
        for (int i = 0; i < 4; ++i) SS[i] = (f32x4){0.f, 0.f, 0.f, 0.f};
        for (int i = tid; i < 2 * 64 * 40 + 64 * 72; i += NT) UVt[i] = (u16)0;
        int prev_row0 = -1;
#define RW_GEOM(fc, L_, base_, tlo_) const int L_ = (fc) < 8 ? 256 : 2048, base_ = (fc) < 8 ? b * 256 : RC + b * 2048, tlo_ = d ? L_ - 32 * (((fc) < 8 ? (fc) : (fc) - 8) + 1) : 32 * ((fc) < 8 ? (fc) : (fc) - 8)
#define RW_FETCH(fc) do { RW_GEOM(fc, Lf, basef, tlof); _Pragma("unroll") for (int i3 = 0; i3 < 3; ++i3) { const int i = tid + i3 * NT; const int rr = i / 40, c8 = i - rr * 40; const int t = tlof - 1 + rr; const int j = c8 >> 3; \
            u32x4 v = (u32x4){0u, 0u, 0u, 0u}; if (i < 34 * 40 && t >= 0 && t < Lf) v = ldc_16(pr + ((size_t)basef + t) * 2048 + cbase[j] + (c8 & 7) * 8); rawreg[i3] = v; } } while (0)
        u32x4 rawreg[3];
        RW_FETCH(0);
        for (int fc = 0; fc < 72; ++fc) {
            {
                RW_GEOM(fc, L, base, t_lo); (void)L;
                __syncthreads();
                if (prev_row0 >= 0) { const f32x4 o = *(const f32x4*)(Oc + pt * 64 + pc4); stc_8(ob + ((size_t)d * MT + prev_row0 + pt) * 512 + h * 64 + pc4, pk4bf(o)); }
#pragma unroll
                for (int i3 = 0; i3 < 3; ++i3) { const int i = tid + i3 * NT; const int rr = i / 40, c8 = i - rr * 40; if (i < 34 * 40) *(u32x4*)(RAW + rr * 320 + c8 * 8) = rawreg[i3]; }
                __syncthreads();
                for (int rwr_ = 0; rwr_ < 1 + ((RWREP >> 0) & 1); ++rwr_) { if (rwr_) __syncthreads();
                {
                    float x[5][4];
#pragma unroll
                    for (int j = 0; j < 5; ++j) { const u32x2 a = *(const u32x2*)(RAW + pt * 320 + j * 64 + pc4), c = *(const u32x2*)(RAW + (pt + 1) * 320 + j * 64 + pc4), n = *(const u32x2*)(RAW + (pt + 2) * 320 + j * 64 + pc4);
                        const float pm[4] = {__uint_as_float(a.x << 16), __uint_as_float(a.x & 0xffff0000u), __uint_as_float(a.y << 16), __uint_as_float(a.y & 0xffff0000u)};
                        const float pc[4] = {__uint_as_float(c.x << 16), __uint_as_float(c.x & 0xffff0000u), __uint_as_float(c.y << 16), __uint_as_float(c.y & 0xffff0000u)};
                        const float pn[4] = {__uint_as_float(n.x << 16), __uint_as_float(n.x & 0xffff0000u), __uint_as_float(n.y << 16), __uint_as_float(n.y & 0xffff0000u)};
                        const f32x4 m0 = *(const f32x4*)(MUs + j * 64 + pc4), m1 = *(const f32x4*)(MUs + 320 + j * 64 + pc4);
#pragma unroll
                        for (int e = 0; e < 4; ++e) x[j][e] = pc[e] + m0[e] * (pm[e] - pc[e]) + m1[e] * (pn[e] - pc[e]); }
                    float kr[4], ss = 0.f;
                    const f32x4 kk_k = *(const f32x4*)(KKs + pc4);
#pragma unroll
                    for (int e = 0; e < 4; ++e) { kr[e] = x[1][e] * kk_k[e]; ss += kr[e] * kr[e]; }
                    ss = rowsum16(ss);
                    const float inv = frcp(fmaxf(__builtin_amdgcn_sqrtf(ss), 1e-12f));
                    *(f32x4*)(Rv + pt * 64 + pc4) = (f32x4){x[0][0], x[0][1], x[0][2], x[0][3]};
                    *(f32x4*)(Ks + pt * 64 + pc4) = (f32x4){x[1][0], x[1][1], x[1][2], x[1][3]};
                    *(f32x4*)(Vv + pt * 64 + pc4) = (f32x4){x[2][0], x[2][1], x[2][2], x[2][3]};
                    *(f32x4*)(KKv + pt * 64 + pc4) = (f32x4){kr[0] * inv, kr[1] * inv, kr[2] * inv, kr[3] * inv};
                    u32x2 tw, ad; tw.x = pk2(ftanh(x[3][0]), ftanh(x[3][1])); tw.y = pk2(ftanh(x[3][2]), ftanh(x[3][3])); ad.x = pk2(x[4][0], x[4][1]); ad.y = pk2(x[4][2], x[4][3]);
                    *(u32x2*)(TWb + pt * 72 + pc4) = tw; *(u32x2*)(ADb + pt * 72 + pc4) = ad;
                }
                }
                __syncthreads();
                for (int rwr_ = 0; rwr_ < 1 + ((RWREP >> 1) & 1); ++rwr_) { if (rwr_) __syncthreads();
                {
                    f32x4 dw = (f32x4){0.f, 0.f, 0.f, 0.f}, da = dw;
#pragma unroll
                    for (int ks = 0; ks < 2; ++ks) {
                        const bf16x8 aw = *(const bf16x8*)(TWb + (tt * 16 + (lane & 15)) * 72 + ks * 32 + eq * 8), aa = *(const bf16x8*)(ADb + (tt * 16 + (lane & 15)) * 72 + ks * 32 + eq * 8);
                        const bf16x8 bw = *(const bf16x8*)(WUt + ech * 72 + ks * 32 + eq * 8), ba = *(const bf16x8*)(AUt + ech * 72 + ks * 32 + eq * 8);
                        mfma_safe(dw, aw, bw); mfma_safe(da, aa, ba);
                    }
                    float lw[4], kap[4], bet[4], kdv[4], rr[4], vvv[4];
#pragma unroll
                    for (int j = 0; j < 4; ++j) { const int tok = tt * 16 + eq * 4 + j;
                        const float wv = -0.606531f * sigm(e_w0 + dw[j]), av = sigm(e_a0 + da[j]);
                        const float ks_ = Ks[tok * 64 + ech], kkv = KKv[tok * 64 + ech], rs = Rv[tok * 64 + ech];
                        const float kd = ks_ * (1.f + (av - 1.f) * e_ka);
                        lw[j] = wv; kap[j] = kkv; bet[j] = kkv * av; kdv[j] = kd; rr[j] = rs; vvv[j] = Vv[tok * 64 + ech];
                        const float bs = rowsum16(rs * kd * e_rk);
                        if ((lane & 15) == 0) bonp[ct * 32 + tok] = bs; }
                    {
                        float pf[4];
                        if (!d) { pf[0] = lw[0]; pf[1] = pf[0] + lw[1]; pf[2] = pf[1] + lw[2]; pf[3] = pf[2] + lw[3]; }
                        else { pf[3] = lw[3]; pf[2] = pf[3] + lw[2]; pf[1] = pf[2] + lw[1]; pf[0] = pf[1] + lw[0]; }
                        const float gt = d ? pf[0] : pf[3];
                        float inc = gt;
                        { const float u1 = __int_as_float(__builtin_amdgcn_ds_bpermute((lane - 16) * 4, __float_as_int(inc))); if (eq >= 1) inc += u1; }
                        { const float u2 = __int_as_float(__builtin_amdgcn_ds_bpermute((lane - 32) * 4, __float_as_int(inc))); if (eq >= 2) inc += u2; }
                        const float tile_tot = __int_as_float(__builtin_amdgcn_ds_bpermute((48 + (lane & 15)) * 4, __float_as_int(inc)));
                        const float excl = d ? tile_tot - inc : inc - gt;
                        const int c = d ? 1 - tt : tt;
                        const int i0 = d ? 12 - 4 * eq : 4 * eq;
                        float bt4[4], kd4[4], vv4[4];
#pragma unroll
                        for (int j = 0; j < 4; ++j) { const float cum = pf[j] + excl, P = fexp(cum), Pm1 = fexp(cum - lw[j]), rP = fexp(-cum);
                            const int ii = d ? 3 - j : j, sp = c * 16 + i0 + ii;
                            KT[sp * 72 + ech] = f2bf(kap[j] * Pm1); BT[sp * 72 + ech] = f2bf(bet[j] * rP); KD[sp * 72 + ech] = f2bf(kdv[j] * rP); RT[sp * 72 + ech] = f2bf(rr[j] * P);
                            bt4[ii] = bet[j] * rP; kd4[ii] = kdv[j] * rP; vv4[ii] = vvv[j];
                            if (i0 + ii == 15) PC[c * 64 + ech] = P; }
                        u32x2 w2;
                        w2.x = pk2(bt4[0], bt4[1]); w2.y = pk2(bt4[2], bt4[3]); *(u32x2*)(BKt + (c * 64 + ech) * 40 + i0) = w2;
                        w2.x = pk2(kd4[0], kd4[1]); w2.y = pk2(kd4[2], kd4[3]); *(u32x2*)(BKt + (c * 64 + ech) * 40 + 16 + i0) = w2;
                        w2.x = pk2(vv4[0], vv4[1]); w2.y = pk2(vv4[2], vv4[3]); *(u32x2*)(UVt + (c * 64 + ech) * 40 + 16 + i0) = w2;
                    }
                }
                }
                __syncthreads();
                if (tid < 32) stc_f32(bon + ((size_t)d * MT + base + t_lo + tid) * 8 + h, (bonp[tid] + bonp[32 + tid]) + (bonp[64 + tid] + bonp[96 + tid]));
                if (fc + 1 < 72) RW_FETCH(fc + 1);
                int tid_o = tid; asm volatile("" : "+v"(tid_o));
                const int tid = tid_o, wid = __builtin_amdgcn_readfirstlane(tid_o >> 6), lane = tid_o & 63;
                for (int rwr_ = 0; rwr_ < 1 + ((RWREP >> 3) & 1); ++rwr_) { if (rwr_) __syncthreads();
                {
                    const int c = wid >> 2, which = wid & 3, c16 = lane & 15, q = lane >> 4;
                    const u16* X = (which < 2) ? KT : RT; const u16* Y = (which & 1) ? KD : BT;
                    f32x4 pa = (f32x4){0.f, 0.f, 0.f, 0.f};
#pragma unroll
                    for (int ks = 0; ks < 2; ++ks) { const bf16x8 a = *(const bf16x8*)(X + (c * 16 + c16) * 72 + ks * 32 + q * 8), bb = *(const bf16x8*)(Y + (c * 16 + c16) * 72 + ks * 32 + q * 8); mfma_safe(pa, a, bb); }
#pragma unroll
                    for (int j = 0; j < 4; ++j) { const int t = 4 * q + j, sx = c16; const bool keep = (which < 2) ? (sx < t) : (sx <= t); const float val = keep ? pa[j] : 0.f;
                        if (which == 0) { Amat[c * 256 + sx * 16 + t] = val; AB[(c * 16 + t) * 40 + sx] = (u16)0; }
                        else if (which == 1) AB[(c * 16 + t) * 40 + 16 + sx] = f2bf(val);
                        else if (which == 2) CC[(c * 16 + t) * 40 + sx] = f2bf(val);
                        else CC[(c * 16 + t) * 40 + 16 + sx] = f2bf(val); }
                    if (which == 0) {
                        LDSWAIT(); const int jcol = lane & 15; float part[16], an[16];
#pragma unroll
                        for (int t = 0; t < 16; ++t) part[t] = (t == jcol) ? 1.f : 0.f;
#pragma unroll
                        for (int t4 = 0; t4 < 4; ++t4) { const f32x4 av = *(const f32x4*)(Amat + c * 256 + t4 * 4); an[t4 * 4] = av[0]; an[t4 * 4 + 1] = av[1]; an[t4 * 4 + 2] = av[2]; an[t4 * 4 + 3] = av[3]; }
#pragma unroll
                        for (int sx = 0; sx < 16; ++sx) { const float xs = part[sx];
                            float acol[16];
#pragma unroll
                            for (int t = 0; t < 16; ++t) acol[t] = an[t];
                            if (sx + 1 < 16) {
#pragma unroll
                                for (int t4 = 0; t4 < 4; ++t4) { const f32x4 av = *(const f32x4*)(Amat + c * 256 + (sx + 1) * 16 + t4 * 4); an[t4 * 4] = av[0]; an[t4 * 4 + 1] = av[1]; an[t4 * 4 + 2] = av[2]; an[t4 * 4 + 3] = av[3]; } }
                            if (lane < 32) Tm[(c * 16 + sx) * 40 + lane] = lane < 16 ? f2bf(xs) : (u16)0;
#pragma unroll
                            for (int t = sx + 1; t < 16; ++t) part[t] -= acol[t] * xs; }
                    }
                }
                }
                __syncthreads();
                if (wid < 4) {
                    const int w = wid, c16 = lane & 15, q = lane >> 4;
#pragma unroll
                    for (int c = 0; c < 2; ++c) {
                        *(u32x2*)(MtT + (w * 16 + c16) * 40 + 16 + 4 * q) = (u32x2){0u, 0u};
                        f32x4 m = (f32x4){0.f, 0.f, 0.f, 0.f};
#pragma unroll
                        for (int ks = 0; ks < 2; ++ks) { const bf16x8 a = *(const bf16x8*)(KT + (c * 16 + c16) * 72 + ks * 32 + q * 8), bb = *(const bf16x8*)(Sb + (w * 16 + c16) * 72 + ks * 32 + q * 8); mfma_safe(m, a, bb); }
                        { const bf16x8 a = *(const bf16x8*)(AB + (c * 16 + c16) * 40 + q * 8), bb = *(const bf16x8*)(UVt + (c * 64 + w * 16 + c16) * 40 + q * 8); mfma_safe(m, a, bb); }
                        { u32x2 w2; w2.x = pk2(m[0], m[1]); w2.y = pk2(m[2], m[3]); *(u32x2*)(MtT + (w * 16 + c16) * 40 + 4 * q) = w2; }
                        LDSWAIT();
                        f32x4 u = (f32x4){0.f, 0.f, 0.f, 0.f};
                        { const bf16x8 a = *(const bf16x8*)(Tm + (c * 16 + c16) * 40 + q * 8), bb = *(const bf16x8*)(MtT + (w * 16 + c16) * 40 + q * 8); mfma_safe(u, a, bb); }
                        { u32x2 w2; w2.x = pk2(-u[0], -u[1]); w2.y = pk2(-u[2], -u[3]); *(u32x2*)(UVt + (c * 64 + w * 16 + c16) * 40 + 4 * q) = w2; }
                        LDSWAIT();
                        f32x4 o = (f32x4){0.f, 0.f, 0.f, 0.f};
#pragma unroll
                        for (int ks = 0; ks < 2; ++ks) { const bf16x8 a = *(const bf16x8*)(Sb + (w * 16 + c16) * 72 + ks * 32 + q * 8), bb = *(const bf16x8*)(RT + (c * 16 + c16) * 72 + ks * 32 + q * 8); mfma_safe(o, a, bb); }
                        { const bf16x8 a = *(const bf16x8*)(UVt + (c * 64 + w * 16 + c16) * 40 + q * 8), bb = *(const bf16x8*)(CC + (c * 16 + c16) * 40 + q * 8); mfma_safe(o, a, bb); }
                        { const int sp = c * 16 + c16, tk = d ? 31 - sp : sp; *(f32x4*)(Oc + tk * 64 + w * 16 + 4 * q) = o; }
#pragma unroll
                        for (int kt = 0; kt < 4; ++kt) {
                            const bf16x8 a = *(const bf16x8*)(BKt + (c * 64 + kt * 16 + c16) * 40 + q * 8), bb = *(const bf16x8*)(UVt + (c * 64 + w * 16 + c16) * 40 + q * 8);
                            mfma_safe(SS[kt], a, bb);
                            const f32x4 pc = *(const f32x4*)(PC + c * 64 + kt * 16 + 4 * q);
#pragma unroll
                            for (int j = 0; j < 4; ++j) SS[kt][j] *= pc[j];
                            u32x2 w2; w2.x = pk2(SS[kt][0], SS[kt][1]); w2.y = pk2(SS[kt][2], SS[kt][3]); *(u32x2*)(Sb + (w * 16 + c16) * 72 + kt * 16 + 4 * q) = w2;
                        }
                        LDSWAIT();
                    }
                }
                prev_row0 = base + t_lo;
            }
        }
#undef RW_FETCH
#undef RW_GEOM
        __syncthreads();
        { const f32x4 o = *(const f32x4*)(Oc + pt * 64 + pc4); stc_8(ob + ((size_t)d * MT + prev_row0 + pt) * 512 + h * 64 + pc4, pk4bf(o)); }
    }
}
#define RW_GG(p) ((u16*)((p).arena + (size_t)MT * 2048 * 2 + (size_t)2 * MT * 512 * 2 + (size_t)2 * MT * 8 * 4 + 4096))
__device__ __forceinline__ void rw_sg_rows(PP pp, int l, int r0) {
    PREF; l = uni(l); r0 = uni(r0); u16* pr = (u16*)p.arena;
    const int wid = tix >> 6, lane = tix & 63, l16 = lane & 15, sub = lane >> 4;
    const float* mu = p.in[I_rw_mu] + (size_t)l * 2 * 1920;
    float m0[8], m1[8];
#pragma unroll
    for (int e = 0; e < 8; ++e) { m0[e] = mu[1792 + l16 * 8 + e]; m1[e] = mu[1920 + 1792 + l16 * 8 + e]; }
    for (int row = r0 + ((int)blockIdx.x * 8 + wid) * 4 + sub; row < MT; row += (int)gridDim.x * 32) {
        int base, t, L; seq_of(row, base, t, L);
        const u16* q0 = pr + (size_t)row * 2048 + 1792 + l16 * 8;
        float pc[8], pm[8], pn[8], o[8];
        u32x4 vm = (u32x4){0u, 0u, 0u, 0u}, vn = vm; const u32x4 vc = ldc_16(q0);
        if (t > 0) vm = ldc_16(q0 - 2048);
        if (t < L - 1) vn = ldc_16(q0 + 2048);
        unpack8(vc, pc); unpack8(vm, pm); unpack8(vn, pn);
#pragma unroll
        for (int e = 0; e < 8; ++e) o[e] = sigm(pc[e] + m0[e] * (pm[e] - pc[e]) + m1[e] * (pn[e] - pc[e]));
        stc_16(pr + (size_t)row * 2048 + 1920 + l16 * 8, pack8(o));
    }
}
__device__ __forceinline__ void ph_rw_out(PP pp, int l, int r0) {
    PREF; l = uni(l); r0 = uni(r0); const u16* pr = (const u16*)p.arena; const u16* ob = (const u16*)(p.arena + (size_t)MT * 2048 * 2); const float* bon = (const float*)(p.arena + (size_t)MT * 2048 * 2 + (size_t)2 * MT * 512 * 2); const u16* gg = RW_GG(p);
    const int wid = tix >> 6, lane = tix & 63, c0 = lane * 8, h = lane >> 3;
    const float* mu = p.in[I_rw_mu] + (size_t)l * 2 * 1920;
    float m0[8], m1[8], lg[8], lb[8];
#pragma unroll
    for (int e = 0; e < 8; ++e) { m0[e] = mu[1024 + c0 + e]; m1[e] = mu[1920 + 1024 + c0 + e]; lg[e] = p.in[I_rw_ln_g][l * 512 + c0 + e]; lb[e] = p.in[I_rw_ln_b][l * 512 + c0 + e]; }
    for (int row = r0 + blockIdx.x * 8 + wid; row < MT; row += gridDim.x * 8) {
        int base, t, L; seq_of(row, base, t, L);
        const u16* q0 = pr + (size_t)row * 2048 + 1024 + c0;
        float pc[8], pm[8], pn[8], g[8], o[8];
        f32x4 a0, a1, b0, b1; ld8bf(ob + (size_t)row * 512 + c0, a0, a1); ld8bf(ob + ((size_t)MT + row) * 512 + c0, b0, b1);
        unpack8(ldc_16(q0), pc); unpack8(ldc_16(gg + (size_t)row * 512 + c0), g);
        if (t > 0) unpack8(ldc_16(q0 - 2048), pm); else { for (int e = 0; e < 8; ++e) pm[e] = 0.f; }
        if (t < L - 1) unpack8(ldc_16(q0 + 2048), pn); else { for (int e = 0; e < 8; ++e) pn[e] = 0.f; }
        const float bs = ldc_f32(bon + (size_t)row * 8 + h) + ldc_f32(bon + ((size_t)MT + row) * 8 + h);
        float sm = 0.f;
#pragma unroll
        for (int e = 0; e < 4; ++e) { o[e] = a0[e] + b0[e]; o[4 + e] = a1[e] + b1[e]; }
#pragma unroll
        for (int e = 0; e < 8; ++e) sm += o[e];
        const float mean = sum8lanes(sm) * (1.f / 64.f);
        float sv = 0.f;
#pragma unroll
        for (int e = 0; e < 8; ++e) { o[e] -= mean; sv += o[e] * o[e]; }
        const float rs = rsqrtf(sum8lanes(sv) * (1.f / 64.f) + 64e-5f);
        float y[8];
#pragma unroll
        for (int e = 0; e < 8; ++e) { const float v = pc[e] + m0[e] * (pm[e] - pc[e]) + m1[e] * (pn[e] - pc[e]); y[e] = (o[e] * rs * lg[e] + lb[e] + bs * v) * g[e]; }
        stc_16(p.y + ((size_t)MT + row) * 512 + c0, pack8(y));
    }
}

__device__ __forceinline__ void ph_s5_scan(PP pp, int l) {
    PREF; l = uni(l); const u16* ps = p.y + (size_t)3 * MT * 512; u16* ys = (u16*)(p.arena + (size_t)MT * 512 * 2);
    const int wid = tix >> 6, lane = tix & 63, c = lane & 15, q = lane >> 4;
    if (wid >= 4) return;
    float* X0 = (float*)(smem + wid * 24832);
    u16* Hs = (u16*)(smem + wid * 24832 + 20480);
    for (int sid = blockIdx.x + wid * gridDim.x; sid < 1024; sid += gridDim.x * 4) {
        const int b = sid >> 6, g = (sid >> 1) & 31, d = sid & 1;
        const float dt = expf(p.in[I_s5_log_dt][(l * 2 + d) * 32 + g]);
        const float* are_p = p.in[I_s5_a_re] + ((size_t)(l * 2 + d) * 32 + g) * 64; const float* aim_p = p.in[I_s5_a_im] + ((size_t)(l * 2 + d) * 32 + g) * 64;
        float abr, abi;
        { const float are = are_p[lane], aim = aim_p[lane]; const float mag = expf(are * dt), ang = aim * dt; abr = mag * cosf(ang); abi = mag * sinf(ang); }
        bf16x8 bfr[8];
#pragma unroll
        for (int tn = 0; tn < 4; ++tn) {
            const int n = tn * 16 + c;
            const float are = are_p[n], aim = aim_p[n]; const float mag = expf(are * dt), ang = aim * dt, ar = mag * cosf(ang), ai = mag * sinf(ang);
            const float nr = ar - 1.f, ni = ai, den = are * are + aim * aim, fre = (nr * are + ni * aim) / den, fim = (ni * are - nr * aim) / den;
            unsigned wr[4], wi[4];
#pragma unroll
            for (int j2 = 0; j2 < 4; ++j2) { float vr[2], vi[2];
#pragma unroll
                for (int e = 0; e < 2; ++e) { const int u = 8 * q + 2 * j2 + e; float br = 0.f, bi = 0.f;
                    if (q < 2) { br = p.in[I_s5_b_re][((size_t)(l * 32 + g) * 64 + n) * 16 + u]; bi = p.in[I_s5_b_im][((size_t)(l * 32 + g) * 64 + n) * 16 + u]; }
                    vr[e] = fre * br - fim * bi; vi[e] = fre * bi + fim * br; }
                wr[j2] = pk2(vr[0], vr[1]); wi[j2] = pk2(vi[0], vi[1]); }
            u32x4 t0 = (u32x4){wr[0], wr[1], wr[2], wr[3]}, t1 = (u32x4){wi[0], wi[1], wi[2], wi[3]};
            bfr[tn] = __builtin_bit_cast(bf16x8, t0); bfr[4 + tn] = __builtin_bit_cast(bf16x8, t1);
        }
        bf16x8 cfr[4];
#pragma unroll
        for (int ks = 0; ks < 4; ++ks) { unsigned w[4];
#pragma unroll
            for (int j2 = 0; j2 < 4; ++j2) { float v[2];
#pragma unroll
                for (int e = 0; e < 2; ++e) { const int n = ks * 16 + 4 * q + j2;
                    v[e] = e == 0 ? p.in[I_s5_c_re][((size_t)(l * 32 + g) * 16 + c) * 64 + n] : -p.in[I_s5_c_im][((size_t)(l * 32 + g) * 16 + c) * 64 + n]; }
                w[j2] = pk2(v[0], v[1]); }
            u32x4 t = (u32x4){w[0], w[1], w[2], w[3]}; cfr[ks] = __builtin_bit_cast(bf16x8, t); }
        float hr = 0.f, hi = 0.f;
#define S5_ROW(fc, i) ((fc) < 16 ? (b * 256 + (d ? 255 - (16 * (fc) + (i)) : 16 * (fc) + (i))) : (RC + b * 2048 + (d ? 2047 - (16 * ((fc) - 16) + (i)) : 16 * ((fc) - 16) + (i))))
        u32x4 ua = (u32x4){0u, 0u, 0u, 0u};
        if (q < 2) ua = ldc_16(ps + (size_t)S5_ROW(0, c) * 512 + g * 16 + q * 8);
#define S5_DRIVE(Xb, afr_) do { _Pragma("unroll") for (int tl = 0; tl < 8; ++tl) { f32x4 xa = (f32x4){0.f, 0.f, 0.f, 0.f}; mfma_safe(xa, afr_, bfr[tl]); \
            *(f32x4*)((Xb) + (tl * 16 + c) * 20 + 4 * q) = xa; } } while (0)
        { const bf16x8 afr0 = __builtin_bit_cast(bf16x8, ua); LDSWAIT(); S5_DRIVE(X0, afr0); }
        if (q < 2) ua = ldc_16(ps + (size_t)S5_ROW(1, c) * 512 + g * 16 + q * 8);
        for (int fc = 0; fc < 144; ++fc) {
            float* Xc = X0 + (fc & 1) * 2560; float* Xn = X0 + ((fc & 1) ^ 1) * 2560;
            float xr[16], xi[16];
#pragma unroll
            for (int t4 = 0; t4 < 4; ++t4) { const f32x4 vr = *(const f32x4*)(Xc + lane * 20 + 4 * t4), vi = *(const f32x4*)(Xc + (64 + lane) * 20 + 4 * t4);
#pragma unroll
                for (int e = 0; e < 4; ++e) { xr[4 * t4 + e] = vr[e]; xi[4 * t4 + e] = vi[e]; } }
            if (fc + 1 < 144) { const bf16x8 afr = __builtin_bit_cast(bf16x8, ua);
                if (q < 2 && fc + 2 < 144) ua = ldc_16(ps + (size_t)S5_ROW(fc + 2, c) * 512 + g * 16 + q * 8);
                S5_DRIVE(Xn, afr); }
#pragma unroll
            for (int tk = 0; tk < 16; ++tk) {
                const float nhr = abr * hr - abi * hi + xr[tk], nhi = abr * hi + abi * hr + xi[tk]; hr = nhr; hi = nhi;
                *(unsigned*)(Hs + tk * 136 + 2 * lane) = pk2(hr, hi);
            }
            LDSWAIT();
            f32x4 ya = (f32x4){0.f, 0.f, 0.f, 0.f};
#pragma unroll
            for (int ks = 0; ks < 4; ++ks) { const bf16x8 hf = *(const bf16x8*)(Hs + c * 136 + ks * 32 + q * 8); mfma_safe(ya, cfr[ks], hf); }
            stc_8(ys + ((size_t)d * MT + S5_ROW(fc, c)) * 512 + g * 16 + 4 * q, pk4bf(ya));
        }
#undef S5_DRIVE
#undef S5_ROW
    }
}
__device__ __forceinline__ void ph_s5_act(PP pp, int l, int r0) {
    PREF; l = uni(l); r0 = uni(r0); const u16* ps = p.y + (size_t)3 * MT * 512; const u16* ys = (const u16*)(p.arena + (size_t)MT * 512 * 2); u16* ya = (u16*)(p.arena + (size_t)MT * 512 * 2 + (size_t)2 * MT * 512 * 4);
    const int wid = tix >> 6, lane = tix & 63, c0 = lane * 8;
    float dsk[8];
#pragma unroll
    for (int e = 0; e < 8; ++e) dsk[e] = p.in[I_s5_d][l * 512 + c0 + e];
    for (int row = r0 + blockIdx.x * 8 + wid; row < MT; row += gridDim.x * 8) {
        f32x4 a0, a1, b0, b1; ld8bf(ys + (size_t)row * 512 + c0, a0, a1); ld8bf(ys + ((size_t)MT + row) * 512 + c0, b0, b1);
        float u[8], o[8]; unpack8(ldc_16(ps + (size_t)row * 512 + c0), u);
#pragma unroll
        for (int e = 0; e < 8; ++e) { const float x = (e < 4 ? a0[e & 3] + b0[e & 3] : a1[e & 3] + b1[e & 3]) + dsk[e] * u[e]; o[e] = 0.5f * x * (1.f + ftanh(0.7978845608028654f * (x + 0.044715f * x * x * x))); }
        stc_16(ya + (size_t)row * 512 + c0, pack8(o));
    }
}

typedef __amdgpu_buffer_rsrc_t brsrc_t;
__device__ __forceinline__ brsrc_t mk_rsrc(const void* base, unsigned bytes) { return __builtin_amdgcn_make_buffer_rsrc((void*)base, (short)0, (int)bytes, 0x00020000); }
__device__ __forceinline__ u32x4 ld16_sc1(brsrc_t r, unsigned off) { return __builtin_bit_cast(u32x4, __builtin_amdgcn_raw_buffer_load_b128(r, (int)off, 0, SC1_AUX)); }
__device__ __forceinline__ unsigned ld4_sc1(brsrc_t r, unsigned off) { return __builtin_amdgcn_raw_buffer_load_b32(r, (int)off, 0, SC1_AUX); }
__device__ __forceinline__ void ph_gla_scan(PP pp, int l) {
    PREF; l = uni(l); const u16* pg = (const u16*)p.arena; u16* og = (u16*)(p.arena + (size_t)MT * 1792 * 2);
    const int tid = tix, wid = tid >> 6, lane = tid & 63, c = lane & 15, q = lane >> 4;
    const brsrc_t pgr = mk_rsrc(pg, (unsigned)((size_t)MT * 1792 * 2));
    u16* QT = (u16*)smem; u16* KT = QT + 4608; u16* QH = KT + 4608; u16* KHt = QH + 4608; u16* Vt = KHt + 4608; u16* Pm = Vt + 4608; u16* St = Pm + 4608;
    float* CUM = (float*)(St + 4608); float* TOT = CUM + 4096; float* GB = TOT + 512; float* DEC = GB + 64;
    u16* GUt = (u16*)(DEC + 64); u16* GDp = GUt + 64 * 40;
    const int tok = tid >> 3, c8 = (tid & 7) * 8;
    for (int item = blockIdx.x; item < 256; item += gridDim.x) {
        const int b = item >> 4, h = (item >> 2) & 3, d = (item >> 1) & 1, eh = item & 1;
        __syncthreads();
        for (int i = tid; i < 64 * 40; i += NT) { const int chn = i / 40, m = i - chn * 40; GUt[i] = m < 16 ? f2bf(p.in[I_gla_gate_up][((size_t)(l * 2 + d) * 16 + m) * 256 + h * 64 + chn]) : (u16)0; GDp[i] = (u16)0; GDp[64 * 40 + i] = (u16)0; }
        if (tid < 64) GB[tid] = p.in[I_gla_gate_b][(l * 2 + d) * 256 + h * 64 + tid];
        f32x4 sacc[2];
        sacc[0] = (f32x4){0.f, 0.f, 0.f, 0.f}; sacc[1] = sacc[0];
#define GLA_ROW(s) ((s) < 256 ? (b * 256 + (d ? 255 - (s) : (s))) : (RC + b * 2048 + ((((d ? 2047 - ((s) - 256) : ((s) - 256)) & 31) * 64) + ((d ? 2047 - ((s) - 256) : ((s) - 256)) >> 5))))
        u32x4 rq, rk, rv; unsigned rg;
        { const unsigned ro = (unsigned)GLA_ROW(tok) * 3584u; rq = ld16_sc1(pgr, ro + (h * 64 + c8) * 2); rk = ld16_sc1(pgr, ro + (256 + h * 64 + c8) * 2);
          rv = ld16_sc1(pgr, ro + (512 + h * 128 + eh * 64 + c8) * 2); rg = ld4_sc1(pgr, ro + (1536 + d * 16 + (tid & 7) * 2) * 2); }
        for (int ch = 0; ch < 36; ++ch) {
            const u32x4 cq = rq, ck = rk, cv = rv; const unsigned cg = rg;
            u16* GDc = GDp + (ch & 1) * (64 * 40);
            *(unsigned*)(GDc + tok * 40 + (tid & 7) * 2) = cg;
            __syncthreads();
            if (ch + 1 < 36) { const unsigned ro = (unsigned)GLA_ROW((ch + 1) * 64 + tok) * 3584u; rq = ld16_sc1(pgr, ro + (h * 64 + c8) * 2); rk = ld16_sc1(pgr, ro + (256 + h * 64 + c8) * 2);
                rv = ld16_sc1(pgr, ro + (512 + h * 128 + eh * 64 + c8) * 2); rg = ld4_sc1(pgr, ro + (1536 + d * 16 + (tid & 7) * 2) * 2); }
#pragma unroll
            for (int s2 = 0; s2 < 2; ++s2) { const int id = wid * 2 + s2, tt = id >> 2, ct = id & 3;
                f32x4 g4 = (f32x4){0.f, 0.f, 0.f, 0.f};
                { const bf16x8 a = *(const bf16x8*)(GDc + (tt * 16 + c) * 40 + q * 8), bb = *(const bf16x8*)(GUt + (ct * 16 + c) * 40 + q * 8); mfma_safe(g4, a, bb); }
                const float gb = GB[ct * 16 + c]; float pf[4];
#pragma unroll
                for (int j = 0; j < 4; ++j) { const float x = g4[j] + gb; pf[j] = (fminf(x, 0.f) - __builtin_amdgcn_logf(1.f + fexp(-fabsf(x))) * 0.6931471805599453f) * (1.f / 16.f); }
                pf[1] += pf[0]; pf[2] += pf[1]; pf[3] += pf[2];
                float sgrp = pf[3];
                { const float u1 = __int_as_float(__builtin_amdgcn_ds_bpermute((lane - 16) * 4, __float_as_int(sgrp))); if (q >= 1) sgrp += u1; }
                { const float u2 = __int_as_float(__builtin_amdgcn_ds_bpermute((lane - 32) * 4, __float_as_int(sgrp))); if (q >= 2) sgrp += u2; }
                const float excl = sgrp - pf[3];
#pragma unroll
                for (int j = 0; j < 4; ++j) CUM[(tt * 16 + 4 * q + j) * 64 + ct * 16 + c] = pf[j] + excl;
                if (q == 3) TOT[tt * 64 + ct * 16 + c] = sgrp; }
            __syncthreads();
            {
                float cm[8], rf[8], la[8];
                { const int tt = tok >> 4;
#pragma unroll
                  for (int hh = 0; hh < 2; ++hh) { const f32x4 mv = *(const f32x4*)(CUM + tok * 64 + c8 + 4 * hh), fv = *(const f32x4*)(CUM + 31 * 64 + c8 + 4 * hh), lv = *(const f32x4*)(CUM + 63 * 64 + c8 + 4 * hh);
                      const f32x4 t0 = *(const f32x4*)(TOT + c8 + 4 * hh), t1 = *(const f32x4*)(TOT + 64 + c8 + 4 * hh), t2 = *(const f32x4*)(TOT + 128 + c8 + 4 * hh);
#pragma unroll
                      for (int e = 0; e < 4; ++e) { cm[4 * hh + e] = mv[e] + (tt >= 1 ? t0[e] : 0.f) + (tt >= 2 ? t1[e] : 0.f) + (tt >= 3 ? t2[e] : 0.f); rf[4 * hh + e] = fv[e] + t0[e]; la[4 * hh + e] = lv[e] + (t0[e] + t1[e]) + t2[e]; } }
                  if (tok == 63) {
#pragma unroll
                      for (int e = 0; e < 8; ++e) DEC[c8 + e] = fexp(la[e]); } }
                const unsigned qw[4] = {cq.x, cq.y, cq.z, cq.w}, kw[4] = {ck.x, ck.y, ck.z, ck.w}, vw[4] = {cv.x, cv.y, cv.z, cv.w};
                float qt[8], kt[8], qh[8], kh[8];
#pragma unroll
                for (int e = 0; e < 8; ++e) {
                    const float qv = (e & 1 ? __uint_as_float(qw[e >> 1] & 0xffff0000u) : __uint_as_float(qw[e >> 1] << 16)) * 0.125f;
                    const float kv = (e & 1 ? __uint_as_float(kw[e >> 1] & 0xffff0000u) : __uint_as_float(kw[e >> 1] << 16));
                    const float e1 = fexp(cm[e] - rf[e]), r1 = fexp(rf[e] - cm[e]);
                    qt[e] = qv * e1; kt[e] = kv * r1; qh[e] = qt[e] * fexp(rf[e]); kh[e] = kt[e] * fexp(la[e] - rf[e]);
                }
                u32x4 w;
                w.x = pk2(qt[0], qt[1]); w.y = pk2(qt[2], qt[3]); w.z = pk2(qt[4], qt[5]); w.w = pk2(qt[6], qt[7]); *(u32x4*)(QT + tok * 72 + c8) = w;
                w.x = pk2(kt[0], kt[1]); w.y = pk2(kt[2], kt[3]); w.z = pk2(kt[4], kt[5]); w.w = pk2(kt[6], kt[7]); *(u32x4*)(KT + tok * 72 + c8) = w;
                w.x = pk2(qh[0], qh[1]); w.y = pk2(qh[2], qh[3]); w.z = pk2(qh[4], qh[5]); w.w = pk2(qh[6], qh[7]); *(u32x4*)(QH + tok * 72 + c8) = w;
#pragma unroll
                for (int e = 0; e < 8; ++e) { KHt[(c8 + e) * 72 + tok] = f2bf(kh[e]); Vt[(c8 + e) * 72 + tok] = (u16)(e & 1 ? (vw[e >> 1] >> 16) : (vw[e >> 1] & 0xffffu)); }
#pragma unroll
                for (int s2 = 0; s2 < 2; ++s2) { const int id = wid * 2 + s2, dkt = id >> 2, et = id & 3;
                    u32x2 sw; sw.x = pk2(sacc[s2][0], sacc[s2][1]); sw.y = pk2(sacc[s2][2], sacc[s2][3]); *(u32x2*)(St + (et * 16 + c) * 72 + dkt * 16 + 4 * q) = sw; }
            }
            __syncthreads();
#pragma unroll
            for (int s2 = 0; s2 < 2; ++s2) { const int id = wid * 2 + s2, it = id >> 2, jt = id & 3;
                f32x4 pa = (f32x4){0.f, 0.f, 0.f, 0.f};
                if (jt <= it) {
#pragma unroll
                    for (int ks = 0; ks < 2; ++ks) { const bf16x8 a = *(const bf16x8*)(QT + (it * 16 + c) * 72 + ks * 32 + q * 8), bb = *(const bf16x8*)(KT + (jt * 16 + c) * 72 + ks * 32 + q * 8); mfma_safe(pa, a, bb); } }
#pragma unroll
                for (int jj = 0; jj < 4; ++jj) { const int i = it * 16 + 4 * q + jj, j = jt * 16 + c; Pm[i * 72 + j] = f2bf(i >= j ? pa[jj] : 0.f); } }
            __syncthreads();
#pragma unroll
            for (int s2 = 0; s2 < 2; ++s2) { const int id = wid * 2 + s2, it = id >> 2, et = id & 3;
                f32x4 oa = (f32x4){0.f, 0.f, 0.f, 0.f};
#pragma unroll
                for (int ks = 0; ks < 2; ++ks) { const bf16x8 a = *(const bf16x8*)(Vt + (et * 16 + c) * 72 + ks * 32 + q * 8), bb = *(const bf16x8*)(Pm + (it * 16 + c) * 72 + ks * 32 + q * 8); mfma_safe(oa, a, bb); }
#pragma unroll
                for (int ks = 0; ks < 2; ++ks) { const bf16x8 a = *(const bf16x8*)(St + (et * 16 + c) * 72 + ks * 32 + q * 8), bb = *(const bf16x8*)(QH + (it * 16 + c) * 72 + ks * 32 + q * 8); mfma_safe(oa, a, bb); }
                stc_8(og + ((size_t)d * MT + GLA_ROW(ch * 64 + it * 16 + c)) * 512 + h * 128 + eh * 64 + et * 16 + 4 * q, pk4bf(oa));
                const int dkt = it;
#pragma unroll
                for (int jj = 0; jj < 4; ++jj) sacc[s2][jj] *= DEC[dkt * 16 + 4 * q + jj];
#pragma unroll
                for (int ks = 0; ks < 2; ++ks) { const bf16x8 a = *(const bf16x8*)(KHt + (dkt * 16 + c) * 72 + ks * 32 + q * 8), bb = *(const bf16x8*)(Vt + (et * 16 + c) * 72 + ks * 32 + q * 8); mfma_safe(sacc[s2], a, bb); }
            }
        }
#undef GLA_ROW
    }
}
__device__ __forceinline__ void ph_gla_out(PP pp, int l, int r0) {
    PREF; l = uni(l); r0 = uni(r0); const u16* pg = (const u16*)p.arena; const u16* og = (const u16*)(p.arena + (size_t)MT * 1792 * 2);
    const int wid = tix >> 6, lane = tix & 63, c0 = lane * 8;
    float ng[8];
#pragma unroll
    for (int e = 0; e < 8; ++e) ng[e] = p.in[I_gla_norm_g][l * 128 + ((c0 + e) & 127)];
    for (int row = r0 + blockIdx.x * 8 + wid; row < MT; row += gridDim.x * 8) {
        f32x4 a0, a1, b0, b1; ld8bf(og + (size_t)row * 512 + c0, a0, a1); ld8bf(og + ((size_t)MT + row) * 512 + c0, b0, b1);
        float g[8], o[8], y[8]; unpack8(ldc_16(pg + (size_t)row * 1792 + 1024 + c0), g);
        float ss = 0.f;
#pragma unroll
        for (int e = 0; e < 4; ++e) { o[e] = a0[e] + b0[e]; o[4 + e] = a1[e] + b1[e]; }
#pragma unroll
        for (int e = 0; e < 8; ++e) ss += o[e] * o[e];
        const float rs = rsqrtf(rowsum16(ss) * (1.f / 128.f) + 1e-6f);
#pragma unroll
        for (int e = 0; e < 8; ++e) y[e] = o[e] * rs * ng[e] * g[e] * sigm(g[e]);
        stc_16(p.y + ((size_t)3 * MT + row) * 512 + c0, pack8(y));
    }
}


__device__ __forceinline__ void ph_moe_slot(PP pp) {
    PREF;
    const int G = (int)gridDim.x, wid = tix >> 6, lane = tix & 63;
    int* tab = (int*)smem; int* sh = tab + 8 * G;
    __syncthreads();
    for (int i = tix; i < 8 * G; i += NT) tab[i] = (int)ldc_u32(p.moe_i + 1024 + i);
    __syncthreads();
    if (tix < 8) { int tot = 0, mine = 0; for (int b = 0; b < G; ++b) { const int c = tab[b * 8 + tix]; if (b < (int)blockIdx.x) mine += c; tot += c; } sh[17 + tix] = tot; sh[tix] = mine; }
    __syncthreads();
    if (tix == 0) { int ps = 0, nt = 0;
#pragma unroll 1
        for (int e = 0; e < 8; ++e) { sh[8 + e] = ps; const int tl = (sh[17 + e] + 255) / 256;
            if (blockIdx.x == 0) { int ev = e; asm volatile("" : "+v"(ev));
#pragma unroll 1
                for (int j = 0; j < tl; ++j) stc_u32(p.moe_i + 32 + nt + j, (unsigned)ev); }
            nt += tl; ps += tl * 256; }
        sh[16] = ps; if (blockIdx.x == 0) stc_u32(p.moe_i + 25, (unsigned)nt); }
    __syncthreads();
    for (int row = RC + blockIdx.x * 8 + wid; row < MT; row += G * 8) {
        const int tok = row - RC;
        const int e0 = (int)ldc_u32(p.top_i + tok * 2), e1 = (int)ldc_u32(p.top_i + tok * 2 + 1), k0 = (int)ldc_u32(p.row_tok + tok * 2), k1 = (int)ldc_u32(p.row_tok + tok * 2 + 1);
        const int d0 = sh[8 + e0] + sh[e0] + k0, d1 = sh[8 + e1] + sh[e1] + k1;
        if (lane == 0) { stc_u32(p.dest_of + tok * 2, (unsigned)d0); stc_u32(p.dest_of + tok * 2 + 1, (unsigned)d1); }
        const u32x4 a = ldc_16((const char*)p.hn + (size_t)row * 1024 + lane * 16);
        stc_16((char*)p.xb8 + (size_t)d0 * 1024 + lane * 16, a); stc_16((char*)p.xb8 + (size_t)d1 * 1024 + lane * 16, a);
    }
}
__device__ __forceinline__ void ph_final(PP pp) {
    PREF;
    const int wid = tix >> 6, lane = tix & 63;
    const float* g = p.in[I_final_norm_g];
    for (int tok = blockIdx.x * 8 + wid; tok < 32768; tok += gridDim.x * 8) {
        const float* gt = p.mod + (size_t)(17 + (tok >> 11)) * 6144 + 5120;
        const int d0 = (int)ldc_u32(p.dest_of + tok * 2), d1 = (int)ldc_u32(p.dest_of + tok * 2 + 1); const float g0 = ldc_f32(p.top_g + tok * 2), g1 = ldc_f32(p.top_g + tok * 2 + 1);
        float* hp = p.out + (size_t)tok * 1024;
        f32x4 v[4]; float ss = 0.f;
#pragma unroll
        for (int i = 0; i < 4; ++i) { const int k = i * 256 + lane * 4;
            const u32x2 a = ldc_8(p.yb + (size_t)d0 * 1024 + k), b = ldc_8(p.yb + (size_t)d1 * 1024 + k);
            const f32x4 hh = ldc_f4(hp + k), gg = *(const f32x4*)(gt + k);
            float ya[4] = {__uint_as_float(a.x << 16), __uint_as_float(a.x & 0xffff0000u), __uint_as_float(a.y << 16), __uint_as_float(a.y & 0xffff0000u)};
            float yc[4] = {__uint_as_float(b.x << 16), __uint_as_float(b.x & 0xffff0000u), __uint_as_float(b.y << 16), __uint_as_float(b.y & 0xffff0000u)};
#pragma unroll
            for (int j = 0; j < 4; ++j) { v[i][j] = hh[j] + gg[j] * (g0 * ya[j] + g1 * yc[j]); ss += v[i][j] * v[i][j]; } }
        ss = wsum(ss); const float rs = rsqrtf(ss * (1.f / 1024.f) + 1e-6f);
#pragma unroll
        for (int i = 0; i < 4; ++i) { const int k = i * 256 + lane * 4; const f32x4 gg = *(const f32x4*)(g + k); f32x4 o;
#pragma unroll
            for (int j = 0; j < 4; ++j) o[j] = v[i][j] * rs * gg[j];
            stc_f4(hp + k, o); }
    }
}


__device__ __forceinline__ GPb mkg(const u16* A, long lda, const u16* Bt, long ldb, int K, int tm0, int ntm, int ntn) { GPb g; g.A = A; g.lda = lda; g.Bt = Bt; g.ldb = ldb; g.Kd = K; g.tm0 = tm0; g.ntm = ntm; g.ntn = ntn; return g; }
#define BIGG (1 << 30)
__device__ __forceinline__ void ph_gemm_in(PP pp, int l, int part) {
    PREF; l = uni(l); part = uni(part);
    const int last = (l == 1);
    const u16* wt = p.wt_in + (size_t)l * 9984 * 1024;
    Dense8<PrStore> g;
    if (part == 0) { (GPb&)g = mkg(p.hn, 1024, wt, 1024, 1024, last ? 16 : 0, last ? 128 : 144, 6); g.ldo = 1536; g.act = 0; }
    else if (part == 1) { (GPb&)g = mkg(p.hn, 1024, wt + (size_t)1536 * 1024, 1024, 1024, 0, 144, 8); g.ldo = 2048; g.act = 0; }
    else if (part == 2) { (GPb&)g = mkg(p.hn, 1024, wt + (size_t)3584 * 1024, 1024, 1024, 0, 144, 2); g.ldo = 512; g.act = 0; }
    else if (part == 3) { (GPb&)g = mkg(p.hn, 1024, wt + (size_t)4096 * 1024, 1024, 1024, 0, 144, 7); g.ldo = 1792; g.act = 0; }
    else { (GPb&)g = mkg(p.hn, 1024, wt + (size_t)5888 * 1024, 1024, 1024, last ? 16 : 0, last ? 128 : 144, 16); g.ldo = 4096; g.act = 1; }
    g.O = part == 2 ? p.y + (size_t)3 * MT * 512 : (u16*)p.arena;
    if (FP8IN_LAST && last && part < 4) {
        const int roff = part == 0 ? 0 : part == 1 ? 1536 : part == 2 ? 3584 : 4096;
        Dense8F<PrStore> g8; (GPb&)g8 = (GPb&)g; g8.A = (const u16*)HN8(p); g8.Bt = (const u16*)((const char*)p.wt_in8 + (size_t)roff * 1024); g8.O = g.O; g8.ldo = g.ldo; g8.act = 0; g8.sa_ = 127; g8.sb_ = 122;
        GEMM8F(g8);
    } else GEMM8(g);
}
__device__ __forceinline__ void ph_hn8(PP pp, int r0) {
    PREF; r0 = uni(r0);
    const int wid = tix >> 6, lane = tix & 63;
    for (int row = r0 + blockIdx.x * 8 + wid; row < MT; row += gridDim.x * 8) {
        float a[8], b[8]; unpack8(ldc_16(p.hn + (size_t)row * 1024 + lane * 16), a); unpack8(ldc_16(p.hn + (size_t)row * 1024 + lane * 16 + 8), b);
        u32x4 w; w.x = pk4_fp8(a[0], a[1], a[2], a[3]); w.y = pk4_fp8(a[4], a[5], a[6], a[7]); w.z = pk4_fp8(b[0], b[1], b[2], b[3]); w.w = pk4_fp8(b[4], b[5], b[6], b[7]);
        stc_16(HN8(p) + (size_t)row * 1024 + lane * 16, w);
    }
}
__device__ __forceinline__ void ph_gemm_gates(PP pp, int l) {
    PREF; l = uni(l); const int last = (l == 1);
    Dense8F<PrStore> g; (GPb&)g = mkg((const u16*)HN8(p), 1024, (const u16*)((const char*)p.wt_gate8 + (size_t)l * 4096 * 1024), 1024, 1024, last ? 16 : 0, last ? 128 : 144, 16); g.ldo = 4096; g.act = 1; g.O = (u16*)p.arena; g.sa_ = 127; g.sb_ = 122;
    GEMM8F(g);
}
__device__ __forceinline__ void ph_gemm_in12(PP pp, int l) {
    PREF; l = uni(l);
    In12 g; g.A = p.hn; g.Wt = p.wt_in + (size_t)l * 9984 * 1024; g.Orw = (u16*)p.arena; g.Os5 = p.y + (size_t)3 * MT * 512;
    GEMM8(g);
}
__device__ __forceinline__ void ph_gemm_rwg(PP pp, int l) {
    PREF; l = uni(l); const int last = (l == 1);
    Dense8<PrStore> g; (GPb&)g = mkg((const u16*)p.arena + 1792, 2048, p.wt_g + (size_t)l * 512 * 256, 256, 256, last ? 16 : 0, last ? 128 : 144, 2); g.O = RW_GG(p); g.ldo = 512; g.act = 0;
    GEMM8(g);
}
__device__ __forceinline__ void ph_gemm_glu(PP pp, int l) {
    PREF; l = uni(l); const int last = (l == 1);
    u16* ya = (u16*)(p.arena + (size_t)MT * 512 * 2 + (size_t)2 * MT * 512 * 4);
    Dense8<PrGlu> q; (GPb&)q = mkg(ya, 512, p.wt_glu + (size_t)l * 512 * 512, 512, 512, last ? 16 : 0, last ? 128 : 144, 2); q.ya = ya; q.gb = p.in[I_s5_glu_b] + l * 512; q.O = p.y + (size_t)2 * MT * 512;
    GEMM8(q);
}
__device__ __forceinline__ void ph_gemm_branch4(PP pp, int l) {
    PREF; l = uni(l); const int last = (l == 1);
    Branch8 q; q.y = p.y; q.wt = p.wt_br + (size_t)l * 4 * 1024 * 512; q.G = (const u16*)p.arena; q.acc = p.hn; q.tm0 = last ? 16 : 0; q.ntm = last ? 128 : 144;
    GEMM8(q);
}
__device__ __forceinline__ void ph_gemm_resid(PP pp, int l, int which, float scale) {
    PREF; l = uni(l); which = uni(which); const int last = (l == 1), first = (l == 0);
    Dense8<PrResid> r;
    if (which == 0) { (GPb&)r = mkg(p.hn, 1024, p.wt_out + (size_t)l * 1024 * 1024, 1024, 1024, last ? 16 : 0, last ? 128 : 144, 4);
        r.oc = first ? p.in[I_ctx] : p.hctx; r.ol = first ? p.in[I_x] : p.out; r.goff = 2048; }
    else { (GPb&)r = mkg((const u16*)p.arena, 2816, p.wt_f2, 2816, 2816, 0, 144, 4); r.oc = p.hctx; r.ol = p.out; r.goff = 5120; }
    r.nc = p.hctx; r.nl = p.out; r.mod = p.mod + (size_t)l * 17 * 6144; r.scale = scale;
    GEMM8(r);
}
__device__ __forceinline__ void ph_gemm_ffn_up(PP pp) {
    PREF;
    Dense8<PrSwiglu> s; (GPb&)s = mkg(p.hn, 1024, p.wt_f13, 1024, 1024, 0, 144, 22); s.G = (u16*)p.arena; s.ldg = 2816;
    GEMM8(s);
}
__device__ __forceinline__ void ph_gemm_moe_up(PP pp, int ch) {
    PREF; ch = uni(ch);
    MoeUp8F u; u.xb8 = (const char*)p.xb8; u.mi = p.moe_i; u.W8 = (const char*)p.wt_m13; u.G8 = (char*)p.gch; u.t0 = ch * 128; u.nt = ch ? 136 : 128;
    GEMM8F(u);
}
__device__ __forceinline__ void ph_gemm_moe_down(PP pp, int ch) {
    PREF; ch = uni(ch);
    MoeDown8F dn; dn.G8 = (const char*)p.gch; dn.mi = p.moe_i; dn.W8 = (const char*)p.wt_m2; dn.yb = p.yb; dn.t0 = ch * 128; dn.nt = ch ? 136 : 128;
    GEMM8F(dn);
}
__device__ __forceinline__ void ph_prep(PP pp) {
    PREF;
    for (int l = 0; l < 2; ++l) {
        const float* wi = p.in[I_w_in] + (size_t)l * 1024 * 9632; u16* wt = p.wt_in + (size_t)l * 9984 * 1024;
        do_transpose(wi + 0, 1024, 1536, 9632, wt, BIGG, 0, 0, smem);
        do_transpose(wi + 1536, 1024, 1920, 9632, wt, BIGG, 0, 1536, smem);
        do_transpose(wi + 3456, 1024, 512, 9632, wt, BIGG, 0, 3584, smem);
        do_transpose(wi + 3968, 1024, 1568, 9632, wt, BIGG, 0, 4096, smem);
        do_transpose(wi + 5536, 1024, 4096, 9632, (u16*)((char*)p.wt_gate8 + (size_t)l * 4096 * 1024), BIGG, 0, 0, smem, 1);
        if (FP8IN_LAST && l == 1) { do_transpose(wi + 0, 1024, 1536, 9632, p.wt_in8, BIGG, 0, 0, smem, 1); do_transpose(wi + 1536, 1024, 1920, 9632, p.wt_in8, BIGG, 0, 1536, smem, 1);
                      do_transpose(wi + 3456, 1024, 512, 9632, p.wt_in8, BIGG, 0, 3584, smem, 1); do_transpose(wi + 3968, 1024, 1568, 9632, p.wt_in8, BIGG, 0, 4096, smem, 1); }
        for (int m = 0; m < 4; ++m) do_transpose(p.in[I_w_branch] + (size_t)(l * 4 + m) * 512 * 1024, 512, 1024, 1024, p.wt_br + (size_t)(l * 4 + m) * 1024 * 512, BIGG, 0, 0, smem);
        do_transpose(p.in[I_w_out] + (size_t)l * 1024 * 1024, 1024, 1024, 1024, p.wt_out + (size_t)l * 1024 * 1024, BIGG, 0, 0, smem);
        do_transpose(p.in[I_s5_glu_w] + (size_t)l * 512 * 512, 512, 512, 512, p.wt_glu + (size_t)l * 512 * 512, BIGG, 0, 0, smem);
        for (int i = blockIdx.x * NT + tix; i < 128 * 512; i += gridDim.x * NT) { const int n = i >> 7, k = i & 127; p.wt_g[((size_t)l * 512 + n) * 256 + 128 + k] = f2bf(p.in[I_rw_g_up][((size_t)l * 128 + k) * 512 + n]); }
    }
    do_transpose(p.in[I_ffn_w1], 1024, 2816, 2816, p.wt_f13, 128, 256, 0, smem);
    do_transpose(p.in[I_ffn_w3], 1024, 2816, 2816, p.wt_f13, 128, 256, 128, smem);
    do_transpose(p.in[I_ffn_w2], 2816, 1024, 1024, p.wt_f2, BIGG, 0, 0, smem);
}
__device__ __forceinline__ void ph_prep_moe(PP pp) {
    PREF;
    for (int e = 0; e < 8; ++e) {
        do_transpose(p.in[I_moe_w1] + (size_t)e * 1024 * 3584, 1024, 3584, 3584, (u16*)((char*)p.wt_m13 + (size_t)e * 7168 * 1024), 128, 256, 0, smem, 1);
        do_transpose(p.in[I_moe_w3] + (size_t)e * 1024 * 3584, 1024, 3584, 3584, (u16*)((char*)p.wt_m13 + (size_t)e * 7168 * 1024), 128, 256, 128, smem, 1);
        do_transpose(p.in[I_moe_w2] + (size_t)e * 3584 * 1024, 3584, 1024, 1024, (u16*)((char*)p.wt_m2 + (size_t)e * 1024 * 3584), BIGG, 0, 0, smem, 1);
    }
}


__device__ __forceinline__ void l2_scrub(PP pp, int parity) {
    PREF; parity = uni(parity);
    const u32x4* src = (const u32x4*)(parity ? p.in[I_moe_w3] : p.in[I_moe_w1]) + (size_t)blockIdx.x * 16384;
    u32x4 a = (u32x4){0u, 0u, 0u, 0u};
#pragma unroll 8
    for (int i = tix; i < 16384; i += NT) { const u32x4 v = src[i]; a.x ^= v.x; a.y ^= v.y; a.z ^= v.z; a.w ^= v.w; }
    asm volatile("" :: "v"(a.x), "v"(a.y), "v"(a.z), "v"(a.w));
}

__global__ void __launch_bounds__(NT, 2) k_fwd(P p_) {
    extern __shared__ __attribute__((aligned(16))) char smem_raw[];
    PP pp = (PP)__builtin_amdgcn_kernarg_segment_ptr();
    if (threadIdx.x == 0) *(uint4*)smem_raw = make_uint4(0u, 0u, 0u, 0u);
    __syncthreads();
    XcdBarrier bar = xcd_barrier_post(pp->bar, (volatile LAS unsigned*)smem_raw);
    int scr = 0;
#define GSYNC() do { (void)scr; for (int _b = 0; _b < (((REPMASK) >> 9) & 1) + 1; ++_b) xcd_barrier(bar); } while (0)
#ifndef REPN
#define REPN 1
#endif
#define RP(bit) for (int _r = 0; _r < (((REPMASK) >> (bit)) & 1) * REPN + 1; ++_r)
    RP(0) { ph_mod(pp); ph_filt(pp); ph_prep(pp); }
    GSYNC();
    for (int l = 0; l < 2; ++l) {
        const int first = (l == 0), last = (l == 1);
        const int r0L = last ? RC : 0;
        RP(5) { ph_norm(pp, l, 0, 0, MT, first, 0, 0); GSYNC(); }
        RP(1) { ph_gemm_in(pp, l, 0); GSYNC(); }
        RP(2) { ph_hy_pre(pp, l); GSYNC(); }
        RP(2) { ph_hy_conv(pp, l); GSYNC(); }
        ph_hy_post(pp, l, 0);
        RP(1) { ph_gemm_in12(pp, l); GSYNC(); }
        RP(3) { rw_sg_rows(pp, l, r0L); ph_rw_scan(pp, l); GSYNC(); }
        RP(1) { ph_gemm_rwg(pp, l); GSYNC(); }
        RP(10) { ph_rw_out(pp, l, r0L); GSYNC(); }
        RP(4) { ph_s5_scan(pp, l); GSYNC(); }
        RP(5) { ph_s5_act(pp, l, r0L); GSYNC(); }
        RP(10) ph_gemm_glu(pp, l);
        RP(1) { ph_gemm_in(pp, l, 3); GSYNC(); }
        RP(6) { ph_gla_scan(pp, l); GSYNC(); }
        RP(5) { ph_gla_out(pp, l, r0L); GSYNC(); }
        RP(1) { ph_gemm_gates(pp, l); GSYNC(); }
        ph_gemm_branch4(pp, l); GSYNC();
        if ((REPMASK >> 11) & 1) { ph_gemm_resid(pp, l, 0, 0.f); GSYNC(); }
        ph_gemm_resid(pp, l, 0, 1.f); GSYNC();
        if (!last) {
            RP(5) { ph_norm(pp, l, 1, 0, MT, 0, 0, 0); GSYNC(); }
            RP(7) { ph_gemm_ffn_up(pp); GSYNC(); }
            ph_gemm_resid(pp, l, 1, 1.f); GSYNC();
        } else {
            RP(8) { ph_prep_moe(pp); }
            RP(11) { ph_norm(pp, l, 1, RC, MT, 0, 1, 1); GSYNC(); }
            RP(11) { ph_moe_slot(pp); GSYNC(); }
            for (int ch = 0; ch < 2; ++ch) {
                RP(7) { ph_gemm_moe_up(pp, ch); GSYNC(); }
                RP(7) { ph_gemm_moe_down(pp, ch); GSYNC(); }
            }
            ph_final(pp);
        }
    }
}

static inline size_t al256(size_t x) { return (x + 255) & ~(size_t)255; }

extern "C" void kernel_launch(void* const* d_in, const int* in_sizes, int n_in, void* d_out, int out_size, void* d_ws, size_t ws_size, hipStream_t stream) {
    P p; memset(&p, 0, sizeof(p));
    for (int i = 0; i < N_IN; ++i) p.in[i] = (const float*)d_in[i];
    p.out = (float*)d_out;
    char* ws = (char*)d_ws; size_t o = 0;
    auto take = [&](size_t bytes) { char* r = ws + o; o = al256(o + bytes); return r; };
    p.bar = (unsigned*)take(16384);
    p.moe_i = (int*)take(32768);
    p.row_tok = (int*)take((size_t)67584 * 4);
    p.mod = (float*)take((size_t)2 * 17 * 6144 * 4);
    p.rvl = (u16*)take((size_t)2 * 512 * 4096 * 2);
    p.rvc = (u16*)take((size_t)2 * 512 * 512 * 2);
    p.dest_of = (int*)take((size_t)65536 * 4);
    p.top_i = (int*)take((size_t)65536 * 4);
    p.top_g = (float*)take((size_t)65536 * 4);
    p.wt_in = (u16*)take((size_t)2 * 9984 * 1024 * 2);
    p.wt_br = (u16*)take((size_t)2 * 4 * 1024 * 512 * 2);
    p.wt_out = (u16*)take((size_t)2 * 1024 * 1024 * 2);
    p.wt_f13 = (u16*)take((size_t)5632 * 1024 * 2);
    p.wt_f2 = (u16*)take((size_t)1024 * 2816 * 2);
    p.wt_glu = (u16*)take((size_t)2 * 512 * 512 * 2);
    p.wt_g = (u16*)take((size_t)2 * 512 * 256 * 2);
    p.wt_gate8 = (u16*)take((size_t)2 * 4096 * 1024);
    p.wt_in8 = (u16*)take((size_t)5888 * 1024);
    p.hctx = (float*)take((size_t)RC * 1024 * 4);
    const size_t off_hn = o;
    p.hn = (u16*)take((size_t)MT * 1024 * 2);
    p.y = (u16*)take((size_t)4 * MT * 512 * 2);
    p.arena = ws + o;
    const size_t arena_need = (size_t)MT * 2048 * 2 + (size_t)2 * MT * 512 * 4 + (size_t)2 * MT * 8 * 4 + 4096 + (size_t)MT * 512 * 2;
    size_t mo = off_hn;
    p.gch = (u16*)(ws + mo); mo = al256(mo + (size_t)136 * 256 * 3584);
    p.wt_m13 = (u16*)(ws + mo); mo = al256(mo + (size_t)8 * 7168 * 1024);
    p.wt_m2 = (u16*)(ws + mo); mo = al256(mo + (size_t)8 * 1024 * 3584);
    p.yb = (u16*)(ws + mo); mo = al256(mo + (size_t)67584 * 1024 * 2);
    p.xb8 = (u16*)(ws + mo); mo = al256(mo + (size_t)67584 * 1024);
    if (o + arena_need > ws_size || mo > ws_size) return;

    static int grid = 0;
    if (!grid) {
        int dev = 0, cus = 0, per_cu = 0;
        hipGetDevice(&dev);
        hipDeviceGetAttribute(&cus, hipDeviceAttributeMultiprocessorCount, dev);
        hipFuncSetAttribute((const void*)k_fwd, hipFuncAttributeMaxDynamicSharedMemorySize, LDS_BYTES);
        hipOccupancyMaxActiveBlocksPerMultiprocessor(&per_cu, k_fwd, NT, LDS_BYTES);
        grid = per_cu >= 1 ? cus : 0;
    }
    if (!grid) return;
    hipMemsetAsync(p.bar, 0, 16384, stream);
    hipMemsetAsync(p.wt_in, 0, (size_t)2 * 9984 * 1024 * 2, stream);
    hipMemsetAsync(p.wt_g, 0, (size_t)2 * 512 * 256 * 2, stream);
    if (FP8IN_LAST) hipMemsetAsync(p.wt_in8, 0, (size_t)5888 * 1024, stream);
    k_fwd<<<grid, NT, LDS_BYTES, stream>>>(p);
}
```

```cpp
#define REPMASK 0
#define FP8IN_LAST 0
#define RWREP 0
#include <hip/hip_runtime.h>
#include <stdint.h>
#include <string.h>

typedef unsigned short u16;
typedef short bf16x8 __attribute__((ext_vector_type(8)));
typedef float f32x4 __attribute__((ext_vector_type(4)));
typedef unsigned u32x4 __attribute__((ext_vector_type(4)));
typedef unsigned u32x2 __attribute__((ext_vector_type(2)));

#define NT 512
#define MT 36864
#define RC 4096
#define LDS_BYTES 163840
#define GC_N 7
#define SM_OFF 128

enum { I_x, I_c, I_ctx, I_c_ctx, I_ada_w, I_ada_b, I_norm_mix_g, I_norm_ffn_g, I_w_in, I_hy_conv_w, I_hy_conv_b, I_hy_f_w1, I_hy_f_b1, I_hy_f_w2, I_hy_f_b2,
       I_hy_f_w3, I_hy_f_b3, I_hy_bias, I_rw_mu, I_rw_w0, I_rw_w_up, I_rw_a0, I_rw_a_up, I_rw_g_up, I_rw_k_k, I_rw_k_a, I_rw_r_k, I_rw_ln_g, I_rw_ln_b,
       I_s5_a_re, I_s5_a_im, I_s5_log_dt, I_s5_b_re, I_s5_b_im, I_s5_c_re, I_s5_c_im, I_s5_d, I_s5_glu_w, I_s5_glu_b, I_gla_gate_up, I_gla_gate_b, I_gla_norm_g,
       I_w_branch, I_w_out, I_ffn_w1, I_ffn_w3, I_ffn_w2, I_moe_router_w, I_moe_router_b, I_moe_w1, I_moe_w3, I_moe_w2, I_final_norm_g, N_IN };

struct P {
    const float* in[N_IN];
    float* out;
    unsigned* bar;
    float* mod;
    u16* rvl;
    u16* rvc;
    int* moe_i;
    int* row_tok;
    int* dest_of;
    int* top_i;
    float* top_g;
    u16* wt_in;
    u16* wt_br;
    u16* wt_out;
    u16* wt_f13;
    u16* wt_f2;
    u16* wt_glu;
    u16* wt_g;
    u16* xr;
    u16* hn;
    u16* y;
    char* arena;
    u16* wt_m13;
    u16* wt_m2;
    u16* yb;
    u16* xb8;
    u16* wt_gate8;
    u16* wt_in8;
    u16* gch;
};

typedef const __attribute__((address_space(4))) P* PP;
#define PREF asm volatile("" : "+s"(pp)); const __attribute__((address_space(4))) P& p = *pp; extern __shared__ __attribute__((aligned(16))) char smem_raw[]; char* smem = smem_raw + SM_OFF; (void)smem; const int tix = ltid(); (void)tix
__device__ __forceinline__ int ltid() { int t = threadIdx.x; asm volatile("" : "+v"(t)); return t; }
__device__ __forceinline__ int uni(int v) { return __builtin_amdgcn_readfirstlane(v); }
__device__ __forceinline__ float bf2f(u16 b) { return __uint_as_float(((unsigned)b) << 16); }

#define RLXA __ATOMIC_RELAXED, __HIP_MEMORY_SCOPE_AGENT
#ifndef COH
#define COH 0
#endif
#if COH
__device__ __forceinline__ unsigned ldc_u32(const void* q) { return __hip_atomic_load((unsigned*)q, RLXA); }
__device__ __forceinline__ unsigned long long ldc_u64(const void* q) { return __hip_atomic_load((unsigned long long*)q, RLXA); }
__device__ __forceinline__ float ldc_f32(const void* q) { return __uint_as_float(ldc_u32(q)); }
__device__ __forceinline__ u32x2 ldc_8(const void* q) { const unsigned long long v = ldc_u64(q); u32x2 r; r.x = (unsigned)v; r.y = (unsigned)(v >> 32); return r; }
__device__ __forceinline__ u32x4 ldc_16(const void* q) { const unsigned long long a = ldc_u64(q), b = ldc_u64((const char*)q + 8); u32x4 r; r.x = (unsigned)a; r.y = (unsigned)(a >> 32); r.z = (unsigned)b; r.w = (unsigned)(b >> 32); return r; }
__device__ __forceinline__ f32x4 ldc_f4(const void* q) { const u32x4 v = ldc_16(q); return (f32x4){__uint_as_float(v.x), __uint_as_float(v.y), __uint_as_float(v.z), __uint_as_float(v.w)}; }
__device__ __forceinline__ void stc_u32(void* q, unsigned v) { __hip_atomic_store((unsigned*)q, v, RLXA); }
__device__ __forceinline__ void stc_f32(void* q, float v) { __hip_atomic_store((unsigned*)q, __float_as_uint(v), RLXA); }
__device__ __forceinline__ void stc_8(void* q, u32x2 v) { __hip_atomic_store((unsigned long long*)q, ((unsigned long long)v.y << 32) | v.x, RLXA); }
__device__ __forceinline__ void stc_16(void* q, u32x4 v) { __hip_atomic_store((unsigned long long*)q, ((unsigned long long)v.y << 32) | v.x, RLXA); __hip_atomic_store((unsigned long long*)q + 1, ((unsigned long long)v.w << 32) | v.z, RLXA); }
__device__ __forceinline__ void stc_u16(void* q, u16 v) { __hip_atomic_store((unsigned short*)q, v, RLXA); }
__device__ __forceinline__ void stc_f4(void* q, f32x4 v) { stc_16(q, (u32x4){__float_as_uint(v[0]), __float_as_uint(v[1]), __float_as_uint(v[2]), __float_as_uint(v[3])}); }
__device__ __forceinline__ float ldc_bf(const u16* q) { const unsigned w = ldc_u32((const void*)((size_t)q & ~(size_t)3)); return ((size_t)q & 2) ? __uint_as_float(w & 0xffff0000u) : __uint_as_float(w << 16); }
#define SC1_AUX 16
#else
__device__ __forceinline__ unsigned ldc_u32(const void* q) { return *(const unsigned*)q; }
__device__ __forceinline__ float ldc_f32(const void* q) { return *(const float*)q; }
__device__ __forceinline__ u32x2 ldc_8(const void* q) { return *(const u32x2*)q; }
__device__ __forceinline__ u32x4 ldc_16(const void* q) { return *(const u32x4*)q; }
__device__ __forceinline__ f32x4 ldc_f4(const void* q) { return *(const f32x4*)q; }
__device__ __forceinline__ void stc_u32(void* q, unsigned v) { *(unsigned*)q = v; }
__device__ __forceinline__ void stc_f32(void* q, float v) { *(float*)q = v; }
__device__ __forceinline__ void stc_8(void* q, u32x2 v) { *(u32x2*)q = v; }
__device__ __forceinline__ void stc_16(void* q, u32x4 v) { *(u32x4*)q = v; }
__device__ __forceinline__ void stc_u16(void* q, u16 v) { *(u16*)q = v; }
__device__ __forceinline__ void stc_f4(void* q, f32x4 v) { *(f32x4*)q = v; }
__device__ __forceinline__ float ldc_bf(const u16* q) { return __uint_as_float(((unsigned)*q) << 16); }
#define SC1_AUX 0
#endif
typedef __bf16 bf16x2_t __attribute__((ext_vector_type(2)));
typedef float f32x2_t __attribute__((ext_vector_type(2)));
__device__ __forceinline__ unsigned pk2(float lo, float hi) { const f32x2_t v = {lo, hi}; return __builtin_bit_cast(unsigned, __builtin_convertvector(v, bf16x2_t)); }
__device__ __forceinline__ u16 f2bf(float f) { return (u16)(pk2(f, 0.f) & 0xffffu); }
__device__ __forceinline__ float fexp(float x) { return __builtin_amdgcn_exp2f(x * 1.4426950408889634f); }
__device__ __forceinline__ float frcp(float x) { return __builtin_amdgcn_rcpf(x); }
__device__ __forceinline__ float sigm(float x) { return frcp(1.f + fexp(-x)); }
__device__ __forceinline__ float ftanh(float x) { return 1.f - 2.f * frcp(1.f + fexp(2.f * x)); }
template <int CTRL> __device__ __forceinline__ float dppf(float v) { return __int_as_float(__builtin_amdgcn_update_dpp(0, __float_as_int(v), CTRL, 0xF, 0xF, true)); }
__device__ __forceinline__ float rowsum16(float v) { v += dppf<0xB1>(v); v += dppf<0x4E>(v); v += dppf<0x141>(v); v += dppf<0x140>(v); return v; }
__device__ __forceinline__ float rdl(float v, int l) { return __int_as_float(__builtin_amdgcn_readlane(__float_as_int(v), l)); }
__device__ __forceinline__ float wsum(float v) { v = rowsum16(v); return (rdl(v, 0) + rdl(v, 16)) + (rdl(v, 32) + rdl(v, 48)); }

__device__ __forceinline__ void unpack8(const u32x4 w, float (&o)[8]) { o[0] = __uint_as_float(w.x << 16); o[1] = __uint_as_float(w.x & 0xffff0000u); o[2] = __uint_as_float(w.y << 16); o[3] = __uint_as_float(w.y & 0xffff0000u);
    o[4] = __uint_as_float(w.z << 16); o[5] = __uint_as_float(w.z & 0xffff0000u); o[6] = __uint_as_float(w.w << 16); o[7] = __uint_as_float(w.w & 0xffff0000u); }
__device__ __forceinline__ u32x4 pack8(const float (&o)[8]) { u32x4 w; w.x = pk2(o[0], o[1]); w.y = pk2(o[2], o[3]); w.z = pk2(o[4], o[5]); w.w = pk2(o[6], o[7]); return w; }
__device__ __forceinline__ unsigned pk4_fp8(float a, float b, float c, float d) {
    a = fminf(fmaxf(a, -448.f), 448.f); b = fminf(fmaxf(b, -448.f), 448.f); c = fminf(fmaxf(c, -448.f), 448.f); d = fminf(fmaxf(d, -448.f), 448.f);
    const unsigned w = __builtin_amdgcn_cvt_pk_fp8_f32(a, b, 0, false); return __builtin_amdgcn_cvt_pk_fp8_f32(c, d, w, true); }
__device__ __forceinline__ u32x2 pk4bf(const f32x4 v) { u32x2 w; w.x = pk2(v[0], v[1]); w.y = pk2(v[2], v[3]); return w; }
__device__ __forceinline__ void ld8bf(const u16* q, f32x4& lo, f32x4& hi) { float t[8]; unpack8(ldc_16(q), t); lo = (f32x4){t[0], t[1], t[2], t[3]}; hi = (f32x4){t[4], t[5], t[6], t[7]}; }
__device__ __forceinline__ float sum8lanes(float v) { v += dppf<0xB1>(v); v += dppf<0x4E>(v); v += dppf<0x141>(v); return v; }
__device__ __forceinline__ int mrow_of(int row) { return row < RC ? 16 : ((row - RC) >> 11); }
#define LDSWAIT() asm volatile("s_waitcnt lgkmcnt(0)" ::: "memory")

#define XB_TMO      128
#define XB_XCNT(j)  (256  + 64 * (j))
#define XB_XSUB(j)  (1280 + 64 * (j))
#define XB_XGEN(j)  (2304 + 64 * (j))
#define XB_TOP      3328
#define XB_TOPGEN   3392
#define XCD_BAR_WORDS 3456
#define XB_SPIN_CAP (1u << 18)
#define LAS __attribute__((address_space(3)))

__device__ __forceinline__ unsigned xb_ld(unsigned* p)              { return __hip_atomic_load(p, __ATOMIC_RELAXED, __HIP_MEMORY_SCOPE_AGENT); }
__device__ __forceinline__ unsigned xb_add(unsigned* p, unsigned v) { return __hip_atomic_fetch_add(p, v, __ATOMIC_RELAXED, __HIP_MEMORY_SCOPE_AGENT); }
__device__ __forceinline__ unsigned xb_xcc_id() { return (unsigned)__builtin_amdgcn_s_getreg((3 << 11) | 20) & 0xFu; }
#define XB_SPIN(cond, bar) do { unsigned _sp = 0; while (cond) { __builtin_amdgcn_s_sleep(1); \
    if ((++_sp & 255u) == 0u) { if (xb_ld(&(bar)[XB_TMO])) break; if (_sp > XB_SPIN_CAP) { atomicAdd(&(bar)[XB_TMO], 1u); break; } } } } while (0)

struct XcdBarrier {
    unsigned* bar; unsigned x;
    volatile LAS unsigned* st;
};

__device__ __forceinline__ XcdBarrier xcd_barrier_post(unsigned* bar, volatile LAS unsigned* st) {
    XcdBarrier b; b.bar = bar; b.x = xb_xcc_id(); b.st = st;
    if (threadIdx.x == 0) (void)xb_add(&bar[XB_XCNT(b.x)], 1u);
    return b;
}
__device__ __forceinline__ void xcd_barrier_complete(unsigned* bar, unsigned x, unsigned& nloc, unsigned& nx) {
    const unsigned G = gridDim.x * gridDim.y * gridDim.z;
    unsigned sum, cnt, mine, sp = 0u;
    for (;;) {
        sum = 0u; cnt = 0u; mine = 0u;
#pragma unroll
        for (unsigned j = 0; j < 16; ++j) { const unsigned c = xb_ld(&bar[XB_XCNT(j)]); sum += c; cnt += (c > 0u) ? 1u : 0u; mine = (j == x) ? c : mine; }
        if (sum == G) break;
        __builtin_amdgcn_s_sleep(1);
        if ((++sp & 255u) == 0u) { if (xb_ld(&bar[XB_TMO])) break; if (sp > XB_SPIN_CAP) { atomicAdd(&bar[XB_TMO], 1u); break; } }
    }
    nloc = mine > 0u ? mine : 1u; nx = cnt > 0u ? cnt : 1u;
}

__device__ __forceinline__ void xcd_barrier(const XcdBarrier& b) {
    asm volatile("s_waitcnt vmcnt(0)" ::: "memory");
    __syncthreads();
    if (threadIdx.x == 0) {
        unsigned* bar = b.bar; unsigned bx = b.x; asm volatile("" : "+s"(bar), "+s"(bx));
        __builtin_amdgcn_s_waitcnt(0);
        unsigned nloc = b.st[0], nx = b.st[1];
        if (nloc == 0u) { xcd_barrier_complete(bar, bx, nloc, nx); b.st[0] = nloc; b.st[1] = nx; }
        const unsigned old = xb_add(&bar[XB_XSUB(bx)], 1u);
        const unsigned gen = old / nloc;
        if (old + 1u == (gen + 1u) * nloc) {
            __builtin_amdgcn_fence(__ATOMIC_RELEASE, "agent");
            asm volatile("s_waitcnt vmcnt(0)" ::: "memory");
            const unsigned og = xb_add(&bar[XB_TOP], 1u);
            const unsigned tg = og / nx;
            if (og + 1u == (tg + 1u) * nx) xb_add(&bar[XB_TOPGEN], 1u);
            else XB_SPIN(xb_ld(&bar[XB_TOPGEN]) == tg, bar);
            __builtin_amdgcn_fence(__ATOMIC_ACQUIRE, "agent");
            xb_add(&bar[XB_XGEN(bx)], 1u);
            asm volatile("s_waitcnt vmcnt(0)" ::: "memory");
        } else {
            XB_SPIN(xb_ld(&bar[XB_XGEN(bx)]) == gen, bar);
            __builtin_amdgcn_fence(__ATOMIC_ACQUIRE, "agent");
            asm volatile("s_waitcnt vmcnt(0)" ::: "memory");
        }
    }
    __syncthreads();
}

__device__ __forceinline__ void do_transpose(const float* src, int K, int N, long ldsrc, u16* dst, int G, int GS, int off, char* smem, int f8 = 0, int* rot_ = nullptr) {
    const int tix = ltid();
    float (*t)[64][65] = (float (*)[64][65])smem;
    const int tk = K / 256, tn = (N + 63) / 64;
    const int sn = tix >> 3, sk = (tix & 7) * 8;
    const int rot = rot_ ? *rot_ : 0, g = (int)gridDim.x;
    int u0 = (int)blockIdx.x - rot; if (u0 < 0) u0 += g;
    for (int u = u0; u < tk * tn; u += g) {
        const int k0 = (u % tk) * 256, n0 = (u / tk) * 64;
        f32x4 v[8];
#pragma unroll
        for (int q2 = 0; q2 < 8; ++q2) { const int q = tix + (q2 & 1) * NT, i = (q2 >> 1) * 64 + (q >> 4), c4 = (q & 15) * 4, n = n0 + c4;
            v[q2] = (f32x4){0.f, 0.f, 0.f, 0.f};
            if (n < N) v[q2] = *(const f32x4*)(src + (long)(k0 + i) * ldsrc + n); }
        __syncthreads();
#pragma unroll
        for (int q2 = 0; q2 < 8; ++q2) { const int q = tix + (q2 & 1) * NT, i = q >> 4, c4 = (q & 15) * 4; float* tp = &t[q2 >> 1][i][c4];
            tp[0] = v[q2][0]; tp[1] = v[q2][1]; tp[2] = v[q2][2]; tp[3] = v[q2][3]; }
        __syncthreads();
        { const int n = n0 + sn;
          if (n < N) { const long dr = (long)(n / G) * GS + (n % G) + off;
#pragma unroll
              for (int j = 0; j < 4; ++j) { float o[8];
#pragma unroll
                  for (int e = 0; e < 8; ++e) o[e] = t[j][sk + e][sn];
                  if (f8) { u32x2 w8; w8.x = pk4_fp8(o[0] * 32.f, o[1] * 32.f, o[2] * 32.f, o[3] * 32.f); w8.y = pk4_fp8(o[4] * 32.f, o[5] * 32.f, o[6] * 32.f, o[7] * 32.f); *(u32x2*)((char*)dst + dr * K + k0 + j * 64 + sk) = w8; }
                  else *(u32x4*)(dst + dr * K + k0 + j * 64 + sk) = pack8(o); } } }
    }
    if (rot_) *rot_ = (rot + tk * tn) % g;
}

__device__ __forceinline__ void ph_mod(PP pp) {
    PREF;
    float* s = (float*)smem; float* red = s + 17 * 1024;
    const int G = (int)gridDim.x, bsh = (int)((blockIdx.x + 64u) % gridDim.x);
    if (bsh >= 192) return;
    for (int i = tix; i < 17 * 1024; i += NT) { const int r = i >> 10, k = i & 1023; const float v = r < 16 ? p.in[I_c][r * 1024 + k] : p.in[I_c_ctx][k]; s[i] = v / (1.f + expf(-v)); }
    __syncthreads();
    const int j = tix & 63, kq = tix >> 6;
    for (int u = bsh; u < 192; u += G) {
        const int l = u / 96, jc = (u % 96) * 64;
        float acc[17];
#pragma unroll
        for (int r = 0; r < 17; ++r) acc[r] = 0.f;
        const float* w = p.in[I_ada_w] + ((size_t)l * 1024 + kq * 128) * 6144 + jc + j;
#pragma unroll 8
        for (int k = 0; k < 128; ++k) { const float wv = w[(size_t)k * 6144];
#pragma unroll
            for (int r = 0; r < 17; ++r) acc[r] += s[r * 1024 + kq * 128 + k] * wv; }
        __syncthreads();
#pragma unroll
        for (int r = 0; r < 17; ++r) red[(kq * 17 + r) * 64 + j] = acc[r];
        __syncthreads();
        for (int o = tix; o < 17 * 64; o += NT) { const int r = o >> 6, jj = o & 63; float a = p.in[I_ada_b][l * 6144 + jc + jj];
#pragma unroll
            for (int q = 0; q < 8; ++q) a += red[(q * 17 + r) * 64 + jj];
            p.mod[(size_t)(l * 17 + r) * 6144 + jc + jj] = a; }
    }
}

__device__ __forceinline__ void ph_filt(PP pp) {
    PREF;
    float* z = (float*)smem; float* h1 = z + 65 * 36; float* h2 = h1 + 65 * 64; u16* tile = (u16*)(h2 + 65 * 64);
    const int tid = tix, wid = tid >> 6, lane = tid & 63;
    const int G = (int)gridDim.x;
    for (int u = (int)((blockIdx.x + 128u) % gridDim.x); u < 288; u += G) {
        const int l = u / 144, r = (u % 144) >> 2, cq = u & 3;
        const int L = r < 4 ? 256 : 2048, k = r < 4 ? r : r - 4;
        __syncthreads();
        for (int idx = tid; idx < 65 * 17; idx += NT) { const int pj = idx / 17, i = idx - pj * 17; const int pos = 64 * k + pj;
            if (i == 16) z[pj * 36] = (float)pos / (float)(L - 1);
            else { const float fr = 1e-4f + (float)i * ((15.f - 1e-4f) / 15.f); const float ang = (6.283185307179586f / (float)L) * (float)pos * fr; z[pj * 36 + 1 + i] = cosf(ang); z[pj * 36 + 17 + i] = -sinf(ang); } }
        __syncthreads();
        for (int idx = tid; idx < 65 * 64; idx += NT) { const int pj = idx >> 6, uu = idx & 63; float a = p.in[I_hy_f_b1][l * 64 + uu];
            for (int i = 0; i < 33; ++i) a += z[pj * 36 + i] * p.in[I_hy_f_w1][(l * 33 + i) * 64 + uu];
            h1[idx] = sinf(a); }
        __syncthreads();
        for (int idx = tid; idx < 65 * 64; idx += NT) { const int pj = idx >> 6, uu = idx & 63; float a = p.in[I_hy_f_b2][l * 64 + uu];
            for (int i = 0; i < 64; ++i) a += h1[pj * 64 + i] * p.in[I_hy_f_w2][(l * 64 + i) * 64 + uu];
            h2[idx] = sinf(a); }
        __syncthreads();
        {
            const int c = tid & 255, ph = tid >> 8, cg = (c < 128 ? 0 : 512) + cq * 128 + (c & 127);
            float wc[64];
#pragma unroll
            for (int i = 0; i < 64; ++i) wc[i] = p.in[I_hy_f_w3][(l * 64 + i) * 1024 + cg];
            const float b3 = p.in[I_hy_f_b3][l * 1024 + cg];
            const float ra = 3.0701134573f, rb = 15.3505672867f;
            const float rate = ra + (float)(cg & 511) * ((rb - ra) / 511.f);
            const float bias0 = cg < 512 ? p.in[I_hy_bias][l * 512 + cg] : 0.f;
            for (int pj = ph * 33; pj < (ph ? 65 : 33); ++pj) {
                const int pos = 64 * k + pj; const float t = (float)pos / (float)(L - 1);
                float a = b3;
#pragma unroll
                for (int i4 = 0; i4 < 16; ++i4) { const f32x4 hv = *(const f32x4*)(h2 + pj * 64 + i4 * 4); a += hv[0] * wc[i4 * 4] + hv[1] * wc[i4 * 4 + 1] + hv[2] * wc[i4 * 4 + 2] + hv[3] * wc[i4 * 4 + 3]; }
                float val = a * expf(-t * rate);
                if (pos == 0) val += bias0;
                if (pos >= L) val = 0.f;
                tile[c * 66 + pj] = f2bf(val);
            }
        }
        __syncthreads();
        u16* rv = L == 2048 ? p.rvl + (size_t)l * 512 * 4096 : p.rvc + (size_t)l * 512 * 512;
        for (int cl = wid; cl < 128; cl += 8) {
            u16* row = rv + (size_t)(cq * 128 + cl) * (2 * L);
            row[L - 64 * k - 64 + lane] = tile[cl * 66 + 64 - lane];
            row[L + 64 * k + lane] = (k == 0 && lane == 0) ? tile[cl * 66] : tile[(128 + cl) * 66 + lane];
        }
    }
}

#define HN8(p) ((char*)(p).arena + (size_t)MT * 8256 + 4096)
__device__ __forceinline__ void ph_norm(PP pp, int l, int which, int r0, int r1, int first, int router, int f8) {
    PREF; l = uni(l); which = uni(which); r0 = uni(r0); r1 = uni(r1); first = uni(first); router = uni(router); f8 = uni(f8);
    const int wid = tix >> 6, lane = tix & 63;
    const float* g = p.in[which ? I_norm_ffn_g : I_norm_mix_g] + l * 1024;
    const int shoff = which ? 3072 : 0, scoff = which ? 4096 : 1024;
    LAS int* lc = (LAS int*)smem;
    float* rwT = (float*)smem + 64;
    if (router) { __syncthreads(); if (tix < 8) lc[tix] = 0;
        for (int i = tix; i < 8192; i += NT) rwT[(i & 7) * 1024 + (i >> 3)] = p.in[I_moe_router_w][i];
        __syncthreads(); }
    for (int row = r0 + blockIdx.x * 8 + wid; row < r1; row += gridDim.x * 8) {
        const float* src = row < RC ? (p.in[I_ctx] + (size_t)row * 1024) : (p.in[I_x] + (size_t)(row - RC) * 1024);
        const float* md = p.mod + (size_t)(l * 17 + mrow_of(row)) * 6144;
        f32x4 v[4]; float ss = 0.f;
#pragma unroll
        for (int i = 0; i < 4; ++i) {
            if (first) v[i] = ldc_f4(src + i * 256 + lane * 4);
            else { const u32x2 w = ldc_8(p.xr + (size_t)row * 1024 + i * 256 + lane * 4); v[i] = (f32x4){__uint_as_float(w.x << 16), __uint_as_float(w.x & 0xffff0000u), __uint_as_float(w.y << 16), __uint_as_float(w.y & 0xffff0000u)}; }
            ss += v[i][0] * v[i][0] + v[i][1] * v[i][1] + v[i][2] * v[i][2] + v[i][3] * v[i][3]; }
        ss = wsum(ss);
        const float rs = rsqrtf(ss * (1.f / 1024.f) + 1e-6f);
        float lg[8];
#pragma unroll
        for (int e = 0; e < 8; ++e) lg[e] = 0.f;
        f32x4 gg4[4], sc4[4], sh4[4];
#pragma unroll
        for (int i = 0; i < 4; ++i) { const int k = i * 256 + lane * 4; gg4[i] = *(const f32x4*)(g + k); sc4[i] = *(const f32x4*)(md + scoff + k); sh4[i] = *(const f32x4*)(md + shoff + k); }
#pragma unroll
        for (int i = 0; i < 4; ++i) {
            const int k = i * 256 + lane * 4;
            const f32x4 gg = gg4[i], sc = sc4[i], sh = sh4[i];
            f32x4 o;
#pragma unroll
            for (int j = 0; j < 4; ++j) o[j] = v[i][j] * rs * gg[j] * (1.f + sc[j]) + sh[j];
            if (f8) stc_u32((char*)p.hn + (size_t)row * 1024 + k, pk4_fp8(o[0], o[1], o[2], o[3]));
            else { u32x2 w; w.x = pk2(o[0], o[1]); w.y = pk2(o[2], o[3]); stc_8(p.hn + (size_t)row * 1024 + k, w);
                   if (!which) stc_u32(HN8(p) + (size_t)row * 1024 + k, pk4_fp8(o[0], o[1], o[2], o[3])); }
            if (router) {
#pragma unroll
                for (int e = 0; e < 8; ++e) { const f32x4 wv = *(const f32x4*)(rwT + e * 1024 + k); lg[e] += (o[0] * wv[0] + o[1] * wv[1]) + (o[2] * wv[2] + o[3] * wv[3]); }
            }
        }
        if (router) {
#pragma unroll
            for (int e = 0; e < 8; ++e) lg[e] = wsum(lg[e]) + p.in[I_moe_router_b][e];
            if (lane == 0) {
                int i0 = 0; float v0 = lg[0];
#pragma unroll
                for (int e = 1; e < 8; ++e) if (lg[e] > v0) { v0 = lg[e]; i0 = e; }
                int i1 = -1; float v1 = -3.4e38f;
#pragma unroll
                for (int e = 0; e < 8; ++e) if (e != i0 && lg[e] > v1) { v1 = lg[e]; i1 = e; }
                const float e1 = expf(v1 - v0), g0 = 1.f / (1.f + e1), g1 = e1 / (1.f + e1);
                const int tok = row - RC;
                stc_u32(p.top_i + tok * 2, (unsigned)i0); stc_u32(p.top_i + tok * 2 + 1, (unsigned)i1); stc_f32(p.top_g + tok * 2, g0); stc_f32(p.top_g + tok * 2 + 1, g1);
                const int k0 = __hip_atomic_fetch_add(lc + i0, 1, __ATOMIC_RELAXED, __HIP_MEMORY_SCOPE_WORKGROUP), k1 = __hip_atomic_fetch_add(lc + i1, 1, __ATOMIC_RELAXED, __HIP_MEMORY_SCOPE_WORKGROUP);
                stc_u32(p.row_tok + tok * 2, (unsigned)k0); stc_u32(p.row_tok + tok * 2 + 1, (unsigned)k1);
            }
        }
    }
    if (router) { __syncthreads(); if (tix < 8) stc_u32(p.moe_i + 1024 + blockIdx.x * 8 + tix, (unsigned)lc[tix]); }
}

typedef f32x4 Acc[2][2][4][2];
__device__ __forceinline__ int perm32(int rho) { const int n = rho >> 4, i = rho & 15; return 8 * (i >> 2) + 4 * n + (i & 3); }

template <class Pr>
__device__ __forceinline__ void gemm_v1(const Pr& pr, char* smem) {
    const int tid = ltid(), wid = tid >> 6, lane = tid & 63, wr = wid >> 2, wc = wid & 3, fr = lane & 15, fq = lane >> 4;
    u16* sA = (u16*)smem; u16* sB = sA + 256 * 40;
    const int nu = pr.num_units();
    const int kp = (tid & 3) * 8;
    for (int u = blockIdx.x; u < nu; u += gridDim.x) {
        int pm, pn; if (!pr.unit(u, pm, pn)) continue;
        const u16* arow[2]; const u16* brow[2];
#pragma unroll
        for (int i = 0; i < 2; ++i) { const int row = (tid + i * 512) >> 2; arow[i] = pr.a_row(pm, row); brow[i] = pr.b_row(pm, pn, (row & ~31) + perm32(row & 31)); }
        Acc acc;
#pragma unroll
        for (int a = 0; a < 2; ++a)
#pragma unroll
            for (int b = 0; b < 2; ++b)
#pragma unroll
                for (int m = 0; m < 4; ++m)
#pragma unroll
                    for (int n = 0; n < 2; ++n) acc[a][b][m][n] = (f32x4){0.f, 0.f, 0.f, 0.f};
        const int K = pr.K();
        for (int k0 = 0; k0 < K; k0 += 32) {
            u32x4 ra[2], rb[2];
#pragma unroll
            for (int i = 0; i < 2; ++i) { ra[i] = arow[i] ? *(const u32x4*)(arow[i] + k0 + kp) : (u32x4){0u, 0u, 0u, 0u}; rb[i] = *(const u32x4*)(brow[i] + k0 + kp); }
            __syncthreads();
#pragma unroll
            for (int i = 0; i < 2; ++i) { const int row = (tid + i * 512) >> 2; *(u32x4*)(sA + row * 40 + kp) = ra[i]; *(u32x4*)(sB + row * 40 + kp) = rb[i]; }
            __syncthreads();
            bf16x8 af[2][4], bf[2][2];
#pragma unroll
            for (int a = 0; a < 2; ++a)
#pragma unroll
                for (int m = 0; m < 4; ++m) af[a][m] = *(const bf16x8*)(sA + (a * 128 + wr * 64 + m * 16 + fr) * 40 + fq * 8);
#pragma unroll
            for (int b = 0; b < 2; ++b)
#pragma unroll
                for (int n = 0; n < 2; ++n) bf[b][n] = *(const bf16x8*)(sB + (b * 128 + wc * 32 + n * 16 + fr) * 40 + fq * 8);
#pragma unroll
            for (int a = 0; a < 2; ++a)
#pragma unroll
                for (int b = 0; b < 2; ++b)
#pragma unroll
                    for (int m = 0; m < 4; ++m)
#pragma unroll
                        for (int n = 0; n < 2; ++n) acc[a][b][m][n] = __builtin_amdgcn_mfma_f32_16x16x32_bf16(bf[b][n], af[a][m], acc[a][b][m][n], 0, 0, 0);
        }
        pr.epi(acc, pm, pn, wr, wc, fr, fq);
    }
}

struct GPb {
    const u16* A; long lda; const u16* Bt; long ldb; int Kd; int tm0, ntm, ntn;
    __device__ int num_units() const { return ntm * ntn; }
    __device__ bool unit(int u, int& pm, int& pn) const { pm = tm0 + u / ntn; pn = u % ntn; return true; }
    __device__ const u16* a_row(int pm, int r) const { return A + (size_t)(pm * 256 + r) * lda; }
    __device__ const u16* b_row(int pm, int pn, int r) const { return Bt + (size_t)(pn * 256 + r) * ldb; }
    __device__ int K() const { return Kd; }
};
struct PrStore : GPb { u16* O; long ldo; int act; int pad_;
    __device__ void epi(Acc& acc, int pm, int pn, int wr, int wc, int fr, int fq) const {
#pragma unroll
        for (int a = 0; a < 2; ++a)
#pragma unroll
            for (int m = 0; m < 4; ++m) { const size_t row = (size_t)pm * 256 + a * 128 + wr * 64 + m * 16 + fr;
#pragma unroll
                for (int b = 0; b < 2; ++b) { const int col = pn * 256 + b * 128 + wc * 32 + fq * 8; f32x4 v0 = acc[a][b][m][0], v1 = acc[a][b][m][1];
                    if (act == 1) {
#pragma unroll
                        for (int j = 0; j < 4; ++j) { v0[j] = sigm(v0[j]); v1[j] = sigm(v1[j]); } }
                    u32x4 w; w.x = pk2(v0[0], v0[1]); w.y = pk2(v0[2], v0[3]); w.z = pk2(v1[0], v1[1]); w.w = pk2(v1[2], v1[3]);
                    stc_16(O + row * ldo + col, w); } }
    }
};
struct PrGate : GPb { u16* O;
    __device__ void epi(Acc& acc, int pm, int pn, int wr, int wc, int fr, int fq) const {
        char* tb = (char*)O + (size_t)(pm * 16 + pn) * 65536 + (unsigned)(((wr * 4 + wc) * 64 + fq * 16 + fr) * 8);
#pragma unroll
        for (int a = 0; a < 2; ++a)
#pragma unroll
            for (int m = 0; m < 4; ++m)
#pragma unroll
                for (int b = 0; b < 2; ++b) { const f32x4 v0 = acc[a][b][m][0], v1 = acc[a][b][m][1];
                    unsigned q[8];
#pragma unroll
                    for (int j = 0; j < 4; ++j) { q[j] = min((unsigned)(sigm(v0[j]) * 256.f), 255u); q[4 + j] = min((unsigned)(sigm(v1[j]) * 256.f), 255u); }
                    u32x2 w; w.x = q[0] | (q[1] << 8) | (q[2] << 16) | (q[3] << 24); w.y = q[4] | (q[5] << 8) | (q[6] << 16) | (q[7] << 24);
                    stc_8(tb + ((a * 4 + m) * 2 + b) * 4096, w); }
    }
};
struct PrBranch : GPb { const u16* g; float* ACC; u16* accb; int mi; float scale;
    __device__ void epi(Acc& acc, int pm, int pn, int wr, int wc, int fr, int fq) const {
#pragma unroll
        for (int a = 0; a < 2; ++a)
#pragma unroll
            for (int m = 0; m < 4; ++m) { const size_t row = (size_t)pm * 256 + a * 128 + wr * 64 + m * 16 + fr;
#pragma unroll
                for (int b = 0; b < 2; ++b) { const int col = pn * 256 + b * 128 + wc * 32 + fq * 8;
                    const u32x4 gw = ldc_16(g + row * 1024 + col);
                    float gv[8]; gv[0] = __uint_as_float(gw.x << 16); gv[1] = __uint_as_float(gw.x & 0xffff0000u); gv[2] = __uint_as_float(gw.y << 16); gv[3] = __uint_as_float(gw.y & 0xffff0000u);
                    gv[4] = __uint_as_float(gw.z << 16); gv[5] = __uint_as_float(gw.z & 0xffff0000u); gv[6] = __uint_as_float(gw.w << 16); gv[7] = __uint_as_float(gw.w & 0xffff0000u);
                    float* ap = ACC + row * 1024 + col;
                    f32x4 o0, o1;
                    if (mi == 0) { o0 = (f32x4){0.f, 0.f, 0.f, 0.f}; o1 = o0; } else { o0 = ldc_f4(ap); o1 = ldc_f4(ap + 4); }
#pragma unroll
                    for (int j = 0; j < 4; ++j) { o0[j] += scale * gv[j] * acc[a][b][m][0][j]; o1[j] += scale * gv[4 + j] * acc[a][b][m][1][j]; }
                    if (mi == 3) { u32x4 w; w.x = pk2(o0[0], o0[1]); w.y = pk2(o0[2], o0[3]); w.z = pk2(o1[0], o1[1]); w.w = pk2(o1[2], o1[3]); stc_16(accb + row * 1024 + col, w); }
                    else { stc_f4(ap, o0); stc_f4(ap + 4, o1); } } }
    }
};
struct PrResid : GPb { const float* oc; const float* ol; u16* xr; const float* mod; int goff; float scale; int first; int pad2_;
    __device__ void epi(Acc& acc, int pm, int pn, int wr, int wc, int fr, int fq) const {
        const float* gt = mod + (size_t)mrow_of(pm * 256) * 6144 + goff;
#pragma unroll
        for (int a = 0; a < 2; ++a)
#pragma unroll
            for (int m = 0; m < 4; ++m) { const int row = pm * 256 + a * 128 + wr * 64 + m * 16 + fr;
                const float* op = row < RC ? oc + (size_t)row * 1024 : ol + (size_t)(row - RC) * 1024;
                u16* np = xr + (size_t)row * 1024;
#pragma unroll
                for (int b = 0; b < 2; ++b) { const int col = pn * 256 + b * 128 + wc * 32 + fq * 8;
                    float o[8];
                    if (first) { const f32x4 o0 = ldc_f4(op + col), o1 = ldc_f4(op + col + 4);
#pragma unroll
                        for (int j = 0; j < 4; ++j) { o[j] = o0[j]; o[4 + j] = o1[j]; } }
                    else unpack8(ldc_16(np + col), o);
                    const f32x4 g0 = *(const f32x4*)(gt + col), g1 = *(const f32x4*)(gt + col + 4);
#pragma unroll
                    for (int j = 0; j < 4; ++j) { o[j] += scale * g0[j] * acc[a][b][m][0][j]; o[4 + j] += scale * g1[j] * acc[a][b][m][1][j]; }
                    stc_16(np + col, pack8(o)); } }
    }
};
struct PrSwiglu : GPb { u16* G; long ldg;
    __device__ void epi(Acc& acc, int pm, int pn, int wr, int wc, int fr, int fq) const {
#pragma unroll
        for (int a = 0; a < 2; ++a)
#pragma unroll
            for (int m = 0; m < 4; ++m) { const size_t row = (size_t)pm * 256 + a * 128 + wr * 64 + m * 16 + fr; const int col = pn * 128 + wc * 32 + fq * 8;
                float o[8];
#pragma unroll
                for (int n = 0; n < 2; ++n)
#pragma unroll
                    for (int j = 0; j < 4; ++j) { const float x = acc[a][0][m][n][j]; o[n * 4 + j] = x * sigm(x) * acc[a][1][m][n][j]; }
                stc_16(G + row * ldg + col, pack8(o)); }
    }
};
struct PrGlu : GPb { const u16* ya; const float* gb; u16* O;
    __device__ void epi(Acc& acc, int pm, int pn, int wr, int wc, int fr, int fq) const {
#pragma unroll
        for (int a = 0; a < 2; ++a)
#pragma unroll
            for (int m = 0; m < 4; ++m) { const size_t row = (size_t)pm * 256 + a * 128 + wr * 64 + m * 16 + fr;
#pragma unroll
                for (int b = 0; b < 2; ++b) { const int col = pn * 256 + b * 128 + wc * 32 + fq * 8;
                    const u32x4 yw = ldc_16(ya + row * 512 + col);
                    float yv[8]; yv[0] = __uint_as_float(yw.x << 16); yv[1] = __uint_as_float(yw.x & 0xffff0000u); yv[2] = __uint_as_float(yw.y << 16); yv[3] = __uint_as_float(yw.y & 0xffff0000u);
                    yv[4] = __uint_as_float(yw.z << 16); yv[5] = __uint_as_float(yw.z & 0xffff0000u); yv[6] = __uint_as_float(yw.w << 16); yv[7] = __uint_as_float(yw.w & 0xffff0000u);
                    float o[8];
#pragma unroll
                    for (int n = 0; n < 2; ++n)
#pragma unroll
                        for (int j = 0; j < 4; ++j) o[n * 4 + j] = yv[n * 4 + j] * sigm(acc[a][b][m][n][j] + gb[col + n * 4 + j]);
                    u32x4 w; w.x = pk2(o[0], o[1]); w.y = pk2(o[2], o[3]); w.z = pk2(o[4], o[5]); w.w = pk2(o[6], o[7]);
                    stc_16(O + row * 512 + col, w); } }
    }
};
struct PrMoeUp { const u16* h2; const int* row_tok; const int* mi; const u16* W; u16* G; int t0, nt;
    __device__ int num_units() const { return nt * 28; }
    __device__ bool unit(int u, int& pm, int& pn) const { pm = t0 + u / 28; pn = u % 28; return pm < mi[25]; }
    __device__ const u16* a_row(int pm, int r) const { const int t = row_tok[pm * 256 + r]; return t >= 0 ? h2 + (size_t)(RC + t) * 1024 : (const u16*)0; }
    __device__ const u16* b_row(int pm, int pn, int r) const { return W + ((size_t)mi[32 + pm] * 7168 + pn * 256 + r) * 1024; }
    __device__ int K() const { return 1024; }
    __device__ void epi(Acc& acc, int pm, int pn, int wr, int wc, int fr, int fq) const {
#pragma unroll
        for (int a = 0; a < 2; ++a)
#pragma unroll
            for (int m = 0; m < 4; ++m) { const size_t row = (size_t)(pm - t0) * 256 + a * 128 + wr * 64 + m * 16 + fr; const int col = pn * 128 + wc * 32 + fq * 8;
                float o[8];
#pragma unroll
                for (int n = 0; n < 2; ++n)
#pragma unroll
                    for (int j = 0; j < 4; ++j) { const float x = acc[a][0][m][n][j]; o[n * 4 + j] = x * sigm(x) * acc[a][1][m][n][j]; }
                u32x4 w; w.x = pk2(o[0], o[1]); w.y = pk2(o[2], o[3]); w.z = pk2(o[4], o[5]); w.w = pk2(o[6], o[7]);
                stc_16(G + row * 3584 + col, w); }
    }
};
struct PrMoeDown { const u16* G; const int* mi; const u16* W; u16* yb; int t0, nt;
    __device__ int num_units() const { return nt * 4; }
    __device__ bool unit(int u, int& pm, int& pn) const { pm = t0 + u / 4; pn = u % 4; return pm < mi[25]; }
    __device__ const u16* a_row(int pm, int r) const { return G + (size_t)((pm - t0) * 256 + r) * 3584; }
    __device__ const u16* b_row(int pm, int pn, int r) const { return W + ((size_t)mi[32 + pm] * 1024 + pn * 256 + r) * 3584; }
    __device__ int K() const { return 3584; }
    __device__ void epi(Acc& acc, int pm, int pn, int wr, int wc, int fr, int fq) const {
#pragma unroll
        for (int a = 0; a < 2; ++a)
#pragma unroll
            for (int m = 0; m < 4; ++m) { const size_t row = (size_t)pm * 256 + a * 128 + wr * 64 + m * 16 + fr;
#pragma unroll
                for (int b = 0; b < 2; ++b) { const int col = pn * 256 + b * 128 + wc * 32 + fq * 8; const f32x4 v0 = acc[a][b][m][0], v1 = acc[a][b][m][1];
                    u32x4 w; w.x = pk2(v0[0], v0[1]); w.y = pk2(v0[2], v0[3]); w.z = pk2(v1[0], v1[1]); w.w = pk2(v1[2], v1[3]);
                    stc_16(yb + row * 1024 + col, w); } }
    }
};


#define LAS3 __attribute__((address_space(3)))
#ifndef G8_AUXA
#define G8_AUXA 0
#endif
namespace g8 {
constexpr int BK = 64, HALF = 128, HTB = HALF * BK * 2, STAGE_BYTES = 8 * HTB;
__device__ __forceinline__ int lds_byte(int r, int c) { const int st = (r >> 4) * 2 + (c >> 5), rr = r & 15, cc = c & 31, ob = rr * 64 + cc * 2; return st * 1024 + (ob ^ (((ob >> 9) & 1) << 5)); }
__device__ __forceinline__ void stage_rc(int b, int& R, int& C) { const int st = b / 1024, sb = b % 1024, swz = sb ^ (((sb >> 9) & 1) << 5); R = (st >> 1) * 16 + swz / 64; C = (st & 1) * 32 + (swz % 64) / 2; }
struct U8 { const char* a; const char* b; int kb, kbb; int nt; int pm, pn, kind; };
__device__ __forceinline__ bool order8(int L, int nM, int nN, int& pm, int& pn) {
    const int nwg = nM * nN; if (L >= nwg) return false;
    int wgid = L; { const int q = nwg / 8, r = nwg % 8, xcd = wgid % 8, off = wgid / 8; wgid = (xcd < r ? xcd * (q + 1) : r * (q + 1) + (xcd - r) * q) + off; }
    const int nig = 8 * nN, gid = wgid / nig, fm = gid * 8, gsz = (nM - fm) < 8 ? (nM - fm) : 8;
    pm = fm + ((wgid % nig) % gsz); pn = (wgid % nig) / gsz; return true;
}
template <class Pr>
__device__ __forceinline__ void gemm8(LAS3 unsigned char* lds, const Pr& pr) {
    const int tid = ltid(), wid = __builtin_amdgcn_readfirstlane(tid >> 6), lane = tid & 63, wr = wid >> 2, wc = wid & 3, fr = lane & 15, fq = lane >> 4;
    unsigned RA[2], RB[2], C2[2];
#pragma unroll
    for (int i = 0; i < 2; ++i) { int R, C; stage_rc(tid * 16 + i * 8192, R, C); RA[i] = (unsigned)R; RB[i] = (unsigned)((R & ~31) + perm32(R & 31)); C2[i] = (unsigned)C * 2u; }
    const size_t kstep = (size_t)(BK * 2);
    const unsigned ldsw = (unsigned)wid * 1024u;
    const int aoff = lds_byte(wr * 64 + fr, fq * 8), boff = lds_byte(wc * 32 + fr, fq * 8);
#define G8_SA(b, h) (((b) * 2 + (h)) * HTB)
#define G8_SB(b, h) ((4 + (b) * 2 + (h)) * HTB)
#define G8_STAGE(bufoff, gbase, RR, kb) do { _Pragma("unroll") for (int _i = 0; _i < 2; ++_i) { \
        if ((const void*)RR == (const void*)RA) __builtin_amdgcn_global_load_lds((const unsigned*)((const char*)(gbase) + (RR[_i] * (unsigned)(kb) + C2[_i])), (LAS3 unsigned*)(lds + (bufoff) + ldsw + _i * 8192), 16, 0, G8_AUXA); \
        else __builtin_amdgcn_global_load_lds((const unsigned*)((const char*)(gbase) + (RR[_i] * (unsigned)(kb) + C2[_i])), (LAS3 unsigned*)(lds + (bufoff) + ldsw + _i * 8192), 16, 0, 0); } } while (0)
#define G8_LDA(dst, b, h) do { _Pragma("unroll") for (int m = 0; m < 4; ++m) _Pragma("unroll") for (int k = 0; k < 2; ++k) dst[m][k] = *(const LAS3 bf16x8*)(lds + G8_SA(b, h) + aoff + m * 2048 + k * 1024); } while (0)
#define G8_LDB(dst, b, h) do { _Pragma("unroll") for (int n = 0; n < 2; ++n) _Pragma("unroll") for (int k = 0; k < 2; ++k) dst[n][k] = *(const LAS3 bf16x8*)(lds + G8_SB(b, h) + boff + n * 2048 + k * 1024); } while (0)
#define G8_MMA(ai, bj, At, Bt) do { __builtin_amdgcn_s_setprio(1); _Pragma("unroll") for (int m = 0; m < 4; ++m) _Pragma("unroll") for (int n = 0; n < 2; ++n) _Pragma("unroll") for (int k = 0; k < 2; ++k) \
        acc[ai][bj][m][n] = __builtin_amdgcn_mfma_f32_16x16x32_bf16(Bt[n][k], At[m][k], acc[ai][bj][m][n], 0, 0, 0); __builtin_amdgcn_s_setprio(0); } while (0)
#define G8_WAIT_V(n) asm volatile("s_waitcnt vmcnt(" #n ")" ::: "memory")
#define G8_WAIT_L(n) asm volatile("s_waitcnt lgkmcnt(" #n ")" ::: "memory")
#define G8_BAR __builtin_amdgcn_s_barrier()
#define G8_SCHED __builtin_amdgcn_sched_barrier(0)
    U8 cur, nxt; int ui = 0;
    if (!pr.unit8(0, cur)) return;
    nxt = cur;
    f32x4 acc[2][2][4][2];
#pragma unroll
    for (int a = 0; a < 2; ++a)
#pragma unroll
        for (int b = 0; b < 2; ++b)
#pragma unroll
            for (int m = 0; m < 4; ++m)
#pragma unroll
                for (int n = 0; n < 2; ++n) acc[a][b][m][n] = (f32x4){0.f, 0.f, 0.f, 0.f};
    bf16x8 At[4][2], B0[2][2], B1[2][2];
    const char* cA = cur.a; const char* cB = cur.b; int ckb = cur.kb, ckbb = cur.kbb; size_t chs = (size_t)HALF * ckb, chsb = (size_t)HALF * ckbb;
    G8_STAGE(G8_SB(0, 0), cB, RB, ckbb); G8_STAGE(G8_SB(0, 1), cB + chsb, RB, ckbb); G8_STAGE(G8_SA(0, 0), cA, RA, ckb); G8_STAGE(G8_SA(0, 1), cA + chs, RA, ckb);
    if (wr == 1) G8_BAR;
    G8_WAIT_V(2); G8_BAR;
    G8_STAGE(G8_SB(1, 0), cB + kstep, RB, ckbb); G8_STAGE(G8_SA(1, 0), cA + kstep, RA, ckb); G8_STAGE(G8_SB(1, 1), cB + chsb + kstep, RB, ckbb);
    G8_WAIT_V(6); G8_BAR;
    for (;;) {
        const bool has_next = pr.unit8(ui + 1, nxt);
        const char* nA = has_next ? nxt.a : cA; const char* nB = has_next ? nxt.b : cB; const int nkb = has_next ? nxt.kb : ckb, nkbb = has_next ? nxt.kbb : ckbb;
        const int nt = cur.nt;
        for (int t = 0; t < nt; t += 2) {
            const bool last = (t == nt - 2);
            const char* a1 = cA + (size_t)(t + 1) * kstep;
            const char* a2 = last ? nA : cA + (size_t)(t + 2) * kstep; const char* b2 = last ? nB : cB + (size_t)(t + 2) * kstep;
            const int kb2 = last ? nkb : ckb, kbb2 = last ? nkbb : ckbb; const size_t hs2 = (size_t)HALF * kb2, hsb2 = (size_t)HALF * kbb2;
            const char* a3 = a2 + kstep; const char* b3 = b2 + kstep;
            G8_LDB(B0, 0, 0); G8_LDB(B1, 0, 1); G8_SCHED; G8_LDA(At, 0, 0); G8_STAGE(G8_SA(1, 1), a1 + chs, RA, ckb);
            G8_WAIT_V(8); G8_WAIT_L(0); G8_BAR; G8_MMA(0, 0, At, B0); G8_MMA(0, 1, At, B1); G8_BAR; G8_SCHED;
            G8_LDA(At, 0, 1); G8_STAGE(G8_SB(0, 0), b2, RB, kbb2); G8_STAGE(G8_SB(0, 1), b2 + hsb2, RB, kbb2); G8_STAGE(G8_SA(0, 0), a2, RA, kb2);
            G8_WAIT_V(8); G8_WAIT_L(0); G8_BAR; G8_MMA(1, 0, At, B0); G8_MMA(1, 1, At, B1); G8_BAR; G8_SCHED;
            G8_LDB(B0, 1, 0); G8_LDB(B1, 1, 1); G8_SCHED; G8_LDA(At, 1, 0); G8_STAGE(G8_SA(0, 1), a2 + hs2, RA, kb2);
            G8_WAIT_V(8); G8_WAIT_L(0); G8_BAR; G8_MMA(0, 0, At, B0); G8_MMA(0, 1, At, B1); G8_BAR; G8_SCHED;
            G8_LDA(At, 1, 1); G8_STAGE(G8_SB(1, 0), b3, RB, kbb2); G8_STAGE(G8_SB(1, 1), b3 + hsb2, RB, kbb2); G8_STAGE(G8_SA(1, 0), a3, RA, kb2);
            G8_WAIT_V(8); G8_WAIT_L(0); G8_BAR; G8_MMA(1, 0, At, B0); G8_MMA(1, 1, At, B1); G8_BAR; G8_SCHED;
        }
        if (wr == 0) G8_BAR;
        const bool clr = pr.epi8(acc, cur, wr, wc, fr, fq);
        if (!has_next) break;
        if (clr) {
#pragma unroll
            for (int a = 0; a < 2; ++a)
#pragma unroll
                for (int b = 0; b < 2; ++b)
#pragma unroll
                    for (int m = 0; m < 4; ++m)
#pragma unroll
                        for (int n = 0; n < 2; ++n) acc[a][b][m][n] = (f32x4){0.f, 0.f, 0.f, 0.f};
        }
        cur = nxt; cA = nA; cB = nB; ckb = nkb; ckbb = nkbb; chs = (size_t)HALF * ckb; chsb = (size_t)HALF * ckbb; ++ui;
        if (wr == 1) G8_BAR;
    }
    G8_WAIT_V(0);
    G8_BAR;
#undef G8_SA
#undef G8_SB
#undef G8_STAGE
#undef G8_LDA
#undef G8_LDB
#undef G8_MMA
#undef G8_WAIT_V
#undef G8_WAIT_L
#undef G8_BAR
#undef G8_SCHED
}
typedef int i32x8 __attribute__((ext_vector_type(8)));
typedef short s16x16a __attribute__((ext_vector_type(16), aligned(16)));
template <class Pr>
__device__ __forceinline__ void gemm8f(LAS3 unsigned char* lds, const Pr& pr) {
    const int tid = ltid(), wid = __builtin_amdgcn_readfirstlane(tid >> 6), lane = tid & 63, wr = wid >> 2, wc = wid & 3, fr = lane & 15, fq = lane >> 4;
    unsigned RA[2], RB[2], C2[2];
#pragma unroll
    for (int i = 0; i < 2; ++i) { int R, C; stage_rc(tid * 16 + i * 8192, R, C); RA[i] = (unsigned)R; RB[i] = (unsigned)((R & ~31) + perm32(R & 31)); C2[i] = (unsigned)C * 2u; }
    const size_t kstep = (size_t)(BK * 2);
    const unsigned ldsw = (unsigned)wid * 1024u;
    const int aoff = lds_byte(wr * 64 + fr, fq * 16), boff = lds_byte(wc * 32 + fr, fq * 16);
    const int sca = pr.scale_a(), scb = pr.scale_b();
#define G8_SA(b, h) (((b) * 2 + (h)) * HTB)
#define G8_SB(b, h) ((4 + (b) * 2 + (h)) * HTB)
#define G8_STAGE(bufoff, gbase, RR, kb) do { _Pragma("unroll") for (int _i = 0; _i < 2; ++_i) { \
        if ((const void*)RR == (const void*)RA) __builtin_amdgcn_global_load_lds((const unsigned*)((const char*)(gbase) + (RR[_i] * (unsigned)(kb) + C2[_i])), (LAS3 unsigned*)(lds + (bufoff) + ldsw + _i * 8192), 16, 0, G8_AUXA); \
        else __builtin_amdgcn_global_load_lds((const unsigned*)((const char*)(gbase) + (RR[_i] * (unsigned)(kb) + C2[_i])), (LAS3 unsigned*)(lds + (bufoff) + ldsw + _i * 8192), 16, 0, 0); } } while (0)
#define G8_LDA(dst, b, h) do { _Pragma("unroll") for (int m = 0; m < 4; ++m) { const bf16x8 lo_ = *(const LAS3 bf16x8*)(lds + G8_SA(b, h) + aoff + m * 2048), hi_ = *(const LAS3 bf16x8*)(lds + G8_SA(b, h) + aoff + m * 2048 + 16); dst[m] = __builtin_bit_cast(i32x8, __builtin_shufflevector(lo_, hi_, 0, 1, 2, 3, 4, 5, 6, 7, 8, 9, 10, 11, 12, 13, 14, 15)); } } while (0)
#define G8_LDB(dst, b, h) do { _Pragma("unroll") for (int n = 0; n < 2; ++n) { const bf16x8 lo_ = *(const LAS3 bf16x8*)(lds + G8_SB(b, h) + boff + n * 2048), hi_ = *(const LAS3 bf16x8*)(lds + G8_SB(b, h) + boff + n * 2048 + 16); dst[n] = __builtin_bit_cast(i32x8, __builtin_shufflevector(lo_, hi_, 0, 1, 2, 3, 4, 5, 6, 7, 8, 9, 10, 11, 12, 13, 14, 15)); } } while (0)
#define G8_MMA(ai, bj, At, Bt) do { __builtin_amdgcn_s_setprio(1); asm volatile("s_nop 1"); _Pragma("unroll") for (int m = 0; m < 4; ++m) _Pragma("unroll") for (int n = 0; n < 2; ++n) \
        asm volatile("v_mfma_scale_f32_16x16x128_f8f6f4 %0, %1, %2, %0, %3, %4 op_sel_hi:[0,0,0]" : "+v"(acc[ai][bj][m][n]) : "v"(Bt[n]), "v"(At[m]), "v"(scb), "v"(sca)); __builtin_amdgcn_s_setprio(0); } while (0)
#define G8_WAIT_V(n) asm volatile("s_waitcnt vmcnt(" #n ")" ::: "memory")
#define G8_WAIT_L(n) asm volatile("s_waitcnt lgkmcnt(" #n ")" ::: "memory")
#define G8_BAR __builtin_amdgcn_s_barrier()
#define G8_SCHED __builtin_amdgcn_sched_barrier(0)
    U8 cur, nxt; int ui = 0;
    if (!pr.unit8(0, cur)) return;
    nxt = cur;
    f32x4 acc[2][2][4][2];
#pragma unroll
    for (int a = 0; a < 2; ++a)
#pragma unroll
        for (int b = 0; b < 2; ++b)
#pragma unroll
            for (int m = 0; m < 4; ++m)
#pragma unroll
                for (int n = 0; n < 2; ++n) acc[a][b][m][n] = (f32x4){0.f, 0.f, 0.f, 0.f};
    i32x8 At[4], B0[2], B1[2];
    const char* cA = cur.a; const char* cB = cur.b; int ckb = cur.kb, ckbb = cur.kbb; size_t chs = (size_t)HALF * ckb, chsb = (size_t)HALF * ckbb;
    G8_STAGE(G8_SB(0, 0), cB, RB, ckbb); G8_STAGE(G8_SB(0, 1), cB + chsb, RB, ckbb); G8_STAGE(G8_SA(0, 0), cA, RA, ckb); G8_STAGE(G8_SA(0, 1), cA + chs, RA, ckb);
    if (wr == 1) G8_BAR;
    G8_WAIT_V(2); G8_BAR;
    G8_STAGE(G8_SB(1, 0), cB + kstep, RB, ckbb); G8_STAGE(G8_SA(1, 0), cA + kstep, RA, ckb); G8_STAGE(G8_SB(1, 1), cB + chsb + kstep, RB, ckbb);
    G8_WAIT_V(6); G8_BAR;
    for (;;) {
        const bool has_next = pr.unit8(ui + 1, nxt);
        const char* nA = has_next ? nxt.a : cA; const char* nB = has_next ? nxt.b : cB; const int nkb = has_next ? nxt.kb : ckb, nkbb = has_next ? nxt.kbb : ckbb;
        const int nt = cur.nt;
        for (int t = 0; t < nt; t += 2) {
            const bool last = (t == nt - 2);
            const char* a1 = cA + (size_t)(t + 1) * kstep;
            const char* a2 = last ? nA : cA + (size_t)(t + 2) * kstep; const char* b2 = last ? nB : cB + (size_t)(t + 2) * kstep;
            const int kb2 = last ? nkb : ckb, kbb2 = last ? nkbb : ckbb; const size_t hs2 = (size_t)HALF * kb2, hsb2 = (size_t)HALF * kbb2;
            const char* a3 = a2 + kstep; const char* b3 = b2 + kstep;
            G8_LDB(B0, 0, 0); G8_LDB(B1, 0, 1); G8_SCHED; G8_LDA(At, 0, 0); G8_STAGE(G8_SA(1, 1), a1 + chs, RA, ckb);
            G8_WAIT_V(8); G8_WAIT_L(0); G8_BAR; G8_MMA(0, 0, At, B0); G8_MMA(0, 1, At, B1); G8_BAR; G8_SCHED;
            G8_LDA(At, 0, 1); G8_STAGE(G8_SB(0, 0), b2, RB, kbb2); G8_STAGE(G8_SB(0, 1), b2 + hsb2, RB, kbb2); G8_STAGE(G8_SA(0, 0), a2, RA, kb2);
            G8_WAIT_V(8); G8_WAIT_L(0); G8_BAR; G8_MMA(1, 0, At, B0); G8_MMA(1, 1, At, B1); G8_BAR; G8_SCHED;
            G8_LDB(B0, 1, 0); G8_LDB(B1, 1, 1); G8_SCHED; G8_LDA(At, 1, 0); G8_STAGE(G8_SA(0, 1), a2 + hs2, RA, kb2);
            G8_WAIT_V(8); G8_WAIT_L(0); G8_BAR; G8_MMA(0, 0, At, B0); G8_MMA(0, 1, At, B1); G8_BAR; G8_SCHED;
            G8_LDA(At, 1, 1); G8_STAGE(G8_SB(1, 0), b3, RB, kbb2); G8_STAGE(G8_SB(1, 1), b3 + hsb2, RB, kbb2); G8_STAGE(G8_SA(1, 0), a3, RA, kb2);
            G8_WAIT_V(8); G8_WAIT_L(0); G8_BAR; G8_MMA(1, 0, At, B0); G8_MMA(1, 1, At, B1); G8_BAR; G8_SCHED;
        }
        asm volatile("s_nop 7\n\ts_nop 7\n\ts_nop 7" : "+v"(acc[1][0][0][0]), "+v"(acc[1][0][0][1]), "+v"(acc[1][0][1][0]), "+v"(acc[1][0][1][1]), "+v"(acc[1][0][2][0]), "+v"(acc[1][0][2][1]), "+v"(acc[1][0][3][0]), "+v"(acc[1][0][3][1]), "+v"(acc[1][1][0][0]), "+v"(acc[1][1][0][1]), "+v"(acc[1][1][1][0]), "+v"(acc[1][1][1][1]), "+v"(acc[1][1][2][0]), "+v"(acc[1][1][2][1]), "+v"(acc[1][1][3][0]), "+v"(acc[1][1][3][1]) :: "memory");
        if (wr == 0) G8_BAR;
        const bool clr = pr.epi8(acc, cur, wr, wc, fr, fq);
        if (!has_next) break;
        if (clr) {
#pragma unroll
            for (int a = 0; a < 2; ++a)
#pragma unroll
                for (int b = 0; b < 2; ++b)
#pragma unroll
                    for (int m = 0; m < 4; ++m)
#pragma unroll
                        for (int n = 0; n < 2; ++n) acc[a][b][m][n] = (f32x4){0.f, 0.f, 0.f, 0.f};
        }
        cur = nxt; cA = nA; cB = nB; ckb = nkb; ckbb = nkbb; chs = (size_t)HALF * ckb; chsb = (size_t)HALF * ckbb; ++ui;
        if (wr == 1) G8_BAR;
    }
    G8_WAIT_V(0);
    G8_BAR;
#undef G8_SA
#undef G8_SB
#undef G8_STAGE
#undef G8_LDA
#undef G8_LDB
#undef G8_MMA
#undef G8_WAIT_V
#undef G8_WAIT_L
#undef G8_BAR
#undef G8_SCHED
}
}

template <class Base> struct Dense8 : Base {
    __device__ bool unit8(int i, g8::U8& u) const { int pm, pn; if (!g8::order8(i * (int)gridDim.x + (int)blockIdx.x, this->ntm, this->ntn, pm, pn)) return false; pm += this->tm0;
        u.pm = pm; u.pn = pn; u.kind = 0; u.kb = (int)this->lda * 2; u.kbb = (int)this->ldb * 2; u.nt = this->Kd / 64; u.a = (const char*)(this->A + (size_t)pm * 256 * this->lda); u.b = (const char*)(this->Bt + (size_t)pn * 256 * this->ldb); return true; }
    __device__ bool epi8(Acc& acc, const g8::U8& u, int wr, int wc, int fr, int fq) const { this->epi(acc, u.pm, u.pn, wr, wc, fr, fq); return true; }
};
template <class Base> struct Dense8F : Base {
    int sa_, sb_;
    __device__ int scale_a() const { return sa_; }
    __device__ int scale_b() const { return sb_; }
    __device__ bool unit8(int i, g8::U8& u) const { int pm, pn; if (!g8::order8(i * (int)gridDim.x + (int)blockIdx.x, this->ntm, this->ntn, pm, pn)) return false; pm += this->tm0;
        u.pm = pm; u.pn = pn; u.kind = 0; u.kb = (int)this->lda; u.kbb = (int)this->ldb; u.nt = this->Kd / 128; u.a = (const char*)this->A + (size_t)pm * 256 * this->lda; u.b = (const char*)this->Bt + (size_t)pn * 256 * this->ldb; return true; }
    __device__ bool epi8(Acc& acc, const g8::U8& u, int wr, int wc, int fr, int fq) const { this->epi(acc, u.pm, u.pn, wr, wc, fr, fq); return true; }
};
struct In12 { const u16* A; const u16* Wt; u16* Orw; u16* Os5;
    __device__ bool unit8(int i, g8::U8& u) const { int pm, pn; if (!g8::order8(i * (int)gridDim.x + (int)blockIdx.x, 144, 10, pm, pn)) return false;
        u.pm = pm; u.pn = pn; u.kind = 0; u.kb = 2048; u.kbb = 2048; u.nt = 16; u.a = (const char*)(A + (size_t)pm * 256 * 1024);
        u.b = (const char*)(Wt + (size_t)((pn < 8 ? 1536 + pn * 256 : 3584 + (pn - 8) * 256)) * 1024); return true; }
    __device__ bool epi8(Acc& acc, const g8::U8& u, int wr, int wc, int fr, int fq) const {
        u16* O = u.pn < 8 ? Orw : Os5; const long ldo = u.pn < 8 ? 2048 : 512; const int cb = (u.pn < 8 ? u.pn : u.pn - 8) * 256;
#pragma unroll
        for (int a = 0; a < 2; ++a)
#pragma unroll
            for (int m = 0; m < 4; ++m) { const size_t row = (size_t)u.pm * 256 + a * 128 + wr * 64 + m * 16 + fr;
#pragma unroll
                for (int b = 0; b < 2; ++b) { const int col = cb + b * 128 + wc * 32 + fq * 8; const f32x4 v0 = acc[a][b][m][0], v1 = acc[a][b][m][1];
                    u32x4 w; w.x = pk2(v0[0], v0[1]); w.y = pk2(v0[2], v0[3]); w.z = pk2(v1[0], v1[1]); w.w = pk2(v1[2], v1[3]);
                    stc_16(O + row * ldo + col, w); } }
        return true; }
};
struct MoeUp8 : PrMoeUp { const u16* xb;
    __device__ bool unit8(int i, g8::U8& u) const { int nM = uni((int)ldc_u32(mi + 25)) - t0; nM = nM < 0 ? 0 : (nM > nt ? nt : nM); int pm, pn; if (!g8::order8(i * (int)gridDim.x + (int)blockIdx.x, nM, 28, pm, pn)) return false; pm += t0;
        u.pm = pm; u.pn = pn; u.kind = 0; u.kb = 2048; u.kbb = 2048; u.nt = 16; u.a = (const char*)(xb + (size_t)pm * 256 * 1024); u.b = (const char*)(W + ((size_t)uni((int)ldc_u32(mi + 32 + pm)) * 7168 + pn * 256) * 1024); return true; }
    __device__ bool epi8(Acc& acc, const g8::U8& u, int wr, int wc, int fr, int fq) const { this->epi(acc, u.pm, u.pn, wr, wc, fr, fq); return true; }
};
struct MoeDown8 : PrMoeDown {
    __device__ bool unit8(int i, g8::U8& u) const { int nM = uni((int)ldc_u32(mi + 25)) - t0; nM = nM < 0 ? 0 : (nM > nt ? nt : nM); int pm, pn; if (!g8::order8(i * (int)gridDim.x + (int)blockIdx.x, nM, 4, pm, pn)) return false; pm += t0;
        u.pm = pm; u.pn = pn; u.kind = 0; u.kb = 7168; u.kbb = 7168; u.nt = 56; u.a = (const char*)(G + (size_t)(pm - t0) * 256 * 3584); u.b = (const char*)(W + ((size_t)uni((int)ldc_u32(mi + 32 + pm)) * 1024 + pn * 256) * 3584); return true; }
    __device__ bool epi8(Acc& acc, const g8::U8& u, int wr, int wc, int fr, int fq) const { this->epi(acc, u.pm, u.pn, wr, wc, fr, fq); return true; }
};
struct Branch8 { const u16* y; const u16* wt; u16* G; u16* acc; int tm0, ntm;
    __device__ bool unit8(int i, g8::U8& u) const { const int ti = i >> 2, m = i & 3; int pm, pn; if (!g8::order8(ti * (int)gridDim.x + (int)blockIdx.x, ntm, 4, pm, pn)) return false; pm += tm0;
        u.pm = pm; u.pn = pn; u.kind = m; u.kb = 1024; u.kbb = 1024; u.nt = 8; u.a = (const char*)(y + ((size_t)m * MT + (size_t)pm * 256) * 512); u.b = (const char*)(wt + ((size_t)m * 1024 + pn * 256) * 512); return true; }
    __device__ bool epi8(Acc& acc_, const g8::U8& u, int wr, int wc, int fr, int fq) const {
        const int m = u.kind;
        const char* gb = (const char*)G + (size_t)(u.pm * 16 + m * 4 + u.pn) * 65536 + (unsigned)(((wr * 4 + wc) * 64 + fq * 16 + fr) * 8);
        extern __shared__ __attribute__((aligned(16))) char smem_raw[]; LAS3 char* gc = (LAS3 char*)smem_raw + SM_OFF + 131072 + (unsigned)(((wr * 4 + wc) * 64 + fq * 16 + fr) * 8);
#pragma unroll
        for (int a = 0; a < 2; ++a)
#pragma unroll
            for (int mm = 0; mm < 4; ++mm) { const size_t row = (size_t)u.pm * 256 + a * 128 + wr * 64 + mm * 16 + fr;
#pragma unroll
                for (int b = 0; b < 2; ++b) { const int col = u.pn * 256 + b * 128 + wc * 32 + fq * 8;
                    const char* gp = gb + ((a * 4 + mm) * 2 + b) * 4096;
                    const int idx = (a * 4 + mm) * 2 + b;
                    u32x2 qa;
                    if (idx < GC_N && m != 0) qa = *(const LAS3 u32x2*)(gc + idx * 4096);
                    else qa = ldc_8(gp);
                    float gv[8];
#pragma unroll
                    for (int j = 0; j < 4; ++j) { gv[j] = (float)((qa.x >> (8 * j)) & 255u) * (1.f / 256.f) + (0.5f / 256.f); gv[4 + j] = (float)((qa.y >> (8 * j)) & 255u) * (1.f / 256.f) + (0.5f / 256.f); }
                    if (m != 3) {
                        const u32x2 qn = ldc_8(gp + 4 * 65536);
                        if (idx < GC_N) *(LAS3 u32x2*)(gc + idx * 4096) = qn;
#pragma unroll
                        for (int j = 0; j < 4; ++j) { gv[j] *= frcp((float)((qn.x >> (8 * j)) & 255u) * (1.f / 256.f) + (0.5f / 256.f)); gv[4 + j] *= frcp((float)((qn.y >> (8 * j)) & 255u) * (1.f / 256.f) + (0.5f / 256.f)); }
#pragma unroll
                        for (int j = 0; j < 4; ++j) { acc_[a][b][mm][0][j] *= gv[j]; acc_[a][b][mm][1][j] *= gv[4 + j]; }
                    } else {
                        float o[8];
#pragma unroll
                        for (int j = 0; j < 4; ++j) { o[j] = gv[j] * acc_[a][b][mm][0][j]; o[4 + j] = gv[4 + j] * acc_[a][b][mm][1][j]; }
                        stc_16(acc + row * 1024 + col, pack8(o)); } } }
        return m == 3; }
};
struct MoeUp8F { const char* xb8; const int* mi; const char* W8; char* G8; int t0, nt;
    __device__ int scale_a() const { return 127; }
    __device__ int scale_b() const { return 122; }
    __device__ bool unit8(int i, g8::U8& u) const { int nM = uni((int)ldc_u32(mi + 25)) - t0; nM = nM < 0 ? 0 : (nM > nt ? nt : nM); int pm, pn; if (!g8::order8(i * (int)gridDim.x + (int)blockIdx.x, nM, 28, pm, pn)) return false; pm += t0;
        u.pm = pm; u.pn = pn; u.kind = 0; u.kb = 1024; u.kbb = 1024; u.nt = 8; u.a = xb8 + (size_t)pm * 256 * 1024; u.b = W8 + ((size_t)uni((int)ldc_u32(mi + 32 + pm)) * 7168 + pn * 256) * 1024; return true; }
    __device__ bool epi8(Acc& acc, const g8::U8& u, int wr, int wc, int fr, int fq) const {
#pragma unroll
        for (int a = 0; a < 2; ++a)
#pragma unroll
            for (int m = 0; m < 4; ++m) { const size_t row = (size_t)(u.pm - t0) * 256 + a * 128 + wr * 64 + m * 16 + fr; const int col = u.pn * 128 + wc * 32 + fq * 8;
                float o[8];
#pragma unroll
                for (int n = 0; n < 2; ++n)
#pragma unroll
                    for (int j = 0; j < 4; ++j) { const float x = acc[a][0][m][n][j]; o[n * 4 + j] = 4.f * x * sigm(x) * acc[a][1][m][n][j]; }
                u32x2 w; w.x = pk4_fp8(o[0], o[1], o[2], o[3]); w.y = pk4_fp8(o[4], o[5], o[6], o[7]);
                stc_8(G8 + row * 3584 + col, w); }
        return true; }
};
struct MoeDown8F { const char* G8; const int* mi; const char* W8; u16* yb; int t0, nt;
    __device__ int scale_a() const { return 125; }
    __device__ int scale_b() const { return 122; }
    __device__ bool unit8(int i, g8::U8& u) const { int nM = uni((int)ldc_u32(mi + 25)) - t0; nM = nM < 0 ? 0 : (nM > nt ? nt : nM); int pm, pn; if (!g8::order8(i * (int)gridDim.x + (int)blockIdx.x, nM, 4, pm, pn)) return false; pm += t0;
        u.pm = pm; u.pn = pn; u.kind = 0; u.kb = 3584; u.kbb = 3584; u.nt = 28; u.a = G8 + (size_t)(pm - t0) * 256 * 3584; u.b = W8 + ((size_t)uni((int)ldc_u32(mi + 32 + pm)) * 1024 + pn * 256) * 3584; return true; }
    __device__ bool epi8(Acc& acc, const g8::U8& u, int wr, int wc, int fr, int fq) const {
#pragma unroll
        for (int a = 0; a < 2; ++a)
#pragma unroll
            for (int m = 0; m < 4; ++m) { const size_t row = (size_t)u.pm * 256 + a * 128 + wr * 64 + m * 16 + fr;
#pragma unroll
                for (int b = 0; b < 2; ++b) { const int col = u.pn * 256 + b * 128 + wc * 32 + fq * 8; const f32x4 v0 = acc[a][b][m][0], v1 = acc[a][b][m][1];
                    u32x4 w; w.x = pk2(v0[0], v0[1]); w.y = pk2(v0[2], v0[3]); w.z = pk2(v1[0], v1[1]); w.w = pk2(v1[2], v1[3]);
                    stc_16(yb + row * 1024 + col, w); } }
        return true; }
};
#define GEMM8(pr) g8::gemm8((LAS3 unsigned char*)smem, pr)
#define GEMM8F(pr) g8::gemm8f((LAS3 unsigned char*)smem, pr)

__device__ __forceinline__ void seq_of(int row, int& base, int& t, int& L) {
    if (row < RC) { t = row & 255; L = 256; } else { t = (row - RC) & 2047; L = 2048; }
    base = row - t;
}
__device__ __forceinline__ void mfma_safe(f32x4& acc, const bf16x8 a, const bf16x8 b) {
    acc = __builtin_amdgcn_mfma_f32_16x16x32_bf16(a, b, acc, 0, 0, 0);
    asm volatile("" :: "v"(acc), "v"(a), "v"(b));
}
__device__ __forceinline__ void mfma_ip(f32x4& acc, const bf16x8 a, const bf16x8 b) { asm volatile("v_mfma_f32_16x16x32_bf16 %0, %1, %2, %0" : "+v"(acc) : "v"(a), "v"(b)); }
__device__ __forceinline__ void mfma_settle() { asm volatile("s_nop 7\n\ts_nop 7\n\ts_nop 3" ::: "memory"); }
#define HY_UTL(p) ((u16*)((p).arena + (size_t)MT * 1536 * 2))
#define HY_UTC(p) (HY_UTL(p) + (size_t)512 * 16 * 2048)
#define HY_YTL(p) (HY_UTC(p) + (size_t)512 * 16 * 256)
#define HY_YTC(p) (HY_YTL(p) + (size_t)512 * 16 * 2048)
__device__ __forceinline__ void ph_hy_pre(PP pp, int l) {
    PREF; l = uni(l); const u16* ph = (const u16*)p.arena;
    u16* T = (u16*)smem;
    const int w = tix >> 6, lane = tix & 63, tg = lane >> 3, cg = lane & 7, c0 = w * 64 + cg * 8, s0 = tg * 8;
    const float* cw = p.in[I_hy_conv_w] + l * 3 * 1536; const float* cb = p.in[I_hy_conv_b] + l * 1536;
    for (int tt = (l ? 64 : 0) + blockIdx.x; tt < 576; tt += gridDim.x) {
        const int row0 = tt * 64; int b, t0, L; u16* utb;
        if (row0 < RC) { b = row0 >> 8; t0 = row0 & 255; L = 256; utb = HY_UTC(p) + (size_t)b * 256 + t0; }
        else { b = (row0 - RC) >> 11; t0 = (row0 - RC) & 2047; L = 2048; utb = HY_UTL(p) + (size_t)b * 2048 + t0; }
        float uu[8][8];
#pragma unroll
        for (int j = 0; j < 3; ++j) {
            float w0[8], w1[8], w2[8], bb[8];
#pragma unroll
            for (int e4 = 0; e4 < 2; ++e4) { const f32x4 a0 = *(const f32x4*)(cw + j * 512 + c0 + e4 * 4), a1 = *(const f32x4*)(cw + 1536 + j * 512 + c0 + e4 * 4), a2 = *(const f32x4*)(cw + 3072 + j * 512 + c0 + e4 * 4), a3 = *(const f32x4*)(cb + j * 512 + c0 + e4 * 4);
#pragma unroll
                for (int e = 0; e < 4; ++e) { w0[e4 * 4 + e] = a0[e]; w1[e4 * 4 + e] = a1[e]; w2[e4 * 4 + e] = a2[e]; bb[e4 * 4 + e] = a3[e]; } }
            u32x4 raw[10];
#pragma unroll
            for (int r = 0; r < 10; ++r) { const int t = t0 + s0 - 1 + r; raw[r] = (u32x4){0u, 0u, 0u, 0u};
                if (t >= 0 && t < L) raw[r] = ldc_16(ph + (size_t)(row0 + s0 - 1 + r) * 1536 + j * 512 + c0); }
            float xr[10][8];
#pragma unroll
            for (int r = 0; r < 10; ++r) unpack8(raw[r], xr[r]);
#pragma unroll
            for (int i = 0; i < 8; ++i) {
                float r8[8];
#pragma unroll
                for (int e = 0; e < 8; ++e) r8[e] = xr[i][e] * w0[e] + xr[i + 1][e] * w1[e] + xr[i + 2][e] * w2[e] + bb[e];
                if (j == 0) stc_16(p.y + ((size_t)row0 + s0 + i) * 512 + c0, pack8(r8));
                else if (j == 1) {
#pragma unroll
                    for (int e = 0; e < 8; ++e) uu[i][e] = r8[e]; }
                else {
#pragma unroll
                    for (int e = 0; e < 8; ++e) uu[i][e] = r8[e] * uu[i][e]; }
            }
        }
        __syncthreads();
#pragma unroll
        for (int e = 0; e < 8; ++e) { u32x4 wv; wv.x = pk2(uu[0][e], uu[1][e]); wv.y = pk2(uu[2][e], uu[3][e]); wv.z = pk2(uu[4][e], uu[5][e]); wv.w = pk2(uu[6][e], uu[7][e]); *(u32x4*)(T + (c0 + e) * 72 + s0) = wv; }
        __syncthreads();
        { const int c = tix;
#pragma unroll
          for (int k8 = 0; k8 < 8; ++k8) stc_16(utb + (size_t)c * 16 * L + k8 * 8, *(const u32x4*)(T + c * 72 + k8 * 8)); }
    }
}
template <int L>
__device__ __forceinline__ void hy_conv_items(const u16* rvg, const u16* utg, u16* ytg, char* smem, const int tix) {
    constexpr int TPW = L / 128, CPN = 2 * L + 16, OFS = L + 8, RS = L + 8, NKS = L / 32, UNR = TPW / 2;
    u16* cp = (u16*)smem; u16* us = cp + 8 * CPN;
    const int wid = tix >> 6, lane = tix & 63, r = lane & 15, q = lane >> 4;
    const int a = (8 - (r & 7)) & 7;
    const int tb = a * CPN + 8 * q - r - a + OFS;
    const int ubs = r * RS + 8 * q;
    const int t_w = wid * (TPW * 16);
    for (int c = blockIdx.x; c < 512; c += gridDim.x) {
        __syncthreads();
        for (int idx = tix; idx < 8 * CPN; idx += NT) { const int a_ = idx / CPN, xi = idx - a_ * CPN; const int g = xi - OFS + a_ + L; cp[idx] = (g >= 0 && g < 2 * L) ? rvg[(size_t)c * (2 * L) + g] : (u16)0; }
        for (int pc = tix; pc < 16 * (L / 8); pc += NT) { const int b = pc / (L / 8), k8 = pc - b * (L / 8); *(u32x4*)(us + b * RS + k8 * 8) = ldc_16(utg + ((size_t)c * 16 + b) * L + k8 * 8); }
        __syncthreads();
        f32x4 acc[TPW]; bf16x8 W[TPW];
#pragma unroll
        for (int i = 0; i < TPW; ++i) { acc[i] = (f32x4){0.f, 0.f, 0.f, 0.f}; W[i] = *(const bf16x8*)(cp + tb - (t_w + 16 * i)); }
        for (int ks0 = 0; ks0 < NKS; ks0 += UNR) {
#pragma unroll
            for (int u = 0; u < UNR; ++u) {
                const int ks = ks0 + u;
                const bf16x8 U = *(const bf16x8*)(us + ubs + 32 * ks);
#pragma unroll
                for (int i = TPW - 2; i < TPW; ++i) mfma_safe(acc[i], W[(i - 2 * u + 2 * TPW) % TPW], U);
#pragma unroll
                for (int i = 0; i < 2; ++i) W[(i - 2 * (u + 1) + 2 * TPW) % TPW] = *(const bf16x8*)(cp + tb + 32 * (ks + 1) - (t_w + 16 * i));
#pragma unroll
                for (int i = 0; i < TPW - 2; ++i) mfma_safe(acc[i], W[(i - 2 * u + 2 * TPW) % TPW], U);
            }
        }
#pragma unroll
        for (int i = 0; i < TPW; ++i) { u32x2 w; w.x = pk2(acc[i][0], acc[i][1]); w.y = pk2(acc[i][2], acc[i][3]); stc_8(ytg + ((size_t)c * 16 + r) * L + t_w + 16 * i + 4 * q, w); }
    }
}
__device__ __forceinline__ void ph_hy_conv(PP pp, int l) {
    PREF; l = uni(l);
    hy_conv_items<2048>(p.rvl + (size_t)l * 512 * 4096, HY_UTL(p), HY_YTL(p), smem, tix);
    if (l == 0) hy_conv_items<256>(p.rvc + (size_t)l * 512 * 512, HY_UTC(p), HY_YTC(p), smem, tix);
}
__device__ __forceinline__ void ph_hy_post(PP pp, int l, int shadow) {
    PREF; l = uni(l); (void)shadow;
    u16* T = (u16*)smem;
    const int w = tix >> 6, lane = tix & 63, tg = lane >> 3, cg = lane & 7, c0 = w * 64 + cg * 8, s0 = tg * 8;
    for (int tt = (l ? 64 : 0) + blockIdx.x; tt < 576; tt += gridDim.x) {
        const int row0 = tt * 64; const u16* yt;
        if (row0 < RC) yt = HY_YTC(p) + ((size_t)tix * 16 + (row0 >> 8)) * 256 + (row0 & 255);
        else yt = HY_YTL(p) + ((size_t)tix * 16 + ((row0 - RC) >> 11)) * 2048 + ((row0 - RC) & 2047);
        u32x4 v[8], xr[8];
#pragma unroll
        for (int k = 0; k < 8; ++k) v[k] = ldc_16(yt + 8 * k);
#pragma unroll
        for (int i = 0; i < 8; ++i) xr[i] = ldc_16(p.y + ((size_t)row0 + s0 + i) * 512 + c0);
        __syncthreads();
#pragma unroll
        for (int k = 0; k < 8; ++k) *(u32x4*)(T + tix * 72 + 8 * k) = v[k];
        __syncthreads();
#pragma unroll
        for (int i = 0; i < 8; ++i) { float x0[8], o[8]; unpack8(xr[i], x0);
#pragma unroll
            for (int e = 0; e < 8; ++e) o[e] = x0[e] * bf2f(T[(c0 + e) * 72 + s0 + i]);
            stc_16(p.y + ((size_t)row0 + s0 + i) * 512 + c0, pack8(o)); }
    }
}

__device__ __forceinline__ void ph_rw_scan(PP pp, int l) {
    PREF; l = uni(l); const u16* pr = (const u16*)p.arena; u16* ob = (u16*)(p.arena + (size_t)MT * 2048 * 2); float* bon = (float*)(p.arena + (size_t)MT * 2048 * 2 + (size_t)2 * MT * 512 * 2);
    const int tid = tix, wid = tid >> 6, lane = tid & 63;
    u16* WUt = (u16*)smem;
    u16* AUt = WUt + 64 * 72;
    u16* RAW = AUt + 64 * 72;
    u16* TWb = RAW + 34 * 320;
    u16* ADb = TWb + 32 * 72;
    float* Ks = (float*)(ADb + 32 * 72);
    float* KKv = Ks + 2048; float* Rv = KKv + 2048; float* Vv = Rv + 2048; float* Wv = Vv + 2048; float* Bv = Wv + 2048; float* KDv = Bv + 2048;
    float* bonp = KDv + 2048;
    float* Oc = bonp + 128;
    u16* KT = RAW; u16* BT = KT + 32 * 72; u16* KD = BT + 32 * 72; u16* RT = KD + 32 * 72; u16* AB = RT + 32 * 72; u16* CC = AB + 2 * 16 * 40; u16* Tm = CC + 2 * 16 * 40;
    float* Amat = (float*)(Tm + 2 * 16 * 40);
    float* CUMS = Ks;
    u16* MtT = (u16*)KKv;
    u16* BKt = (u16*)(Oc + 32 * 68);
    u16* UVt = BKt + 2 * 64 * 40;
    u16* Sb = UVt + 2 * 64 * 40;
    float* MUs = (float*)(Sb + 64 * 72);
    float* KKs = MUs + 640;
    float* PC = KKs + 64;
    const int pt = tid >> 4, pc4 = (tid & 15) * 4;
    const int r4 = lane >> 4, kq = lane & 15, v0 = wid * 8 + r4 * 2;
    const int tt = wid >> 2, ct = wid & 3, ech = ct * 16 + (lane & 15), eq = lane >> 4;
    for (int sid = blockIdx.x; sid < 256; sid += gridDim.x) {
        const int b = sid >> 4, h = (sid >> 1) & 7, d = sid & 1;
        __syncthreads();
        for (int i = tid; i < 4096; i += NT) { const int m = i >> 6, ch = i & 63;
            WUt[ch * 72 + m] = f2bf(p.in[I_rw_w_up][((size_t)(l * 2 + d) * 64 + m) * 512 + h * 64 + ch]);
            AUt[ch * 72 + m] = f2bf(p.in[I_rw_a_up][((size_t)(l * 2 + d) * 64 + m) * 512 + h * 64 + ch]); }
        const int cbase[5] = {h * 64, 512 + h * 64, 1024 + h * 64, 1536 + d * 64, 1664 + d * 64};
        for (int i = tid; i < 704; i += NT) { const int ch = i & 63, j = (i >> 6) % 5, wh = i / 320;
            MUs[i] = i < 640 ? p.in[I_rw_mu][(size_t)(l * 2 + wh) * 1920 + cbase[j] + ch] : p.in[I_rw_k_k][l * 512 + h * 64 + ch]; }
        const float e_w0 = p.in[I_rw_w0][(l * 2 + d) * 512 + h * 64 + ech], e_a0 = p.in[I_rw_a0][(l * 2 + d) * 512 + h * 64 + ech], e_ka = p.in[I_rw_k_a][l * 512 + h * 64 + ech], e_rk = p.in[I_rw_r_k][l * 512 + h * 64 + ech];
        f32x4 SS[4];
#pragma unroll
        for (int i = 0; i < 4; ++i) SS[i] = (f32x4){0.f, 0.f, 0.f, 0.f};
        for (int i = tid; i < 2 * 64 * 40 + 64 * 72; i += NT) UVt[i] = (u16)0;
        int prev_row0 = -1;
#define RW_GEOM(fc, L_, base_, tlo_) const int L_ = (fc) < 8 ? 256 : 2048, base_ = (fc) < 8 ? b * 256 : RC + b * 2048, tlo_ = d ? L_ - 32 * (((fc) < 8 ? (fc) : (fc) - 8) + 1) : 32 * ((fc) < 8 ? (fc) : (fc) - 8)
#define RW_FETCH(fc) do { RW_GEOM(fc, Lf, basef, tlof); _Pragma("unroll") for (int i3 = 0; i3 < 3; ++i3) { const int i = tid + i3 * NT; const int rr = i / 40, c8 = i - rr * 40; const int t = tlof - 1 + rr; const int j = c8 >> 3; \
            u32x4 v = (u32x4){0u, 0u, 0u, 0u}; if (i < 34 * 40 && t >= 0 && t < Lf) v = ldc_16(pr + ((size_t)basef + t) * 2048 + cbase[j] + (c8 & 7) * 8); rawreg[i3] = v; } } while (0)
        u32x4 rawreg[3];
        RW_FETCH(0);
        for (int fc = 0; fc < 72; ++fc) {
            {
                RW_GEOM(fc, L, base, t_lo); (void)L;
                __syncthreads();
                if (prev_row0 >= 0) { const f32x4 o = *(const f32x4*)(Oc + pt * 68 + pc4); stc_8(ob + ((size_t)d * MT + prev_row0 + pt) * 512 + h * 64 + pc4, pk4bf(o)); }
#pragma unroll
                for (int i3 = 0; i3 < 3; ++i3) { const int i = tid + i3 * NT; const int rr = i / 40, c8 = i - rr * 40; if (i < 34 * 40) *(u32x4*)(RAW + rr * 320 + c8 * 8) = rawreg[i3]; }
                __syncthreads();
                for (int rwr_ = 0; rwr_ < 1 + ((RWREP >> 0) & 1); ++rwr_) { if (rwr_) __syncthreads();
                {
                    float x[5][4];
#pragma unroll
                    for (int j = 0; j < 5; ++j) { const u32x2 a = *(const u32x2*)(RAW + pt * 320 + j * 64 + pc4), c = *(const u32x2*)(RAW + (pt + 1) * 320 + j * 64 + pc4), n = *(const u32x2*)(RAW + (pt + 2) * 320 + j * 64 + pc4);
                        const float pm[4] = {__uint_as_float(a.x << 16), __uint_as_float(a.x & 0xffff0000u), __uint_as_float(a.y << 16), __uint_as_float(a.y & 0xffff0000u)};
                        const float pc[4] = {__uint_as_float(c.x << 16), __uint_as_float(c.x & 0xffff0000u), __uint_as_float(c.y << 16), __uint_as_float(c.y & 0xffff0000u)};
                        const float pn[4] = {__uint_as_float(n.x << 16), __uint_as_float(n.x & 0xffff0000u), __uint_as_float(n.y << 16), __uint_as_float(n.y & 0xffff0000u)};
                        const f32x4 m0 = *(const f32x4*)(MUs + j * 64 + pc4), m1 = *(const f32x4*)(MUs + 320 + j * 64 + pc4);
#pragma unroll
                        for (int e = 0; e < 4; ++e) x[j][e] = pc[e] + m0[e] * (pm[e] - pc[e]) + m1[e] * (pn[e] - pc[e]); }
                    float kr[4], ss = 0.f;
                    const f32x4 kk_k = *(const f32x4*)(KKs + pc4);
#pragma unroll
                    for (int e = 0; e < 4; ++e) { kr[e] = x[1][e] * kk_k[e]; ss += kr[e] * kr[e]; }
                    ss = rowsum16(ss);
                    const float inv = frcp(fmaxf(__builtin_amdgcn_sqrtf(ss), 1e-12f));
                    *(f32x4*)(Rv + pt * 64 + pc4) = (f32x4){x[0][0], x[0][1], x[0][2], x[0][3]};
                    *(f32x4*)(Ks + pt * 64 + pc4) = (f32x4){x[1][0], x[1][1], x[1][2], x[1][3]};
                    *(f32x4*)(Vv + pt * 64 + pc4) = (f32x4){x[2][0], x[2][1], x[2][2], x[2][3]};
                    *(f32x4*)(KKv + pt * 64 + pc4) = (f32x4){kr[0] * inv, kr[1] * inv, kr[2] * inv, kr[3] * inv};
                    u32x2 tw, ad; tw.x = pk2(ftanh(x[3][0]), ftanh(x[3][1])); tw.y = pk2(ftanh(x[3][2]), ftanh(x[3][3])); ad.x = pk2(x[4][0], x[4][1]); ad.y = pk2(x[4][2], x[4][3]);
                    *(u32x2*)(TWb + pt * 72 + pc4) = tw; *(u32x2*)(ADb + pt * 72 + pc4) = ad;
                }
                }
                __syncthreads();
                for (int rwr_ = 0; rwr_ < 1 + ((RWREP >> 1) & 1); ++rwr_) { if (rwr_) __syncthreads();
                {
                    f32x4 dw = (f32x4){0.f, 0.f, 0.f, 0.f}, da = dw;
#pragma unroll
                    for (int ks = 0; ks < 2; ++ks) {
                        const bf16x8 aw = *(const bf16x8*)(TWb + (tt * 16 + (lane & 15)) * 72 + ks * 32 + eq * 8), aa = *(const bf16x8*)(ADb + (tt * 16 + (lane & 15)) * 72 + ks * 32 + eq * 8);
                        const bf16x8 bw = *(const bf16x8*)(WUt + ech * 72 + ks * 32 + eq * 8), ba = *(const bf16x8*)(AUt + ech * 72 + ks * 32 + eq * 8);
                        mfma_safe(dw, aw, bw); mfma_safe(da, aa, ba);
                    }
                    float lw[4], kap[4], bet[4], kdv[4], rr[4], vvv[4];
#pragma unroll
                    for (int j = 0; j < 4; ++j) { const int tok = tt * 16 + eq * 4 + j;
                        const float wv = -0.606531f * sigm(e_w0 + dw[j]), av = sigm(e_a0 + da[j]);
                        const float ks_ = Ks[tok * 64 + ech], kkv = KKv[tok * 64 + ech], rs = Rv[tok * 64 + ech];
                        const float kd = ks_ * (1.f + (av - 1.f) * e_ka);
                        lw[j] = wv; kap[j] = kkv; bet[j] = kkv * av; kdv[j] = kd; rr[j] = rs; vvv[j] = Vv[tok * 64 + ech];
                        const float bs = rowsum16(rs * kd * e_rk);
                        if ((lane & 15) == 0) bonp[ct * 32 + tok] = bs; }
                    {
                        float pf[4];
                        if (!d) { pf[0] = lw[0]; pf[1] = pf[0] + lw[1]; pf[2] = pf[1] + lw[2]; pf[3] = pf[2] + lw[3]; }
                        else { pf[3] = lw[3]; pf[2] = pf[3] + lw[2]; pf[1] = pf[2] + lw[1]; pf[0] = pf[1] + lw[0]; }
                        const float gt = d ? pf[0] : pf[3];
                        float inc = gt;
                        { const float u1 = __int_as_float(__builtin_amdgcn_ds_bpermute((lane - 16) * 4, __float_as_int(inc))); if (eq >= 1) inc += u1; }
                        { const float u2 = __int_as_float(__builtin_amdgcn_ds_bpermute((lane - 32) * 4, __float_as_int(inc))); if (eq >= 2) inc += u2; }
                        const float tile_tot = __int_as_float(__builtin_amdgcn_ds_bpermute((48 + (lane & 15)) * 4, __float_as_int(inc)));
                        const float excl = d ? tile_tot - inc : inc - gt;
                        const int c = d ? 1 - tt : tt;
                        const int i0 = d ? 12 - 4 * eq : 4 * eq;
                        const int pech = (ct >> 1) * 32 + ((lane & 15) >> 2) * 8 + (ct & 1) * 4 + (lane & 3);
                        float bt4[4], kd4[4], vv4[4];
#pragma unroll
                        for (int j = 0; j < 4; ++j) { const float cum = pf[j] + excl, P = fexp(cum), Pm1 = fexp(cum - lw[j]), rP = fexp(-cum);
                            const int ii = d ? 3 - j : j, sp = c * 16 + i0 + ii;
                            KT[sp * 72 + pech] = f2bf(kap[j] * Pm1); BT[sp * 72 + pech] = f2bf(bet[j] * rP); KD[sp * 72 + pech] = f2bf(kdv[j] * rP); RT[sp * 72 + pech] = f2bf(rr[j] * P);
                            bt4[ii] = bet[j] * rP; kd4[ii] = kdv[j] * rP; vv4[ii] = vvv[j];
                            if (i0 + ii == 15) PC[c * 64 + ech] = P; }
                        u32x2 w2;
                        w2.x = pk2(bt4[0], bt4[1]); w2.y = pk2(bt4[2], bt4[3]); *(u32x2*)(BKt + (c * 64 + ech) * 40 + 2 * i0) = w2;
                        w2.x = pk2(kd4[0], kd4[1]); w2.y = pk2(kd4[2], kd4[3]); *(u32x2*)(BKt + (c * 64 + ech) * 40 + 2 * i0 + 4) = w2;
                        w2.x = pk2(vv4[0], vv4[1]); w2.y = pk2(vv4[2], vv4[3]); *(u32x2*)(UVt + (c * 64 + ech) * 40 + 16 + i0) = w2;
                    }
                }
                }
                __syncthreads();
                if (tid < 32) stc_f32(bon + ((size_t)d * MT + base + t_lo + tid) * 8 + h, (bonp[tid] + bonp[32 + tid]) + (bonp[64 + tid] + bonp[96 + tid]));
                if (fc + 1 < 72) RW_FETCH(fc + 1);
                int tid_o = tid; asm volatile("" : "+v"(tid_o));
                const int tid = tid_o, wid = __builtin_amdgcn_readfirstlane(tid_o >> 6), lane = tid_o & 63;
                for (int rwr_ = 0; rwr_ < 1 + ((RWREP >> 3) & 1); ++rwr_) { if (rwr_) __syncthreads();
                {
                    const int c = wid >> 2, which = wid & 3, c16 = lane & 15, q = lane >> 4;
                    const u16* X = (which < 2) ? KT : RT; const u16* Y = (which & 1) ? KD : BT;
                    f32x4 pa = (f32x4){0.f, 0.f, 0.f, 0.f};
#pragma unroll
                    for (int ks = 0; ks < 2; ++ks) { const bf16x8 a = *(const bf16x8*)(X + (c * 16 + c16) * 72 + ks * 32 + q * 8), bb = *(const bf16x8*)(Y + (c * 16 + c16) * 72 + ks * 32 + q * 8); mfma_safe(pa, a, bb); }
#pragma unroll
                    for (int j = 0; j < 4; ++j) { const int t = 4 * q + j, sx = c16; const bool keep = (which < 2) ? (sx < t) : (sx <= t); const float val = keep ? pa[j] : 0.f;
                        const int psx = (sx >> 2) * 8 + (sx & 3);
                        if (which == 0) { Amat[c * 256 + sx * 16 + t] = val; AB[(c * 16 + t) * 40 + psx] = (u16)0; }
                        else if (which == 1) AB[(c * 16 + t) * 40 + psx + 4] = f2bf(val);
                        else if (which == 2) CC[(c * 16 + t) * 40 + psx] = f2bf(val);
                        else CC[(c * 16 + t) * 40 + psx + 4] = f2bf(val); }
                    if (which == 0) {
                        LDSWAIT(); const int jcol = lane & 15; float part[16], an[16];
#pragma unroll
                        for (int t = 0; t < 16; ++t) part[t] = (t == jcol) ? 1.f : 0.f;
#pragma unroll
                        for (int t4 = 0; t4 < 4; ++t4) { const f32x4 av = *(const f32x4*)(Amat + c * 256 + t4 * 4); an[t4 * 4] = av[0]; an[t4 * 4 + 1] = av[1]; an[t4 * 4 + 2] = av[2]; an[t4 * 4 + 3] = av[3]; }
#pragma unroll
                        for (int sx = 0; sx < 16; ++sx) { const float xs = part[sx];
                            float acol[16];
#pragma unroll
                            for (int t = 0; t < 16; ++t) acol[t] = an[t];
                            if (sx + 1 < 16) {
#pragma unroll
                                for (int t4 = 0; t4 < 4; ++t4) { const f32x4 av = *(const f32x4*)(Amat + c * 256 + (sx + 1) * 16 + t4 * 4); an[t4 * 4] = av[0]; an[t4 * 4 + 1] = av[1]; an[t4 * 4 + 2] = av[2]; an[t4 * 4 + 3] = av[3]; } }
                            if (lane < 32) Tm[(c * 16 + sx) * 40 + (((lane & 15) >> 2) * 8 + (lane & 3) + (lane < 16 ? 0 : 4))] = lane < 16 ? f2bf(xs) : (u16)0;
#pragma unroll
                            for (int t = sx + 1; t < 16; ++t) part[t] -= acol[t] * xs; }
                    }
                }
                }
                __syncthreads();
                if (wid < 4) {
                    const int w = wid, c16 = lane & 15, q = lane >> 4;
#pragma unroll
                    for (int c = 0; c < 2; ++c) {
                        const bf16x8 kt0 = *(const bf16x8*)(KT + (c * 16 + c16) * 72 + q * 8), kt1 = *(const bf16x8*)(KT + (c * 16 + c16) * 72 + 32 + q * 8);
                        const bf16x8 ab = *(const bf16x8*)(AB + (c * 16 + c16) * 40 + q * 8);
                        const u32x2 vq = *(const u32x2*)(UVt + (c * 64 + w * 16 + c16) * 40 + 16 + 4 * q);
                        const bf16x8 tm = *(const bf16x8*)(Tm + (c * 16 + c16) * 40 + q * 8);
                        const bf16x8 rt0 = *(const bf16x8*)(RT + (c * 16 + c16) * 72 + q * 8), rt1 = *(const bf16x8*)(RT + (c * 16 + c16) * 72 + 32 + q * 8);
                        const bf16x8 cc = *(const bf16x8*)(CC + (c * 16 + c16) * 40 + q * 8);
                        bf16x8 bk[4]; f32x4 pcv[4];
#pragma unroll
                        for (int kt = 0; kt < 4; ++kt) { bk[kt] = *(const bf16x8*)(BKt + (c * 64 + kt * 16 + c16) * 40 + q * 8); pcv[kt] = *(const f32x4*)(PC + c * 64 + kt * 16 + 4 * q); }
                        const bf16x8 sb0 = __builtin_bit_cast(bf16x8, ((u32x4){pk2(SS[0][0], SS[0][1]), pk2(SS[0][2], SS[0][3]), pk2(SS[1][0], SS[1][1]), pk2(SS[1][2], SS[1][3])}));
                        const bf16x8 sb1 = __builtin_bit_cast(bf16x8, ((u32x4){pk2(SS[2][0], SS[2][1]), pk2(SS[2][2], SS[2][3]), pk2(SS[3][0], SS[3][1]), pk2(SS[3][2], SS[3][3])}));
                        const bf16x8 v0 = __builtin_bit_cast(bf16x8, ((u32x4){0u, 0u, vq.x, vq.y}));
                        f32x4 m = (f32x4){0.f, 0.f, 0.f, 0.f};
                        mfma_safe(m, kt0, sb0); mfma_safe(m, kt1, sb1); mfma_safe(m, ab, v0);
                        const bf16x8 mb = __builtin_bit_cast(bf16x8, ((u32x4){pk2(m[0], m[1]), pk2(m[2], m[3]), 0u, 0u}));
                        f32x4 u = (f32x4){0.f, 0.f, 0.f, 0.f};
                        mfma_safe(u, tm, mb);
                        const bf16x8 uv = __builtin_bit_cast(bf16x8, ((u32x4){pk2(-u[0], -u[1]), pk2(-u[2], -u[3]), vq.x, vq.y}));
                        f32x4 o = (f32x4){0.f, 0.f, 0.f, 0.f};
                        mfma_safe(o, sb0, rt0); mfma_safe(o, sb1, rt1); mfma_safe(o, uv, cc);
#pragma unroll
                        for (int kt = 0; kt < 4; ++kt) mfma_safe(SS[kt], bk[kt], uv);
                        { const int sp = c * 16 + c16, tk = d ? 31 - sp : sp; *(f32x4*)(Oc + tk * 68 + w * 16 + 4 * q) = o; }
#pragma unroll
                        for (int kt = 0; kt < 4; ++kt) {
#pragma unroll
                            for (int j = 0; j < 4; ++j) SS[kt][j] *= pcv[kt][j]; }
                    }
                }
                prev_row0 = base + t_lo;
            }
        }
#undef RW_FETCH
#undef RW_GEOM
        __syncthreads();
        { const f32x4 o = *(const f32x4*)(Oc + pt * 68 + pc4); stc_8(ob + ((size_t)d * MT + prev_row0 + pt) * 512 + h * 64 + pc4, pk4bf(o)); }
    }
}
#define RW_GG(p) ((u16*)((p).arena + (size_t)MT * 2048 * 2 + (size_t)2 * MT * 512 * 2 + (size_t)2 * MT * 8 * 4 + 4096))
__device__ __forceinline__ void rw_sg_rows(PP pp, int l, int r0) {
    PREF; l = uni(l); r0 = uni(r0); u16* pr = (u16*)p.arena;
    const int wid = tix >> 6, lane = tix & 63, l16 = lane & 15, sub = lane >> 4;
    const float* mu = p.in[I_rw_mu] + (size_t)l * 2 * 1920;
    float m0[8], m1[8];
#pragma unroll
    for (int e = 0; e < 8; ++e) { m0[e] = mu[1792 + l16 * 8 + e]; m1[e] = mu[1920 + 1792 + l16 * 8 + e]; }
    for (int row = r0 + ((int)blockIdx.x * 8 + wid) * 4 + sub; row < MT; row += (int)gridDim.x * 32) {
        int base, t, L; seq_of(row, base, t, L);
        const u16* q0 = pr + (size_t)row * 2048 + 1792 + l16 * 8;
        float pc[8], pm[8], pn[8], o[8];
        u32x4 vm = (u32x4){0u, 0u, 0u, 0u}, vn = vm; const u32x4 vc = ldc_16(q0);
        if (t > 0) vm = ldc_16(q0 - 2048);
        if (t < L - 1) vn = ldc_16(q0 + 2048);
        unpack8(vc, pc); unpack8(vm, pm); unpack8(vn, pn);
#pragma unroll
        for (int e = 0; e < 8; ++e) o[e] = sigm(pc[e] + m0[e] * (pm[e] - pc[e]) + m1[e] * (pn[e] - pc[e]));
        stc_16(pr + (size_t)row * 2048 + 1920 + l16 * 8, pack8(o));
    }
}
__device__ __forceinline__ void ph_rw_out(PP pp, int l, int r0, int w0, int nw) {
    PREF; l = uni(l); r0 = uni(r0); const u16* pr = (const u16*)p.arena; const u16* ob = (const u16*)(p.arena + (size_t)MT * 2048 * 2); const float* bon = (const float*)(p.arena + (size_t)MT * 2048 * 2 + (size_t)2 * MT * 512 * 2); const u16* gg = RW_GG(p);
    const int wid = (tix >> 6) - w0, lane = tix & 63, c0 = lane * 8, h = lane >> 3;
    if (wid < 0) return;
    const float* mu = p.in[I_rw_mu] + (size_t)l * 2 * 1920;
    float m0[8], m1[8], lg[8], lb[8];
#pragma unroll
    for (int e = 0; e < 8; ++e) { m0[e] = mu[1024 + c0 + e]; m1[e] = mu[1920 + 1024 + c0 + e]; lg[e] = p.in[I_rw_ln_g][l * 512 + c0 + e]; lb[e] = p.in[I_rw_ln_b][l * 512 + c0 + e]; }
    for (int row = r0 + blockIdx.x * nw + wid; row < MT; row += gridDim.x * nw) {
        int base, t, L; seq_of(row, base, t, L);
        const u16* q0 = pr + (size_t)row * 2048 + 1024 + c0;
        float pc[8], pm[8], pn[8], g[8], o[8];
        f32x4 a0, a1, b0, b1; ld8bf(ob + (size_t)row * 512 + c0, a0, a1); ld8bf(ob + ((size_t)MT + row) * 512 + c0, b0, b1);
        unpack8(ldc_16(q0), pc); unpack8(ldc_16(gg + (size_t)row * 512 + c0), g);
        if (t > 0) unpack8(ldc_16(q0 - 2048), pm); else { for (int e = 0; e < 8; ++e) pm[e] = 0.f; }
        if (t < L - 1) unpack8(ldc_16(q0 + 2048), pn); else { for (int e = 0; e < 8; ++e) pn[e] = 0.f; }
        const float bs = ldc_f32(bon + (size_t)row * 8 + h) + ldc_f32(bon + ((size_t)MT + row) * 8 + h);
        float sm = 0.f;
#pragma unroll
        for (int e = 0; e < 4; ++e) { o[e] = a0[e] + b0[e]; o[4 + e] = a1[e] + b1[e]; }
#pragma unroll
        for (int e = 0; e < 8; ++e) sm += o[e];
        const float mean = sum8lanes(sm) * (1.f / 64.f);
        float sv = 0.f;
#pragma unroll
        for (int e = 0; e < 8; ++e) { o[e] -= mean; sv += o[e] * o[e]; }
        const float rs = rsqrtf(sum8lanes(sv) * (1.f / 64.f) + 64e-5f);
        float y[8];
#pragma unroll
        for (int e = 0; e < 8; ++e) { const float v = pc[e] + m0[e] * (pm[e] - pc[e]) + m1[e] * (pn[e] - pc[e]); y[e] = (o[e] * rs * lg[e] + lb[e] + bs * v) * g[e]; }
        stc_16(p.y + ((size_t)MT + row) * 512 + c0, pack8(y));
    }
}

__device__ __forceinline__ void ph_s5_scan(PP pp, int l) {
    PREF; l = uni(l); const u16* ps = p.y + (size_t)3 * MT * 512; u16* ys0 = p.y + (size_t)2 * MT * 512; u16* ys1 = (u16*)(p.arena + (size_t)MT * 7232 + 4096);
    const int wid = tix >> 6, lane = tix & 63, c = lane & 15, q = lane >> 4;
    if (wid >= 4) return;
    float* X0 = (float*)(smem + wid * 29184);
    u16* Hs0 = (u16*)(smem + wid * 29184 + 20480);
    for (int sid = blockIdx.x + wid * gridDim.x; sid < 1024; sid += gridDim.x * 4) {
        const int b = sid >> 6, g = (sid >> 1) & 31, d = sid & 1;
        const float dt = expf(p.in[I_s5_log_dt][(l * 2 + d) * 32 + g]);
        const float* are_p = p.in[I_s5_a_re] + ((size_t)(l * 2 + d) * 32 + g) * 64; const float* aim_p = p.in[I_s5_a_im] + ((size_t)(l * 2 + d) * 32 + g) * 64;
        float abr, abi;
        { const float are = are_p[lane], aim = aim_p[lane]; const float mag = expf(are * dt), ang = aim * dt; abr = mag * cosf(ang); abi = mag * sinf(ang); }
        bf16x8 bfr[8];
#pragma unroll
        for (int tn = 0; tn < 4; ++tn) {
            const int n = tn * 16 + c;
            const float are = are_p[n], aim = aim_p[n]; const float mag = expf(are * dt), ang = aim * dt, ar = mag * cosf(ang), ai = mag * sinf(ang);
            const float nr = ar - 1.f, ni = ai, den = are * are + aim * aim, fre = (nr * are + ni * aim) / den, fim = (ni * are - nr * aim) / den;
            unsigned wr[4], wi[4];
#pragma unroll
            for (int j2 = 0; j2 < 4; ++j2) { float vr[2], vi[2];
#pragma unroll
                for (int e = 0; e < 2; ++e) { const int u = 8 * q + 2 * j2 + e; float br = 0.f, bi = 0.f;
                    if (q < 2) { br = p.in[I_s5_b_re][((size_t)(l * 32 + g) * 64 + n) * 16 + u]; bi = p.in[I_s5_b_im][((size_t)(l * 32 + g) * 64 + n) * 16 + u]; }
                    vr[e] = fre * br - fim * bi; vi[e] = fre * bi + fim * br; }
                wr[j2] = pk2(vr[0], vr[1]); wi[j2] = pk2(vi[0], vi[1]); }
            u32x4 t0 = (u32x4){wr[0], wr[1], wr[2], wr[3]}, t1 = (u32x4){wi[0], wi[1], wi[2], wi[3]};
            bfr[tn] = __builtin_bit_cast(bf16x8, t0); bfr[4 + tn] = __builtin_bit_cast(bf16x8, t1);
        }
        bf16x8 cfr[4];
#pragma unroll
        for (int ks = 0; ks < 4; ++ks) { unsigned w[4];
#pragma unroll
            for (int j2 = 0; j2 < 4; ++j2) { float v[2];
#pragma unroll
                for (int e = 0; e < 2; ++e) { const int n = ks * 16 + 4 * q + j2;
                    v[e] = e == 0 ? p.in[I_s5_c_re][((size_t)(l * 32 + g) * 16 + c) * 64 + n] : -p.in[I_s5_c_im][((size_t)(l * 32 + g) * 16 + c) * 64 + n]; }
                w[j2] = pk2(v[0], v[1]); }
            u32x4 t = (u32x4){w[0], w[1], w[2], w[3]}; cfr[ks] = __builtin_bit_cast(bf16x8, t); }
        float hr = 0.f, hi = 0.f;
#define S5_ROW(fc, i) ((fc) < 16 ? (b * 256 + (d ? 255 - (16 * (fc) + (i)) : 16 * (fc) + (i))) : (RC + b * 2048 + (d ? 2047 - (16 * ((fc) - 16) + (i)) : 16 * ((fc) - 16) + (i))))
        u32x4 ua = (u32x4){0u, 0u, 0u, 0u};
        if (q < 2) ua = ldc_16(ps + (size_t)S5_ROW(0, c) * 512 + g * 16 + q * 8);
#define S5_DRIVE(Xb, afr_) do { _Pragma("unroll") for (int tl = 0; tl < 8; ++tl) { f32x4 xa = (f32x4){0.f, 0.f, 0.f, 0.f}; mfma_safe(xa, afr_, bfr[tl]); \
            *(f32x4*)((Xb) + (tl * 16 + c) * 20 + 4 * q) = xa; } } while (0)
        { const bf16x8 afr0 = __builtin_bit_cast(bf16x8, ua); LDSWAIT(); S5_DRIVE(X0, afr0); }
        if (q < 2) ua = ldc_16(ps + (size_t)S5_ROW(1, c) * 512 + g * 16 + q * 8);
        for (int fc = 0; fc < 144; ++fc) {
            float* Xc = X0 + (fc & 1) * 2560; float* Xn = X0 + ((fc & 1) ^ 1) * 2560;
            float xr[16], xi[16];
#pragma unroll
            for (int t4 = 0; t4 < 4; ++t4) { const f32x4 vr = *(const f32x4*)(Xc + lane * 20 + 4 * t4), vi = *(const f32x4*)(Xc + (64 + lane) * 20 + 4 * t4);
#pragma unroll
                for (int e = 0; e < 4; ++e) { xr[4 * t4 + e] = vr[e]; xi[4 * t4 + e] = vi[e]; } }
            if (fc + 1 < 144) { const bf16x8 afr = __builtin_bit_cast(bf16x8, ua);
                if (q < 2 && fc + 2 < 144) ua = ldc_16(ps + (size_t)S5_ROW(fc + 2, c) * 512 + g * 16 + q * 8);
                S5_DRIVE(Xn, afr); }
            u16* Hs = Hs0 + (fc & 1) * 2176; const u16* Hp = Hs0 + ((fc & 1) ^ 1) * 2176;
            bf16x8 hf[4];
            if (fc > 0) {
#pragma unroll
                for (int ks = 0; ks < 4; ++ks) hf[ks] = *(const bf16x8*)(Hp + c * 136 + ks * 32 + q * 8); }
#pragma unroll
            for (int tk = 0; tk < 16; ++tk) {
                const float nhr = abr * hr - abi * hi + xr[tk], nhi = abr * hi + abi * hr + xi[tk]; hr = nhr; hi = nhi;
                *(unsigned*)(Hs + tk * 136 + 2 * lane) = pk2(hr, hi);
            }
            if (fc > 0) {
                f32x4 ya = (f32x4){0.f, 0.f, 0.f, 0.f};
#pragma unroll
                for (int ks = 0; ks < 4; ++ks) mfma_safe(ya, cfr[ks], hf[ks]);
                stc_8((d ? ys1 : ys0) + (size_t)S5_ROW(fc - 1, c) * 512 + g * 16 + 4 * q, pk4bf(ya)); }
            LDSWAIT();
        }
        {
            const u16* Hp = Hs0 + (143 & 1) * 2176;
            f32x4 ya = (f32x4){0.f, 0.f, 0.f, 0.f};
#pragma unroll
            for (int ks = 0; ks < 4; ++ks) { const bf16x8 hfl = *(const bf16x8*)(Hp + c * 136 + ks * 32 + q * 8); mfma_safe(ya, cfr[ks], hfl); }
            stc_8((d ? ys1 : ys0) + (size_t)S5_ROW(143, c) * 512 + g * 16 + 4 * q, pk4bf(ya));
        }
#undef S5_DRIVE
#undef S5_ROW
    }
}
__device__ __forceinline__ void ph_s5_act(PP pp, int l, int r0) {
    PREF; l = uni(l); r0 = uni(r0); const u16* ps = p.y + (size_t)3 * MT * 512; const u16* ys0 = p.y + (size_t)2 * MT * 512; const u16* ys1 = (const u16*)(p.arena + (size_t)MT * 7232 + 4096); u16* ya = (u16*)(p.arena + (size_t)MT * 512 * 2 + (size_t)2 * MT * 512 * 4);
    const int wid = tix >> 6, lane = tix & 63, c0 = lane * 8;
    float dsk[8];
#pragma unroll
    for (int e = 0; e < 8; ++e) dsk[e] = p.in[I_s5_d][l * 512 + c0 + e];
    for (int row = r0 + blockIdx.x * 8 + wid; row < MT; row += gridDim.x * 8) {
        f32x4 a0, a1, b0, b1; ld8bf(ys0 + (size_t)row * 512 + c0, a0, a1); ld8bf(ys1 + (size_t)row * 512 + c0, b0, b1);
        float u[8], o[8]; unpack8(ldc_16(ps + (size_t)row * 512 + c0), u);
#pragma unroll
        for (int e = 0; e < 8; ++e) { const float x = (e < 4 ? a0[e & 3] + b0[e & 3] : a1[e & 3] + b1[e & 3]) + dsk[e] * u[e]; o[e] = 0.5f * x * (1.f + ftanh(0.7978845608028654f * (x + 0.044715f * x * x * x))); }
        stc_16(ya + (size_t)row * 512 + c0, pack8(o));
    }
}

typedef __amdgpu_buffer_rsrc_t brsrc_t;
__device__ __forceinline__ brsrc_t mk_rsrc(const void* base, unsigned bytes) { return __builtin_amdgcn_make_buffer_rsrc((void*)base, (short)0, (int)bytes, 0x00020000); }
__device__ __forceinline__ u32x4 ld16_sc1(brsrc_t r, unsigned off) { return __builtin_bit_cast(u32x4, __builtin_amdgcn_raw_buffer_load_b128(r, (int)off, 0, SC1_AUX)); }
__device__ __forceinline__ unsigned ld4_sc1(brsrc_t r, unsigned off) { return __builtin_amdgcn_raw_buffer_load_b32(r, (int)off, 0, SC1_AUX); }
__device__ __forceinline__ void ph_gla_scan(PP pp, int l) {
    PREF; l = uni(l); const u16* pg = (const u16*)p.arena; u16* og = (u16*)(p.arena + (size_t)MT * 1792 * 2);
    const int tid = tix, wid = tid >> 6, lane = tid & 63, c = lane & 15, q = lane >> 4;
    const brsrc_t pgr = mk_rsrc(pg, (unsigned)((size_t)MT * 1792 * 2));
    u16* QT = (u16*)smem; u16* KT = QT + 4608; u16* QH = KT + 4608; u16* KHt = QH + 4608; u16* Vt = KHt + 4608; u16* Pm = Vt + 4608; u16* St = Pm + 4608;
    float* CUM = (float*)(St + 4608); float* TOT = CUM + 4096; float* GB = TOT + 512; float* DEC = GB + 64;
    u16* GUt = (u16*)(DEC + 64); u16* GDp = GUt + 64 * 40;
    const int tok = tid >> 3, c8 = (tid & 7) * 8;
    for (int item = blockIdx.x; item < 256; item += gridDim.x) {
        const int b = item >> 4, h = (item >> 2) & 3, d = (item >> 1) & 1, eh = item & 1;
        __syncthreads();
        for (int i = tid; i < 64 * 40; i += NT) { const int chn = i / 40, m = i - chn * 40; GUt[i] = m < 16 ? f2bf(p.in[I_gla_gate_up][((size_t)(l * 2 + d) * 16 + m) * 256 + h * 64 + chn]) : (u16)0; GDp[i] = (u16)0; GDp[64 * 40 + i] = (u16)0; }
        if (tid < 64) GB[tid] = p.in[I_gla_gate_b][(l * 2 + d) * 256 + h * 64 + tid];
        f32x4 sacc[2];
        sacc[0] = (f32x4){0.f, 0.f, 0.f, 0.f}; sacc[1] = sacc[0];
#define GLA_ROW(s) ((s) < 256 ? (b * 256 + (d ? 255 - (s) : (s))) : (RC + b * 2048 + ((((d ? 2047 - ((s) - 256) : ((s) - 256)) & 31) * 64) + ((d ? 2047 - ((s) - 256) : ((s) - 256)) >> 5))))
        u32x4 rq, rk, rv; unsigned rg;
        { const unsigned ro = (unsigned)GLA_ROW(tok) * 3584u; rq = ld16_sc1(pgr, ro + (h * 64 + c8) * 2); rk = ld16_sc1(pgr, ro + (256 + h * 64 + c8) * 2);
          rv = ld16_sc1(pgr, ro + (512 + h * 128 + eh * 64 + c8) * 2); rg = ld4_sc1(pgr, ro + (1536 + d * 16 + (tid & 7) * 2) * 2); }
        for (int ch = 0; ch < 36; ++ch) {
            const u32x4 cq = rq, ck = rk, cv = rv; const unsigned cg = rg;
            u16* GDc = GDp + (ch & 1) * (64 * 40);
            *(unsigned*)(GDc + tok * 40 + (tid & 7) * 2) = cg;
            __syncthreads();
            if (ch + 1 < 36) { const unsigned ro = (unsigned)GLA_ROW((ch + 1) * 64 + tok) * 3584u; rq = ld16_sc1(pgr, ro + (h * 64 + c8) * 2); rk = ld16_sc1(pgr, ro + (256 + h * 64 + c8) * 2);
                rv = ld16_sc1(pgr, ro + (512 + h * 128 + eh * 64 + c8) * 2); rg = ld4_sc1(pgr, ro + (1536 + d * 16 + (tid & 7) * 2) * 2); }
#pragma unroll
            for (int s2 = 0; s2 < 2; ++s2) { const int id = wid * 2 + s2, tt = id >> 2, ct = id & 3;
                f32x4 g4 = (f32x4){0.f, 0.f, 0.f, 0.f};
                { const bf16x8 a = *(const bf16x8*)(GDc + (tt * 16 + c) * 40 + q * 8), bb = *(const bf16x8*)(GUt + (ct * 16 + c) * 40 + q * 8); mfma_safe(g4, a, bb); }
                const float gb = GB[ct * 16 + c]; float pf[4];
#pragma unroll
                for (int j = 0; j < 4; ++j) { const float x = g4[j] + gb; pf[j] = (fminf(x, 0.f) - __builtin_amdgcn_logf(1.f + fexp(-fabsf(x))) * 0.6931471805599453f) * (1.f / 16.f); }
                pf[1] += pf[0]; pf[2] += pf[1]; pf[3] += pf[2];
                float sgrp = pf[3];
                { const float u1 = __int_as_float(__builtin_amdgcn_ds_bpermute((lane - 16) * 4, __float_as_int(sgrp))); if (q >= 1) sgrp += u1; }
                { const float u2 = __int_as_float(__builtin_amdgcn_ds_bpermute((lane - 32) * 4, __float_as_int(sgrp))); if (q >= 2) sgrp += u2; }
                const float excl = sgrp - pf[3];
#pragma unroll
                for (int j = 0; j < 4; ++j) CUM[(tt * 16 + 4 * q + j) * 64 + ct * 16 + c] = pf[j] + excl;
                if (q == 3) TOT[tt * 64 + ct * 16 + c] = sgrp; }
            __syncthreads();
            {
                float cm[8], rf[8], la[8];
                { const int tt = tok >> 4;
#pragma unroll
                  for (int hh = 0; hh < 2; ++hh) { const f32x4 mv = *(const f32x4*)(CUM + tok * 64 + c8 + 4 * hh), fv = *(const f32x4*)(CUM + 31 * 64 + c8 + 4 * hh), lv = *(const f32x4*)(CUM + 63 * 64 + c8 + 4 * hh);
                      const f32x4 t0 = *(const f32x4*)(TOT + c8 + 4 * hh), t1 = *(const f32x4*)(TOT + 64 + c8 + 4 * hh), t2 = *(const f32x4*)(TOT + 128 + c8 + 4 * hh);
#pragma unroll
                      for (int e = 0; e < 4; ++e) { cm[4 * hh + e] = mv[e] + (tt >= 1 ? t0[e] : 0.f) + (tt >= 2 ? t1[e] : 0.f) + (tt >= 3 ? t2[e] : 0.f); rf[4 * hh + e] = fv[e] + t0[e]; la[4 * hh + e] = lv[e] + (t0[e] + t1[e]) + t2[e]; } }
                  if (tok == 63) {
#pragma unroll
                      for (int e = 0; e < 8; ++e) DEC[c8 + e] = fexp(la[e]); } }
                const unsigned qw[4] = {cq.x, cq.y, cq.z, cq.w}, kw[4] = {ck.x, ck.y, ck.z, ck.w}, vw[4] = {cv.x, cv.y, cv.z, cv.w};
                float qt[8], kt[8], qh[8], kh[8];
#pragma unroll
                for (int e = 0; e < 8; ++e) {
                    const float qv = (e & 1 ? __uint_as_float(qw[e >> 1] & 0xffff0000u) : __uint_as_float(qw[e >> 1] << 16)) * 0.125f;
                    const float kv = (e & 1 ? __uint_as_float(kw[e >> 1] & 0xffff0000u) : __uint_as_float(kw[e >> 1] << 16));
                    const float e1 = fexp(cm[e] - rf[e]), r1 = fexp(rf[e] - cm[e]);
                    qt[e] = qv * e1; kt[e] = kv * r1; qh[e] = qt[e] * fexp(rf[e]); kh[e] = kt[e] * fexp(la[e] - rf[e]);
                }
                u32x4 w;
                w.x = pk2(qt[0], qt[1]); w.y = pk2(qt[2], qt[3]); w.z = pk2(qt[4], qt[5]); w.w = pk2(qt[6], qt[7]); *(u32x4*)(QT + tok * 72 + c8) = w;
                w.x = pk2(kt[0], kt[1]); w.y = pk2(kt[2], kt[3]); w.z = pk2(kt[4], kt[5]); w.w = pk2(kt[6], kt[7]); *(u32x4*)(KT + tok * 72 + c8) = w;
                w.x = pk2(qh[0], qh[1]); w.y = pk2(qh[2], qh[3]); w.z = pk2(qh[4], qh[5]); w.w = pk2(qh[6], qh[7]); *(u32x4*)(QH + tok * 72 + c8) = w;
#pragma unroll
                for (int e = 0; e < 8; ++e) { KHt[(c8 + e) * 72 + tok] = f2bf(kh[e]); Vt[(c8 + e) * 72 + tok] = (u16)(e & 1 ? (vw[e >> 1] >> 16) : (vw[e >> 1] & 0xffffu)); }
#pragma unroll
                for (int s2 = 0; s2 < 2; ++s2) { const int id = wid * 2 + s2, dkt = id >> 2, et = id & 3;
                    u32x2 sw; sw.x = pk2(sacc[s2][0], sacc[s2][1]); sw.y = pk2(sacc[s2][2], sacc[s2][3]); *(u32x2*)(St + (et * 16 + c) * 72 + dkt * 16 + 4 * q) = sw; }
            }
            __syncthreads();
#pragma unroll
            for (int s2 = 0; s2 < 2; ++s2) { const int id = wid * 2 + s2, it = id >> 2, jt = id & 3;
                f32x4 pa = (f32x4){0.f, 0.f, 0.f, 0.f};
                if (jt <= it) {
#pragma unroll
                    for (int ks = 0; ks < 2; ++ks) { const bf16x8 a = *(const bf16x8*)(QT + (it * 16 + c) * 72 + ks * 32 + q * 8), bb = *(const bf16x8*)(KT + (jt * 16 + c) * 72 + ks * 32 + q * 8); mfma_safe(pa, a, bb); } }
#pragma unroll
                for (int jj = 0; jj < 4; ++jj) { const int i = it * 16 + 4 * q + jj, j = jt * 16 + c; Pm[i * 72 + j] = f2bf(i >= j ? pa[jj] : 0.f); } }
            __syncthreads();
#pragma unroll
            for (int s2 = 0; s2 < 2; ++s2) { const int id = wid * 2 + s2, it = id >> 2, et = id & 3;
                f32x4 oa = (f32x4){0.f, 0.f, 0.f, 0.f};
#pragma unroll
                for (int ks = 0; ks < 2; ++ks) { const bf16x8 a = *(const bf16x8*)(Vt + (et * 16 + c) * 72 + ks * 32 + q * 8), bb = *(const bf16x8*)(Pm + (it * 16 + c) * 72 + ks * 32 + q * 8); mfma_safe(oa, a, bb); }
#pragma unroll
                for (int ks = 0; ks < 2; ++ks) { const bf16x8 a = *(const bf16x8*)(St + (et * 16 + c) * 72 + ks * 32 + q * 8), bb = *(const bf16x8*)(QH + (it * 16 + c) * 72 + ks * 32 + q * 8); mfma_safe(oa, a, bb); }
                stc_8(og + ((size_t)d * MT + GLA_ROW(ch * 64 + it * 16 + c)) * 512 + h * 128 + eh * 64 + et * 16 + 4 * q, pk4bf(oa));
                const int dkt = it;
#pragma unroll
                for (int jj = 0; jj < 4; ++jj) sacc[s2][jj] *= DEC[dkt * 16 + 4 * q + jj];
#pragma unroll
                for (int ks = 0; ks < 2; ++ks) { const bf16x8 a = *(const bf16x8*)(KHt + (dkt * 16 + c) * 72 + ks * 32 + q * 8), bb = *(const bf16x8*)(Vt + (et * 16 + c) * 72 + ks * 32 + q * 8); mfma_safe(sacc[s2], a, bb); }
            }
        }
#undef GLA_ROW
    }
}
__device__ __forceinline__ void ph_gla_out(PP pp, int l, int r0) {
    PREF; l = uni(l); r0 = uni(r0); const u16* pg = (const u16*)p.arena; const u16* og = (const u16*)(p.arena + (size_t)MT * 1792 * 2);
    const int wid = tix >> 6, lane = tix & 63, c0 = lane * 8;
    float ng[8];
#pragma unroll
    for (int e = 0; e < 8; ++e) ng[e] = p.in[I_gla_norm_g][l * 128 + ((c0 + e) & 127)];
    for (int row = r0 + blockIdx.x * 8 + wid; row < MT; row += gridDim.x * 8) {
        f32x4 a0, a1, b0, b1; ld8bf(og + (size_t)row * 512 + c0, a0, a1); ld8bf(og + ((size_t)MT + row) * 512 + c0, b0, b1);
        float g[8], o[8], y[8]; unpack8(ldc_16(pg + (size_t)row * 1792 + 1024 + c0), g);
        float ss = 0.f;
#pragma unroll
        for (int e = 0; e < 4; ++e) { o[e] = a0[e] + b0[e]; o[4 + e] = a1[e] + b1[e]; }
#pragma unroll
        for (int e = 0; e < 8; ++e) ss += o[e] * o[e];
        const float rs = rsqrtf(rowsum16(ss) * (1.f / 128.f) + 1e-6f);
#pragma unroll
        for (int e = 0; e < 8; ++e) y[e] = o[e] * rs * ng[e] * g[e] * sigm(g[e]);
        stc_16(p.y + ((size_t)3 * MT + row) * 512 + c0, pack8(y));
    }
}


__device__ __forceinline__ void ph_moe_slot(PP pp) {
    PREF;
    const int G = (int)gridDim.x, wid = tix >> 6, lane = tix & 63;
    int* tab = (int*)smem; int* sh = tab + 8 * G;
    __syncthreads();
    for (int i = tix; i < 8 * G; i += NT) tab[i] = (int)ldc_u32(p.moe_i + 1024 + i);
    __syncthreads();
    if (tix < 8) { int tot = 0, mine = 0; for (int b = 0; b < G; ++b) { const int c = tab[b * 8 + tix]; if (b < (int)blockIdx.x) mine += c; tot += c; } sh[17 + tix] = tot; sh[tix] = mine; }
    __syncthreads();
    if (tix == 0) { int ps = 0, nt = 0;
#pragma unroll 1
        for (int e = 0; e < 8; ++e) { sh[8 + e] = ps; const int tl = (sh[17 + e] + 255) / 256;
            if (blockIdx.x == 0) { int ev = e; asm volatile("" : "+v"(ev));
#pragma unroll 1
                for (int j = 0; j < tl; ++j) stc_u32(p.moe_i + 32 + nt + j, (unsigned)ev); }
            nt += tl; ps += tl * 256; }
        sh[16] = ps; if (blockIdx.x == 0) stc_u32(p.moe_i + 25, (unsigned)nt); }
    __syncthreads();
    for (int row = RC + blockIdx.x * 8 + wid; row < MT; row += G * 8) {
        const int tok = row - RC;
        const int e0 = (int)ldc_u32(p.top_i + tok * 2), e1 = (int)ldc_u32(p.top_i + tok * 2 + 1), k0 = (int)ldc_u32(p.row_tok + tok * 2), k1 = (int)ldc_u32(p.row_tok + tok * 2 + 1);
        const int d0 = sh[8 + e0] + sh[e0] + k0, d1 = sh[8 + e1] + sh[e1] + k1;
        if (lane == 0) { stc_u32(p.dest_of + tok * 2, (unsigned)d0); stc_u32(p.dest_of + tok * 2 + 1, (unsigned)d1); }
        const u32x4 a = ldc_16((const char*)p.hn + (size_t)row * 1024 + lane * 16);
        stc_16((char*)p.xb8 + (size_t)d0 * 1024 + lane * 16, a); stc_16((char*)p.xb8 + (size_t)d1 * 1024 + lane * 16, a);
    }
}
__device__ __forceinline__ void ph_final(PP pp) {
    PREF;
    const int wid = tix >> 6, lane = tix & 63;
    const float* g = p.in[I_final_norm_g];
    for (int tok = blockIdx.x * 8 + wid; tok < 32768; tok += gridDim.x * 8) {
        const float* gt = p.mod + (size_t)(17 + (tok >> 11)) * 6144 + 5120;
        const int d0 = (int)ldc_u32(p.dest_of + tok * 2), d1 = (int)ldc_u32(p.dest_of + tok * 2 + 1); const float g0 = ldc_f32(p.top_g + tok * 2), g1 = ldc_f32(p.top_g + tok * 2 + 1);
        float* hp = p.out + (size_t)tok * 1024;
        f32x4 v[4]; float ss = 0.f;
#pragma unroll
        for (int i = 0; i < 4; ++i) { const int k = i * 256 + lane * 4;
            const u32x2 a = ldc_8(p.yb + (size_t)d0 * 1024 + k), b = ldc_8(p.yb + (size_t)d1 * 1024 + k);
            const u32x2 hw = ldc_8(p.xr + (size_t)(RC + tok) * 1024 + k); const f32x4 hh = (f32x4){__uint_as_float(hw.x << 16), __uint_as_float(hw.x & 0xffff0000u), __uint_as_float(hw.y << 16), __uint_as_float(hw.y & 0xffff0000u)}, gg = *(const f32x4*)(gt + k);
            float ya[4] = {__uint_as_float(a.x << 16), __uint_as_float(a.x & 0xffff0000u), __uint_as_float(a.y << 16), __uint_as_float(a.y & 0xffff0000u)};
            float yc[4] = {__uint_as_float(b.x << 16), __uint_as_float(b.x & 0xffff0000u), __uint_as_float(b.y << 16), __uint_as_float(b.y & 0xffff0000u)};
#pragma unroll
            for (int j = 0; j < 4; ++j) { v[i][j] = hh[j] + gg[j] * (g0 * ya[j] + g1 * yc[j]); ss += v[i][j] * v[i][j]; } }
        ss = wsum(ss); const float rs = rsqrtf(ss * (1.f / 1024.f) + 1e-6f);
#pragma unroll
        for (int i = 0; i < 4; ++i) { const int k = i * 256 + lane * 4; const f32x4 gg = *(const f32x4*)(g + k); f32x4 o;
#pragma unroll
            for (int j = 0; j < 4; ++j) o[j] = v[i][j] * rs * gg[j];
            stc_f4(hp + k, o); }
    }
}


__device__ __forceinline__ GPb mkg(const u16* A, long lda, const u16* Bt, long ldb, int K, int tm0, int ntm, int ntn) { GPb g; g.A = A; g.lda = lda; g.Bt = Bt; g.ldb = ldb; g.Kd = K; g.tm0 = tm0; g.ntm = ntm; g.ntn = ntn; return g; }
#define BIGG (1 << 30)
__device__ __forceinline__ void ph_gemm_in(PP pp, int l, int part) {
    PREF; l = uni(l); part = uni(part);
    const int last = (l == 1);
    const u16* wt = p.wt_in + (size_t)l * 9984 * 1024;
    Dense8<PrStore> g;
    if (part == 0) { (GPb&)g = mkg(p.hn, 1024, wt, 1024, 1024, last ? 16 : 0, last ? 128 : 144, 6); g.ldo = 1536; g.act = 0; }
    else if (part == 1) { (GPb&)g = mkg(p.hn, 1024, wt + (size_t)1536 * 1024, 1024, 1024, 0, 144, 8); g.ldo = 2048; g.act = 0; }
    else if (part == 2) { (GPb&)g = mkg(p.hn, 1024, wt + (size_t)3584 * 1024, 1024, 1024, 0, 144, 2); g.ldo = 512; g.act = 0; }
    else if (part == 3) { (GPb&)g = mkg(p.hn, 1024, wt + (size_t)4096 * 1024, 1024, 1024, 0, 144, 7); g.ldo = 1792; g.act = 0; }
    else { (GPb&)g = mkg(p.hn, 1024, wt + (size_t)5888 * 1024, 1024, 1024, last ? 16 : 0, last ? 128 : 144, 16); g.ldo = 4096; g.act = 1; }
    g.O = part == 2 ? p.y + (size_t)3 * MT * 512 : (u16*)p.arena;
    if (FP8IN_LAST && last && part < 4) {
        const int roff = part == 0 ? 0 : part == 1 ? 1536 : part == 2 ? 3584 : 4096;
        Dense8F<PrStore> g8; (GPb&)g8 = (GPb&)g; g8.A = (const u16*)HN8(p); g8.Bt = (const u16*)((const char*)p.wt_in8 + (size_t)roff * 1024); g8.O = g.O; g8.ldo = g.ldo; g8.act = 0; g8.sa_ = 127; g8.sb_ = 122;
        GEMM8F(g8);
    } else GEMM8(g);
}
__device__ __forceinline__ void ph_hn8(PP pp, int r0) {
    PREF; r0 = uni(r0);
    const int wid = tix >> 6, lane = tix & 63;
    for (int row = r0 + blockIdx.x * 8 + wid; row < MT; row += gridDim.x * 8) {
        float a[8], b[8]; unpack8(ldc_16(p.hn + (size_t)row * 1024 + lane * 16), a); unpack8(ldc_16(p.hn + (size_t)row * 1024 + lane * 16 + 8), b);
        u32x4 w; w.x = pk4_fp8(a[0], a[1], a[2], a[3]); w.y = pk4_fp8(a[4], a[5], a[6], a[7]); w.z = pk4_fp8(b[0], b[1], b[2], b[3]); w.w = pk4_fp8(b[4], b[5], b[6], b[7]);
        stc_16(HN8(p) + (size_t)row * 1024 + lane * 16, w);
    }
}
__device__ __forceinline__ void ph_gemm_gates(PP pp, int l) {
    PREF; l = uni(l); const int last = (l == 1);
    Dense8F<PrGate> g; (GPb&)g = mkg((const u16*)HN8(p), 1024, (const u16*)((const char*)p.wt_gate8 + (size_t)l * 4096 * 1024), 1024, 1024, last ? 16 : 0, last ? 128 : 144, 16); g.O = (u16*)p.arena; g.sa_ = 127; g.sb_ = 122;
    GEMM8F(g);
}
__device__ __forceinline__ void ph_gemm_in12(PP pp, int l) {
    PREF; l = uni(l);
    In12 g; g.A = p.hn; g.Wt = p.wt_in + (size_t)l * 9984 * 1024; g.Orw = (u16*)p.arena; g.Os5 = p.y + (size_t)3 * MT * 512;
    GEMM8(g);
}
__device__ __forceinline__ void ph_gemm_rwg(PP pp, int l) {
    PREF; l = uni(l); const int last = (l == 1);
    Dense8<PrStore> g; (GPb&)g = mkg((const u16*)p.arena + 1792, 2048, p.wt_g + (size_t)l * 512 * 256, 256, 256, last ? 16 : 0, last ? 128 : 144, 2); g.O = RW_GG(p); g.ldo = 512; g.act = 0;
    GEMM8(g);
}
__device__ __forceinline__ void ph_gemm_glu(PP pp, int l) {
    PREF; l = uni(l); const int last = (l == 1);
    u16* ya = (u16*)(p.arena + (size_t)MT * 512 * 2 + (size_t)2 * MT * 512 * 4);
    Dense8<PrGlu> q; (GPb&)q = mkg(ya, 512, p.wt_glu + (size_t)l * 512 * 512, 512, 512, last ? 16 : 0, last ? 128 : 144, 2); q.ya = ya; q.gb = p.in[I_s5_glu_b] + l * 512; q.O = p.y + (size_t)2 * MT * 512;
    GEMM8(q);
}
__device__ __forceinline__ void ph_gemm_branch4(PP pp, int l) {
    PREF; l = uni(l); const int last = (l == 1);
    Branch8 q; q.y = p.y; q.wt = p.wt_br + (size_t)l * 4 * 1024 * 512; q.G = (u16*)p.arena; q.acc = p.hn; q.tm0 = last ? 16 : 0; q.ntm = last ? 128 : 144;
    GEMM8(q);
}
__device__ __forceinline__ void ph_gemm_resid(PP pp, int l, int which, float scale) {
    PREF; l = uni(l); which = uni(which); const int last = (l == 1), first = (l == 0);
    Dense8<PrResid> r;
    if (which == 0) { (GPb&)r = mkg(p.hn, 1024, p.wt_out + (size_t)l * 1024 * 1024, 1024, 1024, last ? 16 : 0, last ? 128 : 144, 4);
        r.first = first; r.goff = 2048; }
    else { (GPb&)r = mkg((const u16*)p.arena, 2816, p.wt_f2, 2816, 2816, 0, 144, 4); r.first = 0; r.goff = 5120; }
    r.oc = p.in[I_ctx]; r.ol = p.in[I_x]; r.xr = p.xr; r.pad2_ = 0; r.mod = p.mod + (size_t)l * 17 * 6144; r.scale = scale;
    GEMM8(r);
}
__device__ __forceinline__ void ph_gemm_ffn_up(PP pp) {
    PREF;
    Dense8<PrSwiglu> s; (GPb&)s = mkg(p.hn, 1024, p.wt_f13, 1024, 1024, 0, 144, 22); s.G = (u16*)p.arena; s.ldg = 2816;
    GEMM8(s);
}
__device__ __forceinline__ void ph_gemm_moe_up(PP pp, int ch) {
    PREF; ch = uni(ch);
    MoeUp8F u; u.xb8 = (const char*)p.xb8; u.mi = p.moe_i; u.W8 = (const char*)p.wt_m13; u.G8 = (char*)p.gch; u.t0 = ch * 128; u.nt = ch ? 136 : 128;
    GEMM8F(u);
}
__device__ __forceinline__ void ph_gemm_moe_down(PP pp, int ch) {
    PREF; ch = uni(ch);
    MoeDown8F dn; dn.G8 = (const char*)p.gch; dn.mi = p.moe_i; dn.W8 = (const char*)p.wt_m2; dn.yb = p.yb; dn.t0 = ch * 128; dn.nt = ch ? 136 : 128;
    GEMM8F(dn);
}
__device__ __forceinline__ void ph_prep(PP pp) {
    PREF; int rot = 0;
    for (int l = 0; l < 2; ++l) {
        const float* wi = p.in[I_w_in] + (size_t)l * 1024 * 9632; u16* wt = p.wt_in + (size_t)l * 9984 * 1024;
        do_transpose(wi + 0, 1024, 1536, 9632, wt, BIGG, 0, 0, smem, 0, &rot);
        do_transpose(wi + 1536, 1024, 1920, 9632, wt, BIGG, 0, 1536, smem, 0, &rot);
        do_transpose(wi + 3456, 1024, 512, 9632, wt, BIGG, 0, 3584, smem, 0, &rot);
        do_transpose(wi + 3968, 1024, 1568, 9632, wt, BIGG, 0, 4096, smem, 0, &rot);
        do_transpose(wi + 5536, 1024, 4096, 9632, (u16*)((char*)p.wt_gate8 + (size_t)l * 4096 * 1024), BIGG, 0, 0, smem, 1, &rot);
        if (FP8IN_LAST && l == 1) { do_transpose(wi + 0, 1024, 1536, 9632, p.wt_in8, BIGG, 0, 0, smem, 1, &rot); do_transpose(wi + 1536, 1024, 1920, 9632, p.wt_in8, BIGG, 0, 1536, smem, 1, &rot);
                      do_transpose(wi + 3456, 1024, 512, 9632, p.wt_in8, BIGG, 0, 3584, smem, 1, &rot); do_transpose(wi + 3968, 1024, 1568, 9632, p.wt_in8, BIGG, 0, 4096, smem, 1, &rot); }
        for (int m = 0; m < 4; ++m) do_transpose(p.in[I_w_branch] + (size_t)(l * 4 + m) * 512 * 1024, 512, 1024, 1024, p.wt_br + (size_t)(l * 4 + m) * 1024 * 512, BIGG, 0, 0, smem, 0, &rot);
        do_transpose(p.in[I_w_out] + (size_t)l * 1024 * 1024, 1024, 1024, 1024, p.wt_out + (size_t)l * 1024 * 1024, BIGG, 0, 0, smem, 0, &rot);
        do_transpose(p.in[I_s5_glu_w] + (size_t)l * 512 * 512, 512, 512, 512, p.wt_glu + (size_t)l * 512 * 512, BIGG, 0, 0, smem, 0, &rot);
        for (int i = blockIdx.x * NT + tix; i < 128 * 512; i += gridDim.x * NT) { const int n = i >> 7, k = i & 127; p.wt_g[((size_t)l * 512 + n) * 256 + 128 + k] = f2bf(p.in[I_rw_g_up][((size_t)l * 128 + k) * 512 + n]); }
    }
    do_transpose(p.in[I_ffn_w1], 1024, 2816, 2816, p.wt_f13, 128, 256, 0, smem, 0, &rot);
    do_transpose(p.in[I_ffn_w3], 1024, 2816, 2816, p.wt_f13, 128, 256, 128, smem, 0, &rot);
    do_transpose(p.in[I_ffn_w2], 2816, 1024, 1024, p.wt_f2, BIGG, 0, 0, smem, 0, &rot);
}
__device__ __forceinline__ void ph_prep_moe(PP pp) {
    PREF; int rot = 0;
    for (int e = 0; e < 8; ++e) {
        do_transpose(p.in[I_moe_w1] + (size_t)e * 1024 * 3584, 1024, 3584, 3584, (u16*)((char*)p.wt_m13 + (size_t)e * 7168 * 1024), 128, 256, 0, smem, 1, &rot);
        do_transpose(p.in[I_moe_w3] + (size_t)e * 1024 * 3584, 1024, 3584, 3584, (u16*)((char*)p.wt_m13 + (size_t)e * 7168 * 1024), 128, 256, 128, smem, 1, &rot);
        do_transpose(p.in[I_moe_w2] + (size_t)e * 3584 * 1024, 3584, 1024, 1024, (u16*)((char*)p.wt_m2 + (size_t)e * 1024 * 3584), BIGG, 0, 0, smem, 1, &rot);
    }
}


__device__ __forceinline__ void l2_scrub(PP pp, int parity) {
    PREF; parity = uni(parity);
    const u32x4* src = (const u32x4*)(parity ? p.in[I_moe_w3] : p.in[I_moe_w1]) + (size_t)blockIdx.x * 16384;
    u32x4 a = (u32x4){0u, 0u, 0u, 0u};
#pragma unroll 8
    for (int i = tix; i < 16384; i += NT) { const u32x4 v = src[i]; a.x ^= v.x; a.y ^= v.y; a.z ^= v.z; a.w ^= v.w; }
    asm volatile("" :: "v"(a.x), "v"(a.y), "v"(a.z), "v"(a.w));
}

__global__ void __launch_bounds__(NT, 2) k_fwd(P p_) {
    extern __shared__ __attribute__((aligned(16))) char smem_raw[];
    PP pp = (PP)__builtin_amdgcn_kernarg_segment_ptr();
    if (threadIdx.x == 0) *(uint4*)smem_raw = make_uint4(0u, 0u, 0u, 0u);
    __syncthreads();
    XcdBarrier bar = xcd_barrier_post(pp->bar, (volatile LAS unsigned*)smem_raw);
    int scr = 0;
#define GSYNC() do { (void)scr; for (int _b = 0; _b < (((REPMASK) >> 9) & 1) + 1; ++_b) xcd_barrier(bar); } while (0)
#ifndef REPN
#define REPN 1
#endif
#define RP(bit) for (int _r = 0; _r < (((REPMASK) >> (bit)) & 1) * REPN + 1; ++_r)
    RP(0) { ph_mod(pp); ph_filt(pp); ph_prep(pp); }
    GSYNC();
    for (int l = 0; l < 2; ++l) {
        const int first = (l == 0), last = (l == 1);
        const int r0L = last ? RC : 0;
        RP(5) { ph_norm(pp, l, 0, 0, MT, first, 0, 0); GSYNC(); }
        RP(1) { ph_gemm_in(pp, l, 0); GSYNC(); }
        RP(2) { ph_hy_pre(pp, l); GSYNC(); }
        RP(2) { ph_hy_conv(pp, l); GSYNC(); }
        ph_hy_post(pp, l, 0);
        RP(1) { ph_gemm_in12(pp, l); GSYNC(); }
        RP(3) { rw_sg_rows(pp, l, r0L); ph_rw_scan(pp, l); GSYNC(); }
        RP(1) { ph_gemm_rwg(pp, l); GSYNC(); }
        { ph_rw_out(pp, l, r0L, 4, 4); ph_s5_scan(pp, l); GSYNC(); }
        RP(5) { ph_s5_act(pp, l, r0L); GSYNC(); }
        RP(10) ph_gemm_glu(pp, l);
        RP(1) { ph_gemm_in(pp, l, 3); GSYNC(); }
        RP(6) { ph_gla_scan(pp, l); GSYNC(); }
        RP(5) { ph_gla_out(pp, l, r0L); GSYNC(); }
        RP(1) { ph_gemm_gates(pp, l); GSYNC(); }
        ph_gemm_branch4(pp, l); GSYNC();
        if ((REPMASK >> 11) & 1) { ph_gemm_resid(pp, l, 0, 0.f); GSYNC(); }
        ph_gemm_resid(pp, l, 0, 1.f); GSYNC();
        if (!last) {
            RP(5) { ph_norm(pp, l, 1, 0, MT, 0, 0, 0); GSYNC(); }
            RP(7) { ph_gemm_ffn_up(pp); GSYNC(); }
            ph_gemm_resid(pp, l, 1, 1.f); GSYNC();
        } else {
            RP(8) { ph_prep_moe(pp); }
            RP(11) { ph_norm(pp, l, 1, RC, MT, 0, 1, 1); GSYNC(); }
            RP(11) { ph_moe_slot(pp); GSYNC(); }
            for (int ch = 0; ch < 2; ++ch) {
                RP(7) { ph_gemm_moe_up(pp, ch); GSYNC(); }
                RP(7) { ph_gemm_moe_down(pp, ch); GSYNC(); }
            }
            ph_final(pp);
        }
    }
}

static inline size_t al256(size_t x) { return (x + 255) & ~(size_t)255; }

extern "C" void kernel_launch(void* const* d_in, const int* in_sizes, int n_in, void* d_out, int out_size, void* d_ws, size_t ws_size, hipStream_t stream) {
    P p; memset(&p, 0, sizeof(p));
    for (int i = 0; i < N_IN; ++i) p.in[i] = (const float*)d_in[i];
    p.out = (float*)d_out;
    char* ws = (char*)d_ws; size_t o = 0;
    auto take = [&](size_t bytes) { char* r = ws + o; o = al256(o + bytes); return r; };
    p.bar = (unsigned*)take(16384);
    p.moe_i = (int*)take(32768);
    p.row_tok = (int*)take((size_t)67584 * 4);
    p.mod = (float*)take((size_t)2 * 17 * 6144 * 4);
    p.rvl = (u16*)take((size_t)2 * 512 * 4096 * 2);
    p.rvc = (u16*)take((size_t)2 * 512 * 512 * 2);
    p.dest_of = (int*)take((size_t)65536 * 4);
    p.top_i = (int*)take((size_t)65536 * 4);
    p.top_g = (float*)take((size_t)65536 * 4);
    p.wt_in = (u16*)take((size_t)2 * 9984 * 1024 * 2);
    p.wt_br = (u16*)take((size_t)2 * 4 * 1024 * 512 * 2);
    p.wt_out = (u16*)take((size_t)2 * 1024 * 1024 * 2);
    p.wt_f13 = (u16*)take((size_t)5632 * 1024 * 2);
    p.wt_f2 = (u16*)take((size_t)1024 * 2816 * 2);
    p.wt_glu = (u16*)take((size_t)2 * 512 * 512 * 2);
    p.wt_g = (u16*)take((size_t)2 * 512 * 256 * 2);
    p.wt_gate8 = (u16*)take((size_t)2 * 4096 * 1024);
    p.wt_in8 = (u16*)take((size_t)5888 * 1024);
    p.xr = (u16*)take((size_t)MT * 1024 * 2);
    p.hn = (u16*)d_out;
    const size_t off_hn = o;
    p.y = (u16*)take((size_t)4 * MT * 512 * 2);
    p.arena = ws + o;
    const size_t arena_need = (size_t)MT * 2048 * 2 + (size_t)2 * MT * 512 * 4 + (size_t)2 * MT * 8 * 4 + 4096 + (size_t)MT * 512 * 2;
    size_t mo = off_hn;
    p.gch = (u16*)(ws + mo); mo = al256(mo + (size_t)136 * 256 * 3584);
    p.wt_m13 = (u16*)(ws + mo); mo = al256(mo + (size_t)8 * 7168 * 1024);
    p.wt_m2 = (u16*)(ws + mo); mo = al256(mo + (size_t)8 * 1024 * 3584);
    p.yb = (u16*)(ws + mo); mo = al256(mo + (size_t)67584 * 1024 * 2);
    p.xb8 = (u16*)(ws + mo); mo = al256(mo + (size_t)67584 * 1024);
    if (o + arena_need > ws_size || mo > ws_size) return;

    static int grid = 0;
    if (!grid) {
        int dev = 0, cus = 0, per_cu = 0;
        hipGetDevice(&dev);
        hipDeviceGetAttribute(&cus, hipDeviceAttributeMultiprocessorCount, dev);
        hipFuncSetAttribute((const void*)k_fwd, hipFuncAttributeMaxDynamicSharedMemorySize, LDS_BYTES);
        hipOccupancyMaxActiveBlocksPerMultiprocessor(&per_cu, k_fwd, NT, LDS_BYTES);
        grid = per_cu >= 1 ? cus : 0;
    }
    if (!grid) return;
    hipMemsetAsync(p.bar, 0, 16384, stream);
    hipMemsetAsync(p.wt_in, 0, (size_t)2 * 9984 * 1024 * 2, stream);
    hipMemsetAsync(p.wt_g, 0, (size_t)2 * 512 * 256 * 2, stream);
    if (FP8IN_LAST) hipMemsetAsync(p.wt_in8, 0, (size_t)5888 * 1024, stream);
    k_fwd<<<grid, NT, LDS_BYTES, stream>>>(p);
}
```
